# Optimizing an MI355X kernel written in HIP

```python
import math
import jax, jax.numpy as jnp
from jax import lax
import numpy as np

D_MODEL = 1024
BATCH = 4
SEQ = 4096
DEPTH = 1

ATT_HEADS = 8
ATT_KV_HEADS = 2
ATT_HEAD_DIM = 64
ATT_GROUP = ATT_HEADS // ATT_KV_HEADS
ATT_Q_DIM = ATT_HEADS * ATT_HEAD_DIM
ATT_KV_DIM = ATT_KV_HEADS * ATT_HEAD_DIM
WINDOW = 128
ATT_BLOCK = 128
ROPE_DIM = ATT_HEAD_DIM // 4
ROPE_THETA = 500000.0

GLA_HEADS = 4
GLA_KEY_DIM = D_MODEL // 2
GLA_VAL_DIM = D_MODEL
GLA_DK = GLA_KEY_DIM // GLA_HEADS
GLA_DV = GLA_VAL_DIM // GLA_HEADS
GLA_GATE_RANK = 16
GLA_GATE_NORM = 16.0
GLA_CHUNK = 64

N_EXPERTS = 16
EXPERT_FF = D_MODEL
CAPACITY_FACTOR = 2

PLE_DIM = 256

EPS = 1e-6

IN_SIZES = (ATT_Q_DIM, ATT_KV_DIM, ATT_KV_DIM,
            GLA_KEY_DIM, GLA_KEY_DIM, GLA_VAL_DIM, GLA_VAL_DIM,
            GLA_GATE_RANK, GLA_GATE_RANK, D_MODEL, D_MODEL)
IN_DIM = ATT_Q_DIM + 2 * ATT_KV_DIM + 2 * GLA_KEY_DIM + 2 * GLA_VAL_DIM + 2 * GLA_GATE_RANK + 2 * D_MODEL

kernel_name = "hybrid_swa_gla_ecmoe_block"


def rmsnorm(x, g):
    xf = x.astype(jnp.float32)
    y = xf * lax.rsqrt(jnp.mean(xf * xf, axis=-1, keepdims=True) + EPS)
    return (y * g.astype(jnp.float32)).astype(x.dtype)


def split_columns(proj):
    parts, start = [], 0
    for size in IN_SIZES:
        parts.append(proj[..., start:start + size])
        start += size
    return parts


def partial_rope(t, positions):
    half = ROPE_DIM // 2
    inv_freq = ROPE_THETA ** (-jnp.arange(0, ROPE_DIM, 2, dtype=jnp.float32) / ROPE_DIM)
    ang = positions.astype(jnp.float32)[..., None] * inv_freq
    cos = jnp.cos(ang)[:, :, None, :].astype(t.dtype)
    sin = jnp.sin(ang)[:, :, None, :].astype(t.dtype)
    t1 = t[..., :half]
    t2 = t[..., half:ROPE_DIM]
    rot = jnp.concatenate([t1 * cos - t2 * sin, t2 * cos + t1 * sin], axis=-1)
    return jnp.concatenate([rot, t[..., ROPE_DIM:]], axis=-1)


def windowed_gqa(q, k, v, sink):
    B, S = q.shape[0], q.shape[1]
    nb = S // ATT_BLOCK
    qb = q.reshape(B, nb, ATT_BLOCK, ATT_KV_HEADS, ATT_GROUP, ATT_HEAD_DIM)

    def band(t):
        tp = jnp.pad(t, ((0, 0), (ATT_BLOCK, ATT_BLOCK), (0, 0), (0, 0)))
        tp = tp.reshape(B, nb + 2, ATT_BLOCK, ATT_KV_HEADS, ATT_HEAD_DIM)
        return jnp.concatenate([tp[:, :-2], tp[:, 1:-1], tp[:, 2:]], axis=2)

    kb, vb = band(k), band(v)
    scores = jnp.einsum('bnqhgd,bnkhd->bnhgqk', qb, kb).astype(jnp.float32) * (ATT_HEAD_DIM ** -0.5)
    blk = jnp.arange(nb)[:, None, None]
    qi = blk * ATT_BLOCK + jnp.arange(ATT_BLOCK)[None, :, None]
    kj = (blk - 1) * ATT_BLOCK + jnp.arange(3 * ATT_BLOCK)[None, None, :]
    valid = (jnp.abs(qi - kj) <= WINDOW) & (kj >= 0) & (kj < S)
    scores = jnp.where(valid[None, :, None, None], scores, -jnp.inf)
    sink_b = sink.astype(jnp.float32).reshape(1, 1, ATT_KV_HEADS, ATT_GROUP, 1, 1)
    m = jnp.maximum(jnp.max(scores, axis=-1, keepdims=True), sink_b)
    e = jnp.exp(scores - m)
    probs = e / (jnp.sum(e, axis=-1, keepdims=True) + jnp.exp(sink_b - m))
    out = jnp.einsum('bnhgqk,bnkhd->bnqhgd', probs.astype(v.dtype), vb)
    return out.reshape(B, S, ATT_Q_DIM)


def gla_chunked(q, k, v, log_a, strict):
    B, S, H, dk = q.shape
    dv = v.shape[-1]
    nc = S // GLA_CHUNK

    def chunk(t):
        return t.reshape(B, nc, GLA_CHUNK, H, t.shape[-1])

    qc, kc, vc, ac = chunk(q), chunk(k), chunk(v), chunk(log_a)
    b = jnp.cumsum(ac, axis=2)
    g = b[:, :, -1]
    q_t = qc * jnp.exp(b)
    k_t = kc * jnp.exp(-b)
    k_end = kc * jnp.exp(g[:, :, None] - b)
    attn = jnp.einsum('bclhd,bcmhd->bchlm', q_t, k_t)
    mask = jnp.tril(jnp.ones((GLA_CHUNK, GLA_CHUNK), dtype=bool), -1 if strict else 0)
    attn = jnp.where(mask, attn, 0.0)
    o_intra = jnp.einsum('bchlm,bcmhe->bclhe', attn, vc)
    kv = jnp.einsum('bclhd,bclhe->bchde', k_end, vc)
    decay = jnp.exp(g)

    def step(state, xs):
        dec, kv_c = xs
        return dec[..., None] * state + kv_c, state

    s0 = jnp.zeros((B, H, dk, dv), dtype=jnp.float32)
    _, s_prev = lax.scan(step, s0, (jnp.moveaxis(decay, 1, 0), jnp.moveaxis(kv, 1, 0)))
    s_prev = jnp.moveaxis(s_prev, 0, 1)
    o_inter = jnp.einsum('bclhd,bchde->bclhe', q_t, s_prev)
    return (o_intra + o_inter).reshape(B, S, H, dv)


def gla_branch(gq, gk, gv, gr, z_f, z_b, up_f, bias_f, up_b, bias_b, norm_gain):
    B, S = gq.shape[0], gq.shape[1]
    f32 = jnp.float32
    q = gq.astype(f32).reshape(B, S, GLA_HEADS, GLA_DK) * (GLA_DK ** -0.5)
    k = gk.astype(f32).reshape(B, S, GLA_HEADS, GLA_DK)
    v = gv.astype(f32).reshape(B, S, GLA_HEADS, GLA_DV)
    la_f = (jax.nn.log_sigmoid(z_f.astype(f32) @ up_f.astype(f32) + bias_f.astype(f32)) / GLA_GATE_NORM).reshape(B, S, GLA_HEADS, GLA_DK)
    la_b = (jax.nn.log_sigmoid(z_b.astype(f32) @ up_b.astype(f32) + bias_b.astype(f32)) / GLA_GATE_NORM).reshape(B, S, GLA_HEADS, GLA_DK)
    o_f = gla_chunked(q, k, v, la_f, strict=False)
    flip = lambda t: jnp.flip(t, axis=1)
    o_b = flip(gla_chunked(flip(q), flip(k), flip(v), flip(la_b), strict=True))
    o = o_f + o_b
    o = o * lax.rsqrt(jnp.mean(o * o, axis=-1, keepdims=True) + EPS) * norm_gain.astype(f32).reshape(GLA_HEADS, GLA_DV)
    o = o.reshape(B, S, GLA_VAL_DIM) * jax.nn.silu(gr.astype(f32))
    return o.astype(gq.dtype)


def expert_choice_ffn(xn, w_router, w_gate, w_up, w_down):
    B, S, D = xn.shape
    cap = CAPACITY_FACTOR * S // N_EXPERTS
    aff = jax.nn.softmax(jnp.einsum('bsd,de->bse', xn, w_router).astype(jnp.float32), axis=-1)
    top_aff, top_idx = lax.top_k(jnp.swapaxes(aff, 1, 2), cap)
    bidx = jnp.arange(B)[:, None, None]
    xg = xn[bidx, top_idx]
    hid = jax.nn.silu(jnp.einsum('becd,edf->becf', xg, w_gate)) * jnp.einsum('becd,edf->becf', xg, w_up)
    y = jnp.einsum('becf,efd->becd', hid, w_down) * top_aff[..., None].astype(xn.dtype)
    return jnp.zeros((B, S, D), dtype=y.dtype).at[bidx, top_idx].add(y)


def setup_inputs(seed: int = 0) -> dict:
    key = jax.random.key(seed)
    ks = jax.random.split(key, 32)
    f32 = jnp.float32
    L, D = DEPTH, D_MODEL

    def w(k, shape, fan_in):
        return jax.random.normal(k, shape, f32) * (fan_in ** -0.5)

    def gain(k, shape):
        return 1.0 + 0.1 * jax.random.normal(k, shape, f32)

    x = jax.random.normal(ks[0], (BATCH, SEQ, D), f32)
    p = jax.random.normal(ks[1], (L, BATCH, SEQ, PLE_DIM), f32)
    offsets = jax.random.randint(ks[2], (BATCH, 1), 0, 1024, dtype=jnp.int32)
    positions = jnp.arange(SEQ, dtype=jnp.int32)[None, :] + offsets
    return {
        "x": x,
        "p": p,
        "positions": positions,
        "norm_mix": gain(ks[3], (L, D)),
        "w_in": w(ks[4], (L, D, IN_DIM), D),
        "gla_gate_up_fwd": w(ks[5], (L, GLA_GATE_RANK, GLA_KEY_DIM), GLA_GATE_RANK),
        "gla_gate_bias_fwd": 1.0 + 0.5 * jax.random.normal(ks[6], (L, GLA_KEY_DIM), f32),
        "gla_gate_up_bwd": w(ks[7], (L, GLA_GATE_RANK, GLA_KEY_DIM), GLA_GATE_RANK),
        "gla_gate_bias_bwd": 1.0 + 0.5 * jax.random.normal(ks[8], (L, GLA_KEY_DIM), f32),
        "attn_sink": 0.5 * jax.random.normal(ks[9], (L, ATT_HEADS), f32),
        "gla_norm": gain(ks[10], (L, GLA_VAL_DIM)),
        "w_branch_attn": w(ks[11], (L, ATT_Q_DIM, D), ATT_Q_DIM),
        "w_branch_gla": w(ks[12], (L, GLA_VAL_DIM, D), GLA_VAL_DIM),
        "w_out": w(ks[13], (L, D, D), D),
        "norm_ffn": gain(ks[14], (L, D)),
        "w_router": w(ks[15], (L, D, N_EXPERTS), D),
        "w_exp_gate": w(ks[16], (L, N_EXPERTS, D, EXPERT_FF), D),
        "w_exp_up": w(ks[17], (L, N_EXPERTS, D, EXPERT_FF), D),
        "w_exp_down": w(ks[18], (L, N_EXPERTS, EXPERT_FF, D), EXPERT_FF),
        "norm_ple": gain(ks[19], (L, D)),
        "w_ple_gate": w(ks[20], (L, D, D), D),
        "w_ple": w(ks[21], (L, PLE_DIM, D), PLE_DIM),
        "norm_final": gain(ks[22], (D,)),
    }


def reference(x, p, positions, norm_mix, w_in, gla_gate_up_fwd, gla_gate_bias_fwd,
              gla_gate_up_bwd, gla_gate_bias_bwd, attn_sink, gla_norm, w_branch_attn,
              w_branch_gla, w_out, norm_ffn, w_router, w_exp_gate, w_exp_up, w_exp_down,
              norm_ple, w_ple_gate, w_ple, norm_final):
    B, S, _ = x.shape
    h = x
    for l in range(DEPTH):
        a = rmsnorm(h, norm_mix[l])
        proj = a @ w_in[l]
        aq, ak, av, gq, gk, gv, gr, z_f, z_b, g_att, g_gla = split_columns(proj)
        aq = partial_rope(aq.reshape(B, S, ATT_HEADS, ATT_HEAD_DIM), positions)
        ak = partial_rope(ak.reshape(B, S, ATT_KV_HEADS, ATT_HEAD_DIM), positions)
        av = av.reshape(B, S, ATT_KV_HEADS, ATT_HEAD_DIM)
        y_att = windowed_gqa(aq, ak, av, attn_sink[l]) @ w_branch_attn[l]
        y_gla = gla_branch(gq, gk, gv, gr, z_f, z_b,
                           gla_gate_up_fwd[l], gla_gate_bias_fwd[l],
                           gla_gate_up_bwd[l], gla_gate_bias_bwd[l], gla_norm[l]) @ w_branch_gla[l]
        merged = jax.nn.sigmoid(g_att) * y_att + jax.nn.sigmoid(g_gla) * y_gla
        h = h + merged @ w_out[l]
        h = h + expert_choice_ffn(rmsnorm(h, norm_ffn[l]), w_router[l],
                                  w_exp_gate[l], w_exp_up[l], w_exp_down[l])
        ple_gate = jax.nn.sigmoid(rmsnorm(h, norm_ple[l]) @ w_ple_gate[l])
        h = h + ple_gate * (p[l] @ w_ple[l])
    return rmsnorm(h, norm_final)
```

```cpp
#include <hip/hip_runtime.h>
#include <cstdio>
#include <cstdint>

constexpr int B_ = 4, S_ = 4096, D_ = 1024, T_ = B_ * S_;
constexpr int IN_DIM = 5920;
constexpr int C_Q = 0, C_K = 512, C_V = 640, C_GQ = 768, C_GK = 1280, C_GV = 1792, C_GR = 2816, C_ZF = 3840, C_ZB = 3856, C_GATT = 3872, C_GGLA = 4896;
constexpr int NE = 16, CAP = 512, FF = 1024, PLE = 256;
constexpr float EPS = 1e-6f;

typedef float f32x4 __attribute__((ext_vector_type(4)));

__global__ void __launch_bounds__(256) gemm_f32(const float* __restrict__ A, int lda, const int* __restrict__ gidx,
                                                const float* __restrict__ Bm, int ldb, float* __restrict__ C, int ldc,
                                                const float* __restrict__ R, int ldr, int M, int N, int K) {
    __shared__ float As[8][128 + 4];
    __shared__ float Bs[8][128 + 4];
    const int tid = threadIdx.x, tx = tid & 15, ty = tid >> 4;
    const int m0 = blockIdx.y * 128, n0 = blockIdx.x * 128;
    float acc[8][8];
#pragma unroll
    for (int i = 0; i < 8; ++i)
#pragma unroll
        for (int j = 0; j < 8; ++j) acc[i][j] = 0.f;
    const int arow_l = tid >> 1, akoff = (tid & 1) * 4;
    const int am = m0 + arow_l;
    const long arow = gidx ? (long)gidx[am] : (long)am;
    const float* Ap = A + arow * lda + akoff;
    const int bk = tid >> 5, bn = (tid & 31) * 4;
    const bool bok = (n0 + bn) < N;
    const float* Bp = Bm + (long)bk * ldb + n0 + bn;
    for (int k0 = 0; k0 < K; k0 += 8) {
        const f32x4 av = *(const f32x4*)(Ap + k0);
        f32x4 bv = (f32x4){0.f, 0.f, 0.f, 0.f};
        if (bok) bv = *(const f32x4*)(Bp + (long)k0 * ldb);
        __syncthreads();
        As[akoff + 0][arow_l] = av.x; As[akoff + 1][arow_l] = av.y; As[akoff + 2][arow_l] = av.z; As[akoff + 3][arow_l] = av.w;
        *(f32x4*)&Bs[bk][bn] = bv;
        __syncthreads();
#pragma unroll
        for (int kk = 0; kk < 8; ++kk) {
            float a[8], b[8];
            const f32x4 a0 = *(const f32x4*)&As[kk][ty * 4], a1 = *(const f32x4*)&As[kk][64 + ty * 4];
            const f32x4 b0 = *(const f32x4*)&Bs[kk][tx * 4], b1 = *(const f32x4*)&Bs[kk][64 + tx * 4];
            a[0] = a0.x; a[1] = a0.y; a[2] = a0.z; a[3] = a0.w; a[4] = a1.x; a[5] = a1.y; a[6] = a1.z; a[7] = a1.w;
            b[0] = b0.x; b[1] = b0.y; b[2] = b0.z; b[3] = b0.w; b[4] = b1.x; b[5] = b1.y; b[6] = b1.z; b[7] = b1.w;
#pragma unroll
            for (int i = 0; i < 8; ++i)
#pragma unroll
                for (int j = 0; j < 8; ++j) acc[i][j] = fmaf(a[i], b[j], acc[i][j]);
        }
    }
#pragma unroll
    for (int i = 0; i < 8; ++i) {
        const int m = m0 + (i < 4 ? ty * 4 + i : 64 + ty * 4 + (i - 4));
#pragma unroll
        for (int jh = 0; jh < 2; ++jh) {
            const int n = n0 + jh * 64 + tx * 4;
            if (n < N) {
                f32x4 v = (f32x4){acc[i][jh * 4 + 0], acc[i][jh * 4 + 1], acc[i][jh * 4 + 2], acc[i][jh * 4 + 3]};
                if (R) v += *(const f32x4*)(R + (long)m * ldr + n);
                *(f32x4*)(C + (long)m * ldc + n) = v;
            }
        }
    }
}

__device__ __forceinline__ float wave_sum(float v) {
#pragma unroll
    for (int o = 1; o < 64; o <<= 1) v += __shfl_xor(v, o);
    return v;
}

__global__ void __launch_bounds__(256) rmsnorm_rows(const float* __restrict__ X, const float* __restrict__ g, float* __restrict__ Y, int rows) {
    const int row = blockIdx.x * 4 + (threadIdx.x >> 6), lane = threadIdx.x & 63;
    if (row >= rows) return;
    const f32x4* xr = (const f32x4*)(X + (long)row * D_) + lane;
    f32x4 v[4]; float s = 0.f;
#pragma unroll
    for (int j = 0; j < 4; ++j) { v[j] = xr[64 * j]; s += v[j].x * v[j].x + v[j].y * v[j].y + v[j].z * v[j].z + v[j].w * v[j].w; }
    const float r = 1.0f / sqrtf(wave_sum(s) * (1.0f / D_) + EPS);
    f32x4* yr = (f32x4*)(Y + (long)row * D_) + lane;
    const f32x4* gr = (const f32x4*)g + lane;
#pragma unroll
    for (int j = 0; j < 4; ++j) yr[64 * j] = v[j] * r * gr[64 * j];
}

__global__ void __launch_bounds__(256) rope_kernel(float* __restrict__ qkv, const int* __restrict__ pos) {
    const int gid = blockIdx.x * 256 + threadIdx.x;
    if (gid >= T_ * 80) return;
    const int i = gid & 7, hh = (gid >> 3) % 10, t = gid / 80;
    const float invf[8] = {1.0f, 0.1939227432012558f, 0.03760603070259094f, 0.007292664609849453f, 0.0014142135623842478f, 0.00027424818836152554f, 5.3182957344688475e-05f, 1.0313385246263351e-05f};
    const float ang = (float)pos[t] * invf[i];
    const float c = cosf(ang), s = sinf(ang);
    float* p = qkv + (long)t * 768 + hh * 64;
    const float t1 = p[i], t2 = p[i + 8];
    p[i] = t1 * c - t2 * s; p[i + 8] = t2 * c + t1 * s;
}

__global__ void __launch_bounds__(128) attn_naive(const float* __restrict__ qkv, const float* __restrict__ sink, float* __restrict__ out) {
    const int h = blockIdx.y, t = blockIdx.x * 128 + threadIdx.x;
    const int b = t / S_, i = t % S_, kvh = h >> 2;
    float q[64];
    const float* qp = qkv + (long)t * 768 + h * 64;
#pragma unroll
    for (int d = 0; d < 64; ++d) q[d] = qp[d] * 0.125f;
    const int j0 = max(0, i - 128), j1 = min(S_ - 1, i + 128);
    const float sk = sink[h];
    float m = sk;
    for (int j = j0; j <= j1; ++j) {
        const float* kp = qkv + (long)(b * S_ + j) * 768 + 512 + kvh * 64;
        float s = 0.f;
#pragma unroll
        for (int d = 0; d < 64; ++d) s = fmaf(q[d], kp[d], s);
        m = fmaxf(m, s);
    }
    float o[64];
#pragma unroll
    for (int d = 0; d < 64; ++d) o[d] = 0.f;
    float l = expf(sk - m);
    for (int j = j0; j <= j1; ++j) {
        const float* kp = qkv + (long)(b * S_ + j) * 768 + 512 + kvh * 64;
        const float* vp = kp + 128;
        float s = 0.f;
#pragma unroll
        for (int d = 0; d < 64; ++d) s = fmaf(q[d], kp[d], s);
        const float p = expf(s - m);
        l += p;
#pragma unroll
        for (int d = 0; d < 64; ++d) o[d] = fmaf(p, vp[d], o[d]);
    }
    const float rl = 1.0f / l;
    float* op = out + (long)t * 512 + h * 64;
#pragma unroll
    for (int d = 0; d < 64; ++d) op[d] = o[d] * rl;
}

__global__ void __launch_bounds__(256) gate_mul(const float* G, const float* Y, float* C, long n, int accf) {
    const long i = (long)blockIdx.x * 256 + threadIdx.x;
    if (i >= n) return;
    const float v = Y[i] / (1.0f + expf(-G[i]));
    C[i] = accf ? C[i] + v : v;
}

__global__ void __launch_bounds__(256) gla_gate(const float* __restrict__ z, int zoff, const float* __restrict__ up, const float* __restrict__ bias, float* __restrict__ la) {
    const long gid = (long)blockIdx.x * 256 + threadIdx.x;
    const int c = gid & 511; const long t = gid >> 9;
    float x = bias[c];
#pragma unroll
    for (int r = 0; r < 16; ++r) x = fmaf(z[t * 32 + zoff + r], up[r * 512 + c], x);
    const float ls = fminf(x, 0.f) - log1pf(expf(-fabsf(x)));
    la[gid] = ls * (1.0f / 16.0f);
}

__global__ void __launch_bounds__(256) gla_recur(const float* __restrict__ qk, const float* __restrict__ v, const float* __restrict__ la, float* __restrict__ o, int dir) {
    __shared__ float sq[32][128], sk[32][128], sa[32][128];
    __shared__ float sv[32][8], so[32][8];
    const int tid = threadIdx.x, w = tid >> 6, lane = tid & 63;
    const int es = blockIdx.x, h = blockIdx.y, b = blockIdx.z, e0 = es * 8;
    const int el = w * 2 + (lane >> 5), dg = lane & 31, d0 = dg * 4;
    float S[4] = {0.f, 0.f, 0.f, 0.f};
    const float scale = 0.08838834764831845f;
    for (int c = 0; c < S_ / 32; ++c) {
        __syncthreads();
        for (int idx = tid; idx < 32 * 32; idx += 256) {
            const int j = idx >> 5, d4 = idx & 31;
            const int il = c * 32 + j; const int t = dir ? (S_ - 1 - il) : il;
            const long row = (long)(b * S_ + t);
            const f32x4 qv = *(const f32x4*)(qk + row * 1024 + h * 128 + d4 * 4);
            const f32x4 kv = *(const f32x4*)(qk + row * 1024 + 512 + h * 128 + d4 * 4);
            const f32x4 lv = *(const f32x4*)(la + row * 512 + h * 128 + d4 * 4);
            *(f32x4*)&sq[j][d4 * 4] = qv; *(f32x4*)&sk[j][d4 * 4] = kv;
            *(f32x4*)&sa[j][d4 * 4] = (f32x4){expf(lv.x), expf(lv.y), expf(lv.z), expf(lv.w)};
        }
        {
            const int j = tid >> 3, e = tid & 7;
            const int il = c * 32 + j; const int t = dir ? (S_ - 1 - il) : il;
            sv[j][e] = v[(long)(b * S_ + t) * 1024 + h * 256 + e0 + e];
        }
        __syncthreads();
        for (int j = 0; j < 32; ++j) {
            const f32x4 a4 = *(const f32x4*)&sa[j][d0], k4 = *(const f32x4*)&sk[j][d0], q4 = *(const f32x4*)&sq[j][d0];
            const float vv = sv[j][el];
            float part;
            if (!dir) {
                S[0] = fmaf(a4.x, S[0], k4.x * vv); S[1] = fmaf(a4.y, S[1], k4.y * vv); S[2] = fmaf(a4.z, S[2], k4.z * vv); S[3] = fmaf(a4.w, S[3], k4.w * vv);
                part = q4.x * S[0] + q4.y * S[1] + q4.z * S[2] + q4.w * S[3];
            } else {
                S[0] *= a4.x; S[1] *= a4.y; S[2] *= a4.z; S[3] *= a4.w;
                part = q4.x * S[0] + q4.y * S[1] + q4.z * S[2] + q4.w * S[3];
                S[0] = fmaf(k4.x, vv, S[0]); S[1] = fmaf(k4.y, vv, S[1]); S[2] = fmaf(k4.z, vv, S[2]); S[3] = fmaf(k4.w, vv, S[3]);
            }
#pragma unroll
            for (int off = 1; off < 32; off <<= 1) part += __shfl_xor(part, off);
            if (dg == 0) so[j][el] = part * scale;
        }
        __syncthreads();
        {
            const int j = tid >> 3, e = tid & 7;
            const int il = c * 32 + j; const int t = dir ? (S_ - 1 - il) : il;
            float* op = o + (long)(b * S_ + t) * 1024 + h * 256 + e0 + e;
            if (dir) *op += so[j][e]; else *op = so[j][e];
        }
    }
}

__global__ void __launch_bounds__(256) gla_post_norm(float* __restrict__ o, const float* __restrict__ gain) {
    const int gw = blockIdx.x * 4 + (threadIdx.x >> 6), lane = threadIdx.x & 63;
    const int h = gw & 3; const long t = gw >> 2;
    f32x4* p = (f32x4*)(o + t * 1024 + h * 256) + lane;
    f32x4 x = *p;
    const float s = wave_sum(x.x * x.x + x.y * x.y + x.z * x.z + x.w * x.w);
    const float r = 1.0f / sqrtf(s * (1.0f / 256.0f) + EPS);
    const f32x4 g = *((const f32x4*)(gain + h * 256) + lane);
    *p = x * r * g;
}
__global__ void __launch_bounds__(256) silu_mul(float* __restrict__ o, const float* __restrict__ gr, long n) {
    const long i = (long)blockIdx.x * 256 + threadIdx.x;
    if (i >= n) return;
    const float g = gr[i];
    o[i] = o[i] * (g / (1.0f + expf(-g)));
}
__global__ void __launch_bounds__(256) swiglu(float* __restrict__ G, const float* __restrict__ U, long n) {
    const long i = (long)blockIdx.x * 256 + threadIdx.x;
    if (i >= n) return;
    const float g = G[i];
    G[i] = (g / (1.0f + expf(-g))) * U[i];
}
__global__ void __launch_bounds__(256) softmax16(const float* __restrict__ logits, float* __restrict__ aff) {
    const int t = blockIdx.x * 256 + threadIdx.x;
    if (t >= T_) return;
    float x[16], m = -INFINITY;
#pragma unroll
    for (int e = 0; e < 16; ++e) { x[e] = logits[t * 16 + e]; m = fmaxf(m, x[e]); }
    float s = 0.f;
#pragma unroll
    for (int e = 0; e < 16; ++e) { x[e] = expf(x[e] - m); s += x[e]; }
    const float r = 1.0f / s;
#pragma unroll
    for (int e = 0; e < 16; ++e) aff[t * 16 + e] = x[e] * r;
}
__global__ void __launch_bounds__(256) topk_rank(const float* __restrict__ aff, int* __restrict__ gidx) {
    __shared__ float sa[S_];
    const int e = blockIdx.y, b = blockIdx.z;
    for (int s = threadIdx.x; s < S_; s += 256) sa[s] = aff[(long)(b * S_ + s) * 16 + e];
    __syncthreads();
    const int s = blockIdx.x * 256 + threadIdx.x;
    const float a = sa[s];
    int rank = 0;
    for (int s2 = 0; s2 < S_; ++s2) { const float a2 = sa[s2]; rank += (a2 > a || (a2 == a && s2 < s)) ? 1 : 0; }
    if (rank < CAP) gidx[e * (B_ * CAP) + b * CAP + rank] = b * S_ + s;
}
__global__ void __launch_bounds__(256) scatter_add(float* __restrict__ h, const float* __restrict__ Y, const float* __restrict__ aff, const int* __restrict__ gidx, int e) {
    const int m = blockIdx.x * 4 + (threadIdx.x >> 6), lane = threadIdx.x & 63;
    const int t = gidx[m];
    const float a = aff[t * 16 + e];
    f32x4* hp = (f32x4*)(h + (long)t * D_) + lane;
    const f32x4* yp = (const f32x4*)(Y + (long)m * D_) + lane;
#pragma unroll
    for (int j = 0; j < 4; ++j) hp[64 * j] += yp[64 * j] * a;
}
__global__ void __launch_bounds__(256) ple_add(float* __restrict__ h, const float* __restrict__ G, const float* __restrict__ P, long n) {
    const long i = (long)blockIdx.x * 256 + threadIdx.x;
    if (i >= n) return;
    h[i] += P[i] / (1.0f + expf(-G[i]));
}

static void gemm(hipStream_t st, const float* A, int lda, const int* gidx, const float* Bm, int ldb, float* C, int ldc, const float* R, int ldr, int M, int N, int K) {
    dim3 grid((N + 127) / 128, M / 128);
    hipLaunchKernelGGL(gemm_f32, grid, dim3(256), 0, st, A, lda, gidx, Bm, ldb, C, ldc, R, ldr, M, N, K);
}

extern "C" void kernel_launch(void* const* d_in, const int* in_sizes, int n_in, void* d_out, int out_size, void* d_ws, size_t ws_size, hipStream_t stream) {
    const float* x = (const float*)d_in[0];
    const float* p = (const float*)d_in[1];
    const int* pos = (const int*)d_in[2];
    const float* norm_mix = (const float*)d_in[3];
    const float* w_in = (const float*)d_in[4];
    const float* up_f = (const float*)d_in[5];
    const float* bias_f = (const float*)d_in[6];
    const float* up_b = (const float*)d_in[7];
    const float* bias_b = (const float*)d_in[8];
    const float* sink = (const float*)d_in[9];
    const float* gla_norm = (const float*)d_in[10];
    const float* w_ba = (const float*)d_in[11];
    const float* w_bg = (const float*)d_in[12];
    const float* w_out = (const float*)d_in[13];
    const float* norm_ffn = (const float*)d_in[14];
    const float* w_router = (const float*)d_in[15];
    const float* w_eg = (const float*)d_in[16];
    const float* w_eu = (const float*)d_in[17];
    const float* w_ed = (const float*)d_in[18];
    const float* norm_ple = (const float*)d_in[19];
    const float* w_pg = (const float*)d_in[20];
    const float* w_ple = (const float*)d_in[21];
    const float* norm_final = (const float*)d_in[22];
    float* out = (float*)d_out;
    const size_t U = (size_t)T_ * D_ * 4;
    char* ws = (char*)d_ws;
    float* R0 = (float*)(ws);
    float* R1 = (float*)(ws + U);
    float* R2 = (float*)(ws + 2 * U);
    float* R3 = (float*)(ws + 3 * U);
    float* R4 = (float*)(ws + 4 * U);
    const long NTD = (long)T_ * D_;
    const int EB = (int)((NTD + 255) / 256);

    hipLaunchKernelGGL(rmsnorm_rows, dim3(T_ / 4), dim3(256), 0, stream, x, norm_mix, R0, T_);
    gemm(stream, R0, D_, nullptr, w_in + C_Q, IN_DIM, R1, 768, nullptr, 0, T_, 768, D_);
    hipLaunchKernelGGL(rope_kernel, dim3(T_ * 80 / 256), dim3(256), 0, stream, R1, pos);
    hipLaunchKernelGGL(attn_naive, dim3(T_ / 128, 8), dim3(128), 0, stream, R1, sink, R2);
    gemm(stream, R2, 512, nullptr, w_ba, D_, R3, D_, nullptr, 0, T_, D_, 512);
    gemm(stream, R0, D_, nullptr, w_in + C_GATT, IN_DIM, R1, D_, nullptr, 0, T_, D_, D_);
    hipLaunchKernelGGL(gate_mul, dim3(EB), dim3(256), 0, stream, R1, R3, R3, NTD, 0);
    gemm(stream, R0, D_, nullptr, w_in + C_GQ, IN_DIM, R1, D_, nullptr, 0, T_, 1024, D_);
    gemm(stream, R0, D_, nullptr, w_in + C_GV, IN_DIM, R2, D_, nullptr, 0, T_, 1024, D_);
    gemm(stream, R0, D_, nullptr, w_in + C_ZF, IN_DIM, R4, 32, nullptr, 0, T_, 32, D_);
    float* la_f = out; float* la_b = out + (size_t)T_ * 512;
    hipLaunchKernelGGL(gla_gate, dim3(T_ * 512 / 256), dim3(256), 0, stream, R4, 0, up_f, bias_f, la_f);
    hipLaunchKernelGGL(gla_gate, dim3(T_ * 512 / 256), dim3(256), 0, stream, R4, 16, up_b, bias_b, la_b);
    hipLaunchKernelGGL(gla_recur, dim3(32, 4, 4), dim3(256), 0, stream, R1, R2, la_f, R0, 0);
    hipLaunchKernelGGL(gla_recur, dim3(32, 4, 4), dim3(256), 0, stream, R1, R2, la_b, R0, 1);
    hipLaunchKernelGGL(gla_post_norm, dim3(T_), dim3(256), 0, stream, R0, gla_norm);
    hipLaunchKernelGGL(rmsnorm_rows, dim3(T_ / 4), dim3(256), 0, stream, x, norm_mix, R1, T_);
    gemm(stream, R1, D_, nullptr, w_in + C_GR, IN_DIM, R2, D_, nullptr, 0, T_, D_, D_);
    hipLaunchKernelGGL(silu_mul, dim3(EB), dim3(256), 0, stream, R0, R2, NTD);
    gemm(stream, R0, D_, nullptr, w_bg, D_, R2, D_, nullptr, 0, T_, D_, D_);
    gemm(stream, R1, D_, nullptr, w_in + C_GGLA, IN_DIM, out, D_, nullptr, 0, T_, D_, D_);
    hipLaunchKernelGGL(gate_mul, dim3(EB), dim3(256), 0, stream, out, R2, R3, NTD, 1);
    gemm(stream, R3, D_, nullptr, w_out, D_, R0, D_, x, D_, T_, D_, D_);

    hipLaunchKernelGGL(rmsnorm_rows, dim3(T_ / 4), dim3(256), 0, stream, R0, norm_ffn, R1, T_);
    float* logits = R4; float* aff = R4 + (size_t)T_ * 16; int* gidx = (int*)(R4 + (size_t)T_ * 32);
    gemm(stream, R1, D_, nullptr, w_router, NE, logits, NE, nullptr, 0, T_, NE, D_);
    hipLaunchKernelGGL(softmax16, dim3(T_ / 256), dim3(256), 0, stream, logits, aff);
    hipLaunchKernelGGL(topk_rank, dim3(S_ / 256, NE, B_), dim3(256), 0, stream, aff, gidx);
    const int ME = B_ * CAP;
    float* Gb = R2; float* Ub = R2 + (size_t)ME * FF; float* Yb = R2 + 2 * (size_t)ME * FF;
    for (int e = 0; e < NE; ++e) {
        const size_t wo = (size_t)e * D_ * FF;
        gemm(stream, R1, D_, gidx + e * ME, w_eg + wo, FF, Gb, FF, nullptr, 0, ME, FF, D_);
        gemm(stream, R1, D_, gidx + e * ME, w_eu + wo, FF, Ub, FF, nullptr, 0, ME, FF, D_);
        hipLaunchKernelGGL(swiglu, dim3(ME * FF / 256), dim3(256), 0, stream, Gb, Ub, (long)ME * FF);
        gemm(stream, Gb, FF, nullptr, w_ed + wo, D_, Yb, D_, nullptr, 0, ME, D_, FF);
        hipLaunchKernelGGL(scatter_add, dim3(ME / 4), dim3(256), 0, stream, R0, Yb, aff, gidx + e * ME, e);
    }
    hipLaunchKernelGGL(rmsnorm_rows, dim3(T_ / 4), dim3(256), 0, stream, R0, norm_ple, R1, T_);
    gemm(stream, R1, D_, nullptr, w_pg, D_, R2, D_, nullptr, 0, T_, D_, D_);
    gemm(stream, p, PLE, nullptr, w_ple, D_, R3, D_, nullptr, 0, T_, D_, PLE);
    hipLaunchKernelGGL(ple_add, dim3(EB), dim3(256), 0, stream, R0, R2, R3, NTD);
    hipLaunchKernelGGL(rmsnorm_rows, dim3(T_ / 4), dim3(256), 0, stream, R0, norm_final, out, T_);
}
```

```cpp
#include <hip/hip_runtime.h>
#include <hip/hip_cooperative_groups.h>
namespace cg = cooperative_groups;
#include <cstdio>
#include <cstdint>

constexpr int B_ = 4, S_ = 4096, D_ = 1024, T_ = B_ * S_;
constexpr int IN_DIM = 5920;
constexpr int C_Q = 0, C_K = 512, C_V = 640, C_GQ = 768, C_GK = 1280, C_GV = 1792, C_GR = 2816, C_ZF = 3840, C_ZB = 3856, C_GATT = 3872, C_GGLA = 4896;
constexpr int NE = 16, CAP = 512, FF = 1024, PLE = 256;
constexpr float EPS = 1e-6f;

typedef float f32x4 __attribute__((ext_vector_type(4)));

__device__ __forceinline__ void gemm_f32(const int bx, const int by, const int bz, const float* A, int lda, const int* gidx,
                                                const float* Bm, int ldb, float* C, int ldc,
                                                const float* R, int ldr, int M, int N, int K) {
    __shared__ float As[8][128 + 4];
    __shared__ float Bs[8][128 + 4];
    const int tid = threadIdx.x, tx = tid & 15, ty = tid >> 4;
    const int m0 = by * 128, n0 = bx * 128;
    float acc[8][8];
#pragma unroll
    for (int i = 0; i < 8; ++i)
#pragma unroll
        for (int j = 0; j < 8; ++j) acc[i][j] = 0.f;
    const int arow_l = tid >> 1, akoff = (tid & 1) * 4;
    const int am = m0 + arow_l;
    const long arow = gidx ? (long)gidx[am] : (long)am;
    const float* Ap = A + arow * lda + akoff;
    const int bk = tid >> 5, bn = (tid & 31) * 4;
    const bool bok = (n0 + bn) < N;
    const float* Bp = Bm + (long)bk * ldb + n0 + bn;
    for (int k0 = 0; k0 < K; k0 += 8) {
        const f32x4 av = *(const f32x4*)(Ap + k0);
        f32x4 bv = (f32x4){0.f, 0.f, 0.f, 0.f};
        if (bok) bv = *(const f32x4*)(Bp + (long)k0 * ldb);
        __syncthreads();
        As[akoff + 0][arow_l] = av.x; As[akoff + 1][arow_l] = av.y; As[akoff + 2][arow_l] = av.z; As[akoff + 3][arow_l] = av.w;
        *(f32x4*)&Bs[bk][bn] = bv;
        __syncthreads();
#pragma unroll
        for (int kk = 0; kk < 8; ++kk) {
            float a[8], b[8];
            const f32x4 a0 = *(const f32x4*)&As[kk][ty * 4], a1 = *(const f32x4*)&As[kk][64 + ty * 4];
            const f32x4 b0 = *(const f32x4*)&Bs[kk][tx * 4], b1 = *(const f32x4*)&Bs[kk][64 + tx * 4];
            a[0] = a0.x; a[1] = a0.y; a[2] = a0.z; a[3] = a0.w; a[4] = a1.x; a[5] = a1.y; a[6] = a1.z; a[7] = a1.w;
            b[0] = b0.x; b[1] = b0.y; b[2] = b0.z; b[3] = b0.w; b[4] = b1.x; b[5] = b1.y; b[6] = b1.z; b[7] = b1.w;
#pragma unroll
            for (int i = 0; i < 8; ++i)
#pragma unroll
                for (int j = 0; j < 8; ++j) acc[i][j] = fmaf(a[i], b[j], acc[i][j]);
        }
    }
#pragma unroll
    for (int i = 0; i < 8; ++i) {
        const int m = m0 + (i < 4 ? ty * 4 + i : 64 + ty * 4 + (i - 4));
#pragma unroll
        for (int jh = 0; jh < 2; ++jh) {
            const int n = n0 + jh * 64 + tx * 4;
            if (n < N) {
                f32x4 v = (f32x4){acc[i][jh * 4 + 0], acc[i][jh * 4 + 1], acc[i][jh * 4 + 2], acc[i][jh * 4 + 3]};
                if (R) v += *(const f32x4*)(R + (long)m * ldr + n);
                *(f32x4*)(C + (long)m * ldc + n) = v;
            }
        }
    }
}

__device__ __forceinline__ float wave_sum(float v) {
#pragma unroll
    for (int o = 1; o < 64; o <<= 1) v += __shfl_xor(v, o);
    return v;
}

__device__ __forceinline__ void rmsnorm_rows(const int bx, const int by, const int bz, const float* X, const float* g, float* Y, int rows) {
    const int row = bx * 4 + (threadIdx.x >> 6), lane = threadIdx.x & 63;
    if (row >= rows) return;
    const f32x4* xr = (const f32x4*)(X + (long)row * D_) + lane;
    f32x4 v[4]; float s = 0.f;
#pragma unroll
    for (int j = 0; j < 4; ++j) { v[j] = xr[64 * j]; s += v[j].x * v[j].x + v[j].y * v[j].y + v[j].z * v[j].z + v[j].w * v[j].w; }
    const float r = 1.0f / sqrtf(wave_sum(s) * (1.0f / D_) + EPS);
    f32x4* yr = (f32x4*)(Y + (long)row * D_) + lane;
    const f32x4* gr = (const f32x4*)g + lane;
#pragma unroll
    for (int j = 0; j < 4; ++j) yr[64 * j] = v[j] * r * gr[64 * j];
}

__device__ __forceinline__ void rope_kernel(const int bx, const int by, const int bz, float* qkv, const int* pos) {
    const int gid = bx * 256 + threadIdx.x;
    if (gid >= T_ * 80) return;
    const int i = gid & 7, hh = (gid >> 3) % 10, t = gid / 80;
    const float invf[8] = {1.0f, 0.1939227432012558f, 0.03760603070259094f, 0.007292664609849453f, 0.0014142135623842478f, 0.00027424818836152554f, 5.3182957344688475e-05f, 1.0313385246263351e-05f};
    const float ang = (float)pos[t] * invf[i];
    const float c = cosf(ang), s = sinf(ang);
    float* p = qkv + (long)t * 768 + hh * 64;
    const float t1 = p[i], t2 = p[i + 8];
    p[i] = t1 * c - t2 * s; p[i + 8] = t2 * c + t1 * s;
}

__device__ __forceinline__ void attn_naive(const int bx, const int by, const int bz, const float* qkv, const float* sink, float* out) {
    const int h = by, t = bx * 256 + threadIdx.x;
    const int b = t / S_, i = t % S_, kvh = h >> 2;
    float q[64];
    const float* qp = qkv + (long)t * 768 + h * 64;
#pragma unroll
    for (int d = 0; d < 64; ++d) q[d] = qp[d] * 0.125f;
    const int j0 = max(0, i - 128), j1 = min(S_ - 1, i + 128);
    const float sk = sink[h];
    float m = sk;
    for (int j = j0; j <= j1; ++j) {
        const float* kp = qkv + (long)(b * S_ + j) * 768 + 512 + kvh * 64;
        float s = 0.f;
#pragma unroll
        for (int d = 0; d < 64; ++d) s = fmaf(q[d], kp[d], s);
        m = fmaxf(m, s);
    }
    float o[64];
#pragma unroll
    for (int d = 0; d < 64; ++d) o[d] = 0.f;
    float l = expf(sk - m);
    for (int j = j0; j <= j1; ++j) {
        const float* kp = qkv + (long)(b * S_ + j) * 768 + 512 + kvh * 64;
        const float* vp = kp + 128;
        float s = 0.f;
#pragma unroll
        for (int d = 0; d < 64; ++d) s = fmaf(q[d], kp[d], s);
        const float p = expf(s - m);
        l += p;
#pragma unroll
        for (int d = 0; d < 64; ++d) o[d] = fmaf(p, vp[d], o[d]);
    }
    const float rl = 1.0f / l;
    float* op = out + (long)t * 512 + h * 64;
#pragma unroll
    for (int d = 0; d < 64; ++d) op[d] = o[d] * rl;
}

__device__ __forceinline__ void gate_mul(const int bx, const int by, const int bz, const float* G, const float* Y, float* C, long n, int accf) {
    const long i = (long)bx * 256 + threadIdx.x;
    if (i >= n) return;
    const float v = Y[i] / (1.0f + expf(-G[i]));
    C[i] = accf ? C[i] + v : v;
}

__device__ __forceinline__ void gla_gate(const int bx, const int by, const int bz, const float* z, int zoff, const float* up, const float* bias, float* la) {
    const long gid = (long)bx * 256 + threadIdx.x;
    const int c = gid & 511; const long t = gid >> 9;
    float x = bias[c];
#pragma unroll
    for (int r = 0; r < 16; ++r) x = fmaf(z[t * 32 + zoff + r], up[r * 512 + c], x);
    const float ls = fminf(x, 0.f) - log1pf(expf(-fabsf(x)));
    la[gid] = ls * (1.0f / 16.0f);
}

__device__ __forceinline__ void gla_recur(const int bx, const int by, const int bz, const float* qk, const float* v, const float* la, float* o, int dir) {
    __shared__ float sq[32][128], sk[32][128], sa[32][128];
    __shared__ float sv[32][8], so[32][8];
    const int tid = threadIdx.x, w = tid >> 6, lane = tid & 63;
    const int es = bx, h = by, b = bz, e0 = es * 8;
    const int el = w * 2 + (lane >> 5), dg = lane & 31, d0 = dg * 4;
    float S[4] = {0.f, 0.f, 0.f, 0.f};
    const float scale = 0.08838834764831845f;
    for (int c = 0; c < S_ / 32; ++c) {
        __syncthreads();
        for (int idx = tid; idx < 32 * 32; idx += 256) {
            const int j = idx >> 5, d4 = idx & 31;
            const int il = c * 32 + j; const int t = dir ? (S_ - 1 - il) : il;
            const long row = (long)(b * S_ + t);
            const f32x4 qv = *(const f32x4*)(qk + row * 1024 + h * 128 + d4 * 4);
            const f32x4 kv = *(const f32x4*)(qk + row * 1024 + 512 + h * 128 + d4 * 4);
            const f32x4 lv = *(const f32x4*)(la + row * 512 + h * 128 + d4 * 4);
            *(f32x4*)&sq[j][d4 * 4] = qv; *(f32x4*)&sk[j][d4 * 4] = kv;
            *(f32x4*)&sa[j][d4 * 4] = (f32x4){expf(lv.x), expf(lv.y), expf(lv.z), expf(lv.w)};
        }
        {
            const int j = tid >> 3, e = tid & 7;
            const int il = c * 32 + j; const int t = dir ? (S_ - 1 - il) : il;
            sv[j][e] = v[(long)(b * S_ + t) * 1024 + h * 256 + e0 + e];
        }
        __syncthreads();
        for (int j = 0; j < 32; ++j) {
            const f32x4 a4 = *(const f32x4*)&sa[j][d0], k4 = *(const f32x4*)&sk[j][d0], q4 = *(const f32x4*)&sq[j][d0];
            const float vv = sv[j][el];
            float part;
            if (!dir) {
                S[0] = fmaf(a4.x, S[0], k4.x * vv); S[1] = fmaf(a4.y, S[1], k4.y * vv); S[2] = fmaf(a4.z, S[2], k4.z * vv); S[3] = fmaf(a4.w, S[3], k4.w * vv);
                part = q4.x * S[0] + q4.y * S[1] + q4.z * S[2] + q4.w * S[3];
            } else {
                S[0] *= a4.x; S[1] *= a4.y; S[2] *= a4.z; S[3] *= a4.w;
                part = q4.x * S[0] + q4.y * S[1] + q4.z * S[2] + q4.w * S[3];
                S[0] = fmaf(k4.x, vv, S[0]); S[1] = fmaf(k4.y, vv, S[1]); S[2] = fmaf(k4.z, vv, S[2]); S[3] = fmaf(k4.w, vv, S[3]);
            }
#pragma unroll
            for (int off = 1; off < 32; off <<= 1) part += __shfl_xor(part, off);
            if (dg == 0) so[j][el] = part * scale;
        }
        __syncthreads();
        {
            const int j = tid >> 3, e = tid & 7;
            const int il = c * 32 + j; const int t = dir ? (S_ - 1 - il) : il;
            float* op = o + (long)(b * S_ + t) * 1024 + h * 256 + e0 + e;
            if (dir) *op += so[j][e]; else *op = so[j][e];
        }
    }
}

__device__ __forceinline__ void gla_post_norm(const int bx, const int by, const int bz, float* o, const float* gain) {
    const int gw = bx * 4 + (threadIdx.x >> 6), lane = threadIdx.x & 63;
    const int h = gw & 3; const long t = gw >> 2;
    f32x4* p = (f32x4*)(o + t * 1024 + h * 256) + lane;
    f32x4 x = *p;
    const float s = wave_sum(x.x * x.x + x.y * x.y + x.z * x.z + x.w * x.w);
    const float r = 1.0f / sqrtf(s * (1.0f / 256.0f) + EPS);
    const f32x4 g = *((const f32x4*)(gain + h * 256) + lane);
    *p = x * r * g;
}
__device__ __forceinline__ void silu_mul(const int bx, const int by, const int bz, float* o, const float* gr, long n) {
    const long i = (long)bx * 256 + threadIdx.x;
    if (i >= n) return;
    const float g = gr[i];
    o[i] = o[i] * (g / (1.0f + expf(-g)));
}
__device__ __forceinline__ void swiglu(const int bx, const int by, const int bz, float* G, const float* U, long n) {
    const long i = (long)bx * 256 + threadIdx.x;
    if (i >= n) return;
    const float g = G[i];
    G[i] = (g / (1.0f + expf(-g))) * U[i];
}
__device__ __forceinline__ void softmax16(const int bx, const int by, const int bz, const float* logits, float* aff) {
    const int t = bx * 256 + threadIdx.x;
    if (t >= T_) return;
    float x[16], m = -INFINITY;
#pragma unroll
    for (int e = 0; e < 16; ++e) { x[e] = logits[t * 16 + e]; m = fmaxf(m, x[e]); }
    float s = 0.f;
#pragma unroll
    for (int e = 0; e < 16; ++e) { x[e] = expf(x[e] - m); s += x[e]; }
    const float r = 1.0f / s;
#pragma unroll
    for (int e = 0; e < 16; ++e) aff[t * 16 + e] = x[e] * r;
}
__device__ __forceinline__ void topk_rank(const int bx, const int by, const int bz, const float* aff, int* gidx) {
    __shared__ float sa[S_];
    const int e = by, b = bz;
    for (int s = threadIdx.x; s < S_; s += 256) sa[s] = aff[(long)(b * S_ + s) * 16 + e];
    __syncthreads();
    const int s = bx * 256 + threadIdx.x;
    const float a = sa[s];
    int rank = 0;
    for (int s2 = 0; s2 < S_; ++s2) { const float a2 = sa[s2]; rank += (a2 > a || (a2 == a && s2 < s)) ? 1 : 0; }
    if (rank < CAP) gidx[e * (B_ * CAP) + b * CAP + rank] = b * S_ + s;
}
__device__ __forceinline__ void scatter_add(const int bx, const int by, const int bz, float* h, const float* Y, const float* aff, const int* gidx, int e) {
    const int m = bx * 4 + (threadIdx.x >> 6), lane = threadIdx.x & 63;
    const int t = gidx[m];
    const float a = aff[t * 16 + e];
    f32x4* hp = (f32x4*)(h + (long)t * D_) + lane;
    const f32x4* yp = (const f32x4*)(Y + (long)m * D_) + lane;
#pragma unroll
    for (int j = 0; j < 4; ++j) hp[64 * j] += yp[64 * j] * a;
}
__device__ __forceinline__ void ple_add(const int bx, const int by, const int bz, float* h, const float* G, const float* P, long n) {
    const long i = (long)bx * 256 + threadIdx.x;
    if (i >= n) return;
    h[i] += P[i] / (1.0f + expf(-G[i]));
}


struct Params {
    const float *x, *p; const int* pos; const float *norm_mix, *w_in, *up_f, *bias_f, *up_b, *bias_b, *sink, *gla_norm, *w_ba, *w_bg, *w_out,
        *norm_ffn, *w_router, *w_eg, *w_eu, *w_ed, *norm_ple, *w_pg, *w_ple, *norm_final;
    float* out; char* ws;
};

#define PHASE(NBX, NBY, NBZ, CALL) do { const int nbx_ = (NBX), nby_ = (NBY), nbz_ = (NBZ); \
    for (int vb_ = blockIdx.x; vb_ < nbx_ * nby_ * nbz_; vb_ += gridDim.x) { const int bx = vb_ % nbx_, by = (vb_ / nbx_) % nby_, bz = vb_ / (nbx_ * nby_); CALL; __syncthreads(); } \
    grid.sync(); } while (0)
#define GEMM(A, lda, gidx, Bm, ldb, C, ldc, R, ldr, M, N, K) PHASE(((N) + 127) / 128, (M) / 128, 1, gemm_f32(bx, by, bz, A, lda, gidx, Bm, ldb, C, ldc, R, ldr, M, N, K))

__global__ void __launch_bounds__(256) mega(Params P) {
    cg::grid_group grid = cg::this_grid();
    const size_t U = (size_t)T_ * D_ * 4;
    char* ws = P.ws;
    float* R0 = (float*)(ws); float* R1 = (float*)(ws + U); float* R2 = (float*)(ws + 2 * U); float* R3 = (float*)(ws + 3 * U); float* R4 = (float*)(ws + 4 * U);
    float* out = P.out;
    const long NTD = (long)T_ * D_;
    const int EB = (int)((NTD + 255) / 256);
    const float* nullf = nullptr; const int* nulli = nullptr;
    PHASE(T_ / 4, 1, 1, rmsnorm_rows(bx, by, bz, P.x, P.norm_mix, R0, T_));
    GEMM(R0, D_, nulli, P.w_in + C_Q, IN_DIM, R1, 768, nullf, 0, T_, 768, D_);
    PHASE(T_ * 80 / 256, 1, 1, rope_kernel(bx, by, bz, R1, P.pos));
    PHASE(T_ / 256, 8, 1, attn_naive(bx, by, bz, R1, P.sink, R2));
    GEMM(R2, 512, nulli, P.w_ba, D_, R3, D_, nullf, 0, T_, D_, 512);
    GEMM(R0, D_, nulli, P.w_in + C_GATT, IN_DIM, R1, D_, nullf, 0, T_, D_, D_);
    PHASE(EB, 1, 1, gate_mul(bx, by, bz, R1, R3, R3, NTD, 0));
    GEMM(R0, D_, nulli, P.w_in + C_GQ, IN_DIM, R1, D_, nullf, 0, T_, 1024, D_);
    GEMM(R0, D_, nulli, P.w_in + C_GV, IN_DIM, R2, D_, nullf, 0, T_, 1024, D_);
    GEMM(R0, D_, nulli, P.w_in + C_ZF, IN_DIM, R4, 32, nullf, 0, T_, 32, D_);
    float* la_f = out; float* la_b = out + (size_t)T_ * 512;
    PHASE(T_ * 512 / 256, 1, 1, gla_gate(bx, by, bz, R4, 0, P.up_f, P.bias_f, la_f));
    PHASE(T_ * 512 / 256, 1, 1, gla_gate(bx, by, bz, R4, 16, P.up_b, P.bias_b, la_b));
    PHASE(32, 4, 4, gla_recur(bx, by, bz, R1, R2, la_f, R0, 0));
    PHASE(32, 4, 4, gla_recur(bx, by, bz, R1, R2, la_b, R0, 1));
    PHASE(T_, 1, 1, gla_post_norm(bx, by, bz, R0, P.gla_norm));
    PHASE(T_ / 4, 1, 1, rmsnorm_rows(bx, by, bz, P.x, P.norm_mix, R1, T_));
    GEMM(R1, D_, nulli, P.w_in + C_GR, IN_DIM, R2, D_, nullf, 0, T_, D_, D_);
    PHASE(EB, 1, 1, silu_mul(bx, by, bz, R0, R2, NTD));
    GEMM(R0, D_, nulli, P.w_bg, D_, R2, D_, nullf, 0, T_, D_, D_);
    GEMM(R1, D_, nulli, P.w_in + C_GGLA, IN_DIM, out, D_, nullf, 0, T_, D_, D_);
    PHASE(EB, 1, 1, gate_mul(bx, by, bz, out, R2, R3, NTD, 1));
    GEMM(R3, D_, nulli, P.w_out, D_, R0, D_, P.x, D_, T_, D_, D_);
    PHASE(T_ / 4, 1, 1, rmsnorm_rows(bx, by, bz, R0, P.norm_ffn, R1, T_));
    float* logits = R4; float* aff = R4 + (size_t)T_ * 16; int* gidx = (int*)(R4 + (size_t)T_ * 32);
    GEMM(R1, D_, nulli, P.w_router, NE, logits, NE, nullf, 0, T_, NE, D_);
    PHASE(T_ / 256, 1, 1, softmax16(bx, by, bz, logits, aff));
    PHASE(S_ / 256, NE, B_, topk_rank(bx, by, bz, aff, gidx));
    const int ME = B_ * CAP;
    float* Gb = R2; float* Ub = R2 + (size_t)ME * FF; float* Yb = R2 + 2 * (size_t)ME * FF;
    for (int e = 0; e < NE; ++e) {
        const size_t wo = (size_t)e * D_ * FF;
        GEMM(R1, D_, gidx + e * ME, P.w_eg + wo, FF, Gb, FF, nullf, 0, ME, FF, D_);
        GEMM(R1, D_, gidx + e * ME, P.w_eu + wo, FF, Ub, FF, nullf, 0, ME, FF, D_);
        PHASE(ME * FF / 256, 1, 1, swiglu(bx, by, bz, Gb, Ub, (long)ME * FF));
        GEMM(Gb, FF, nulli, P.w_ed + wo, D_, Yb, D_, nullf, 0, ME, D_, FF);
        PHASE(ME / 4, 1, 1, scatter_add(bx, by, bz, R0, Yb, aff, gidx + e * ME, e));
    }
    PHASE(T_ / 4, 1, 1, rmsnorm_rows(bx, by, bz, R0, P.norm_ple, R1, T_));
    GEMM(R1, D_, nulli, P.w_pg, D_, R2, D_, nullf, 0, T_, D_, D_);
    GEMM(P.p, PLE, nulli, P.w_ple, D_, R3, D_, nullf, 0, T_, D_, PLE);
    PHASE(EB, 1, 1, ple_add(bx, by, bz, R0, R2, R3, NTD));
    PHASE(T_ / 4, 1, 1, rmsnorm_rows(bx, by, bz, R0, P.norm_final, out, T_));
}

extern "C" void kernel_launch(void* const* d_in, const int* in_sizes, int n_in, void* d_out, int out_size, void* d_ws, size_t ws_size, hipStream_t stream) {
    static int grid_blocks = 0;
    if (!grid_blocks) {
        int dev = 0, cus = 0, per_cu = 0;
        hipGetDevice(&dev);
        hipDeviceGetAttribute(&cus, hipDeviceAttributeMultiprocessorCount, dev);
        hipOccupancyMaxActiveBlocksPerMultiprocessor(&per_cu, mega, 256, 0);
        if (per_cu > 1) per_cu = 1;
        if (per_cu < 1) per_cu = 1;
        grid_blocks = cus * per_cu;
    }
    Params P{};
    P.x = (const float*)d_in[0]; P.p = (const float*)d_in[1]; P.pos = (const int*)d_in[2]; P.norm_mix = (const float*)d_in[3]; P.w_in = (const float*)d_in[4];
    P.up_f = (const float*)d_in[5]; P.bias_f = (const float*)d_in[6]; P.up_b = (const float*)d_in[7]; P.bias_b = (const float*)d_in[8]; P.sink = (const float*)d_in[9];
    P.gla_norm = (const float*)d_in[10]; P.w_ba = (const float*)d_in[11]; P.w_bg = (const float*)d_in[12]; P.w_out = (const float*)d_in[13]; P.norm_ffn = (const float*)d_in[14];
    P.w_router = (const float*)d_in[15]; P.w_eg = (const float*)d_in[16]; P.w_eu = (const float*)d_in[17]; P.w_ed = (const float*)d_in[18]; P.norm_ple = (const float*)d_in[19];
    P.w_pg = (const float*)d_in[20]; P.w_ple = (const float*)d_in[21]; P.norm_final = (const float*)d_in[22];
    P.out = (float*)d_out; P.ws = (char*)d_ws;
    void* args[] = {&P};
    hipError_t e = hipLaunchCooperativeKernel((void*)mega, dim3(grid_blocks), dim3(256), args, 0, stream);
    if (e != hipSuccess) fprintf(stderr, "cooperative launch failed: %s (grid %d)\n", hipGetErrorString(e), grid_blocks);
}
```

```cpp
#include <hip/hip_runtime.h>
#include <cstdio>
#include <cstdint>

constexpr int B_ = 4, S_ = 4096, D_ = 1024, T_ = B_ * S_;
constexpr int IN_DIM = 5920;
constexpr int C_Q = 0, C_K = 512, C_V = 640, C_GQ = 768, C_GK = 1280, C_GV = 1792, C_GR = 2816, C_ZF = 3840, C_ZB = 3856, C_GATT = 3872, C_GGLA = 4896;
constexpr int NE = 16, CAP = 512, FF = 1024, PLE = 256, ME = B_ * CAP;
constexpr float EPS = 1e-6f;
constexpr float LOG2E = 1.4426950408889634f;
constexpr float QSCALE = 0.125f * LOG2E;
constexpr float GQSCALE = 0.08838834764831845f;

typedef float f32x4 __attribute__((ext_vector_type(4)));
typedef float f32x2 __attribute__((ext_vector_type(2)));
typedef unsigned short bf16;
typedef unsigned u32x4 __attribute__((ext_vector_type(4)));
typedef unsigned u32x2 __attribute__((ext_vector_type(2)));

constexpr size_t MiB = 1u << 20;
constexpr size_t WS_CTL = 0, WS_ROPE = 1 * MiB, WS_AFF = 2 * MiB, WS_INV = 3 * MiB, WS_GIDX = 4 * MiB, WS_Z = 5 * MiB;
constexpr size_t WS_WIN = 8 * MiB, WS_WA = 20 * MiB, WS_WB = 21 * MiB, WS_WO = 23 * MiB, WS_WPG = 25 * MiB, WS_WPLE = 27 * MiB;
constexpr size_t WS_A0 = 28 * MiB;
constexpr size_t WS_QKV = 60 * MiB;
constexpr size_t WS_GQK = 84 * MiB;
constexpr size_t WS_GV = 116 * MiB;
constexpr size_t WS_GR = 148 * MiB;
constexpr size_t WS_GATT = 180 * MiB;
constexpr size_t WS_GGLA = 212 * MiB;
constexpr size_t WS_OB = 244 * MiB;
constexpr size_t WS_ATT = 276 * MiB;
constexpr size_t WS_OF = WS_A0, WS_XN = WS_A0, WS_XN3 = WS_A0, WS_GLAO = WS_GQK, WS_MERGED = WS_GV, WS_H = WS_GR, WS_HID = WS_QKV, WS_PLET = WS_QKV;
constexpr size_t WS_WEG = 212 * MiB, WS_WEU = 244 * MiB, WS_WED = 276 * MiB, WS_END = 308 * MiB;

__device__ __forceinline__ unsigned f2bf(float f) { unsigned u = __builtin_bit_cast(unsigned, f); return (u + 0x7fffu + ((u >> 16) & 1u)) >> 16; }
__device__ __forceinline__ float bf2f(unsigned h) { return __builtin_bit_cast(float, h << 16); }
__device__ __forceinline__ unsigned pk2(float lo, float hi) { return f2bf(lo) | (f2bf(hi) << 16); }
__device__ __forceinline__ float sigmoidf_(float x) { return 1.0f / (1.0f + __expf(-x)); }
__device__ __forceinline__ float wave_sum(float v) {
#pragma unroll
    for (int o = 1; o < 64; o <<= 1) v += __shfl_xor(v, o);
    return v;
}

struct Params {
    const float *x, *p; const int* pos; const float *norm_mix, *w_in, *up_f, *bias_f, *up_b, *bias_b, *sink, *gla_norm, *w_ba, *w_bg, *w_out,
        *norm_ffn, *w_router, *w_eg, *w_eu, *w_ed, *norm_ple, *w_pg, *w_ple, *norm_final;
    float* out; char* ws;
};
namespace nv {

template <bool ABF, class Epi>
__global__ void __launch_bounds__(256) gemm(const void* Av, int lda, const int* gidx, const float* Bm, int ldb, int M, int N, int K, Epi E) {
    __shared__ float As[8][128 + 4];
    __shared__ float Bs[8][128 + 4];
    const int tid = threadIdx.x, tx = tid & 15, ty = tid >> 4;
    const int m0 = blockIdx.y * 128, n0 = blockIdx.x * 128;
    float acc[8][8];
#pragma unroll
    for (int i = 0; i < 8; ++i)
#pragma unroll
        for (int j = 0; j < 8; ++j) acc[i][j] = 0.f;
    const int arow_l = tid >> 1, akoff = (tid & 1) * 4;
    const int am = m0 + arow_l;
    const long arow = gidx ? (long)gidx[am] : (long)am;
    const int bk = tid >> 5, bn = (tid & 31) * 4;
    const bool bok = (n0 + bn) < N;
    const float* Bp = Bm + (long)bk * ldb + n0 + bn;
    for (int k0 = 0; k0 < K; k0 += 8) {
        f32x4 av;
        if (ABF) { const u32x2 r = *(const u32x2*)((const bf16*)Av + arow * lda + akoff + k0); av = (f32x4){bf2f(r.x & 0xffffu), bf2f(r.x >> 16), bf2f(r.y & 0xffffu), bf2f(r.y >> 16)}; }
        else av = *(const f32x4*)((const float*)Av + arow * lda + akoff + k0);
        f32x4 bv = (f32x4){0.f, 0.f, 0.f, 0.f};
        if (bok) bv = *(const f32x4*)(Bp + (long)k0 * ldb);
        __syncthreads();
        As[akoff + 0][arow_l] = av.x; As[akoff + 1][arow_l] = av.y; As[akoff + 2][arow_l] = av.z; As[akoff + 3][arow_l] = av.w;
        *(f32x4*)&Bs[bk][bn] = bv;
        __syncthreads();
#pragma unroll
        for (int kk = 0; kk < 8; ++kk) {
            float a[8], b[8];
            const f32x4 a0 = *(const f32x4*)&As[kk][ty * 4], a1 = *(const f32x4*)&As[kk][64 + ty * 4];
            const f32x4 b0 = *(const f32x4*)&Bs[kk][tx * 4], b1 = *(const f32x4*)&Bs[kk][64 + tx * 4];
            a[0] = a0.x; a[1] = a0.y; a[2] = a0.z; a[3] = a0.w; a[4] = a1.x; a[5] = a1.y; a[6] = a1.z; a[7] = a1.w;
            b[0] = b0.x; b[1] = b0.y; b[2] = b0.z; b[3] = b0.w; b[4] = b1.x; b[5] = b1.y; b[6] = b1.z; b[7] = b1.w;
#pragma unroll
            for (int i = 0; i < 8; ++i)
#pragma unroll
                for (int j = 0; j < 8; ++j) acc[i][j] = fmaf(a[i], b[j], acc[i][j]);
        }
    }
#pragma unroll
    for (int i = 0; i < 8; ++i) {
        const int m = m0 + (i < 4 ? ty * 4 + i : 64 + ty * 4 + (i - 4));
#pragma unroll
        for (int jh = 0; jh < 2; ++jh) {
            const int n = n0 + jh * 64 + tx * 4;
            if (n < N) E(m, n, (f32x4){acc[i][jh * 4 + 0], acc[i][jh * 4 + 1], acc[i][jh * 4 + 2], acc[i][jh * 4 + 3]});
        }
    }
}
template <bool ABF, class Epi>
static void launch_gemm(hipStream_t st, const void* A, int lda, const int* gidx, const float* Bm, int ldb, int M, int N, int K, Epi E) {
    hipLaunchKernelGGL((gemm<ABF, Epi>), dim3((N + 127) / 128, M / 128), dim3(256), 0, st, A, lda, gidx, Bm, ldb, M, N, K, E);
}
__device__ __forceinline__ void st_bf4(bf16* p, f32x4 v) { *(u32x2*)p = (u32x2){pk2(v.x, v.y), pk2(v.z, v.w)}; }
__device__ __forceinline__ f32x4 ld_bf4(const bf16* p) { const u32x2 r = *(const u32x2*)p; return (f32x4){bf2f(r.x & 0xffffu), bf2f(r.x >> 16), bf2f(r.y & 0xffffu), bf2f(r.y >> 16)}; }

struct EpiF32 { float* C; int ldc; int pad; __device__ void operator()(int m, int n, f32x4 v) const { *(f32x4*)(C + (long)m * ldc + n) = v; } };
struct EpiBf { bf16* C; int ldc; float scale; int scale_cols; int pad; __device__ void operator()(int m, int n, f32x4 v) const { if (n < scale_cols) v = v * scale; st_bf4(C + (long)m * ldc + n, v); } };
struct EpiGate1 { const bf16* G; float* C; __device__ void operator()(int m, int n, f32x4 v) const { const f32x4 g = ld_bf4(G + (long)m * D_ + n);
    *(f32x4*)(C + (long)m * D_ + n) = (f32x4){sigmoidf_(g.x) * v.x, sigmoidf_(g.y) * v.y, sigmoidf_(g.z) * v.z, sigmoidf_(g.w) * v.w}; } };
struct EpiGate2 { const bf16* G; const float* Tm; bf16* C; __device__ void operator()(int m, int n, f32x4 v) const { const f32x4 g = ld_bf4(G + (long)m * D_ + n); const f32x4 t = *(const f32x4*)(Tm + (long)m * D_ + n);
    st_bf4(C + (long)m * D_ + n, (f32x4){t.x + sigmoidf_(g.x) * v.x, t.y + sigmoidf_(g.y) * v.y, t.z + sigmoidf_(g.z) * v.z, t.w + sigmoidf_(g.w) * v.w}); } };
struct EpiResid { const float* R; float* C; __device__ void operator()(int m, int n, f32x4 v) const { *(f32x4*)(C + (long)m * D_ + n) = *(const f32x4*)(R + (long)m * D_ + n) + v; } };
struct EpiSwiglu { const float* G; bf16* C; __device__ void operator()(int m, int n, f32x4 v) const { const f32x4 g = *(const f32x4*)(G + (long)m * FF + n);
    st_bf4(C + (long)m * FF + n, (f32x4){g.x * sigmoidf_(g.x) * v.x, g.y * sigmoidf_(g.y) * v.y, g.z * sigmoidf_(g.z) * v.z, g.w * sigmoidf_(g.w) * v.w}); } };
struct EpiRowScale { const float* aff; const int* gidx; bf16* C; int e; int pad; __device__ void operator()(int m, int n, f32x4 v) const { const float a = aff[gidx[m] * NE + e]; st_bf4(C + (long)m * D_ + n, v * a); } };
struct EpiPle { const float* Pt; float* Hh; __device__ void operator()(int m, int n, f32x4 v) const { const f32x4 t = *(const f32x4*)(Pt + (long)m * D_ + n); f32x4 h = *(const f32x4*)(Hh + (long)m * D_ + n);
    h += (f32x4){sigmoidf_(v.x) * t.x, sigmoidf_(v.y) * t.y, sigmoidf_(v.z) * t.z, sigmoidf_(v.w) * t.w}; *(f32x4*)(Hh + (long)m * D_ + n) = h; } };

template <bool OBF>
__global__ void __launch_bounds__(256) rmsnorm_rows(const float* X, const float* g, void* Y) {
    const int row = blockIdx.x * 4 + (threadIdx.x >> 6), lane = threadIdx.x & 63;
    const f32x4* xr = (const f32x4*)(X + (long)row * D_) + lane;
    f32x4 v[4]; float s = 0.f;
#pragma unroll
    for (int j = 0; j < 4; ++j) { v[j] = xr[64 * j]; s += v[j].x * v[j].x + v[j].y * v[j].y + v[j].z * v[j].z + v[j].w * v[j].w; }
    const float r = 1.0f / sqrtf(wave_sum(s) * (1.0f / D_) + EPS);
    const f32x4* gr = (const f32x4*)g + lane;
#pragma unroll
    for (int j = 0; j < 4; ++j) { const f32x4 y = v[j] * r * gr[64 * j];
        if (OBF) st_bf4((bf16*)Y + (long)row * D_ + 4 * (lane + 64 * j), y); else *((f32x4*)((float*)Y + (long)row * D_) + lane + 64 * j) = y; }
}
__global__ void __launch_bounds__(256) rope_table(const int* pos, float* RT) {
    const int gid = blockIdx.x * 256 + threadIdx.x; if (gid >= T_ * 8) return;
    const int i = gid & 7, t = gid >> 3;
    const float invf[8] = {1.0f, 0.1939227432012558f, 0.03760603070259094f, 0.007292664609849453f, 0.0014142135623842478f, 0.00027424818836152554f, 5.3182957344688475e-05f, 1.0313385246263351e-05f};
    const float ang = (float)pos[t] * invf[i];
    RT[t * 16 + i] = cosf(ang); RT[t * 16 + 8 + i] = sinf(ang);
}
__global__ void __launch_bounds__(256) rope_cvt(const float* qkv, const float* RT, bf16* O) {
    const long gid = (long)blockIdx.x * 256 + threadIdx.x; if (gid >= (long)T_ * 768) return;
    const int c = gid % 768; const long t = gid / 768;
    float v = qkv[gid];
    if (c < 640) { const int dd = c & 63; if (dd < 16) { const int i = dd & 7; const float cs = RT[t * 16 + i], sn = RT[t * 16 + 8 + i];
            if (dd < 8) v = v * cs - qkv[gid + 8] * sn; else v = v * cs + qkv[gid - 8] * sn; } }
    if (c < 512) v *= QSCALE;
    O[gid] = (bf16)f2bf(v);
}
__global__ void __launch_bounds__(256) attn(const bf16* qkv, const float* sink, bf16* out) {
    const int h = blockIdx.y, t = blockIdx.x * 256 + threadIdx.x;
    const int b = t / S_, i = t % S_, kvh = h >> 2;
    float q[64];
    const bf16* qp = qkv + (long)t * 768 + h * 64;
#pragma unroll
    for (int d = 0; d < 64; ++d) q[d] = bf2f(qp[d]);
    const int j0 = max(0, i - 128), j1 = min(S_ - 1, i + 128);
    const float sk = sink[h] * LOG2E;
    float m = sk;
    for (int j = j0; j <= j1; ++j) {
        const bf16* kp = qkv + (long)(b * S_ + j) * 768 + 512 + kvh * 64;
        float s = 0.f;
#pragma unroll
        for (int d = 0; d < 64; ++d) s = fmaf(q[d], bf2f(kp[d]), s);
        m = fmaxf(m, s);
    }
    float o[64];
#pragma unroll
    for (int d = 0; d < 64; ++d) o[d] = 0.f;
    float l = exp2f(sk - m);
    for (int j = j0; j <= j1; ++j) {
        const bf16* kp = qkv + (long)(b * S_ + j) * 768 + 512 + kvh * 64;
        const bf16* vp = kp + 128;
        float s = 0.f;
#pragma unroll
        for (int d = 0; d < 64; ++d) s = fmaf(q[d], bf2f(kp[d]), s);
        const float p = exp2f(s - m);
        l += p;
#pragma unroll
        for (int d = 0; d < 64; ++d) o[d] = fmaf(p, bf2f(vp[d]), o[d]);
    }
    const float rl = 1.0f / l;
    bf16* op = out + (long)t * 512 + h * 64;
#pragma unroll
    for (int d = 0; d < 64; ++d) op[d] = (bf16)f2bf(o[d] * rl);
}
__global__ void __launch_bounds__(256) gla_recur(const bf16* qk, const bf16* v, const float* z, const float* up, const float* bias, bf16* o, int dir) {
    __shared__ float sq[32][128], sk[32][128], sa[32][128];
    __shared__ float sv[32][8], so[32][8];
    const int tid = threadIdx.x, w = tid >> 6, lane = tid & 63;
    const int es = blockIdx.x, h = blockIdx.y, b = blockIdx.z, e0 = es * 8;
    const int el = w * 2 + (lane >> 5), dg = lane & 31, d0 = dg * 4;
    float S[4] = {0.f, 0.f, 0.f, 0.f};
    for (int c = 0; c < S_ / 32; ++c) {
        __syncthreads();
        for (int idx = tid; idx < 32 * 128; idx += 256) {
            const int j = idx >> 7, d = idx & 127;
            const int il = c * 32 + j; const int t = dir ? (S_ - 1 - il) : il;
            const long row = (long)(b * S_ + t);
            sq[j][d] = bf2f(qk[row * 1024 + h * 128 + d]); sk[j][d] = bf2f(qk[row * 1024 + 512 + h * 128 + d]);
            float x = bias[h * 128 + d];
#pragma unroll
            for (int r = 0; r < 16; ++r) x = fmaf(z[row * 32 + dir * 16 + r], up[r * 512 + h * 128 + d], x);
            const float ls = fminf(x, 0.f) - log1pf(expf(-fabsf(x)));
            sa[j][d] = expf(ls * (1.0f / 16.0f));
        }
        {
            const int j = tid >> 3, e = tid & 7;
            const int il = c * 32 + j; const int t = dir ? (S_ - 1 - il) : il;
            sv[j][e] = bf2f(v[(long)(b * S_ + t) * 1024 + h * 256 + e0 + e]);
        }
        __syncthreads();
        for (int j = 0; j < 32; ++j) {
            const f32x4 a4 = *(const f32x4*)&sa[j][d0], k4 = *(const f32x4*)&sk[j][d0], q4 = *(const f32x4*)&sq[j][d0];
            const float vv = sv[j][el];
            float part;
            if (!dir) {
                S[0] = fmaf(a4.x, S[0], k4.x * vv); S[1] = fmaf(a4.y, S[1], k4.y * vv); S[2] = fmaf(a4.z, S[2], k4.z * vv); S[3] = fmaf(a4.w, S[3], k4.w * vv);
                part = q4.x * S[0] + q4.y * S[1] + q4.z * S[2] + q4.w * S[3];
            } else {
                S[0] *= a4.x; S[1] *= a4.y; S[2] *= a4.z; S[3] *= a4.w;
                part = q4.x * S[0] + q4.y * S[1] + q4.z * S[2] + q4.w * S[3];
                S[0] = fmaf(k4.x, vv, S[0]); S[1] = fmaf(k4.y, vv, S[1]); S[2] = fmaf(k4.z, vv, S[2]); S[3] = fmaf(k4.w, vv, S[3]);
            }
#pragma unroll
            for (int off = 1; off < 32; off <<= 1) part += __shfl_xor(part, off);
            if (dg == 0) so[j][el] = part;
        }
        __syncthreads();
        {
            const int j = tid >> 3, e = tid & 7;
            const int il = c * 32 + j; const int t = dir ? (S_ - 1 - il) : il;
            o[(long)(b * S_ + t) * 1024 + h * 256 + e0 + e] = (bf16)f2bf(so[j][e]);
        }
    }
}
__global__ void __launch_bounds__(256) gla_post(const bf16* OF, const bf16* OB, const bf16* GR, const float* gain, bf16* GLAO) {
    const int gw = blockIdx.x * 4 + (threadIdx.x >> 6), lane = threadIdx.x & 63;
    const int h = gw & 3; const long t = gw >> 2; const long off = t * 1024 + h * 256 + lane * 4;
    const f32x4 x = ld_bf4(OF + off) + ld_bf4(OB + off);
    const float s = wave_sum(x.x * x.x + x.y * x.y + x.z * x.z + x.w * x.w);
    const float r = 1.0f / sqrtf(s * (1.0f / 256.0f) + EPS);
    const f32x4 g = *(const f32x4*)(gain + h * 256 + lane * 4); const f32x4 gr = ld_bf4(GR + off);
    st_bf4(GLAO + off, (f32x4){x.x * r * g.x * gr.x * sigmoidf_(gr.x), x.y * r * g.y * gr.y * sigmoidf_(gr.y), x.z * r * g.z * gr.z * sigmoidf_(gr.z), x.w * r * g.w * gr.w * sigmoidf_(gr.w)});
}
__global__ void __launch_bounds__(256) norm_router(const float* H, const float* g, const float* wr, bf16* XN, float* aff) {
    const int row = blockIdx.x * 4 + (threadIdx.x >> 6), lane = threadIdx.x & 63;
    const f32x4* xr = (const f32x4*)(H + (long)row * D_) + lane;
    f32x4 v[4]; float s = 0.f;
#pragma unroll
    for (int j = 0; j < 4; ++j) { v[j] = xr[64 * j]; s += v[j].x * v[j].x + v[j].y * v[j].y + v[j].z * v[j].z + v[j].w * v[j].w; }
    const float r = 1.0f / sqrtf(wave_sum(s) * (1.0f / D_) + EPS);
    float lg[16];
#pragma unroll
    for (int e = 0; e < 16; ++e) lg[e] = 0.f;
#pragma unroll
    for (int j = 0; j < 4; ++j) { const f32x4 y = v[j] * r * ((const f32x4*)g)[lane + 64 * j]; st_bf4(XN + (long)row * D_ + 4 * (lane + 64 * j), y);
        const int k = 4 * (lane + 64 * j);
#pragma unroll
        for (int e = 0; e < 16; ++e) lg[e] += y.x * wr[(k + 0) * 16 + e] + y.y * wr[(k + 1) * 16 + e] + y.z * wr[(k + 2) * 16 + e] + y.w * wr[(k + 3) * 16 + e]; }
    float m = -INFINITY;
#pragma unroll
    for (int e = 0; e < 16; ++e) { lg[e] = wave_sum(lg[e]); m = fmaxf(m, lg[e]); }
    float sum = 0.f;
#pragma unroll
    for (int e = 0; e < 16; ++e) { lg[e] = expf(lg[e] - m); sum += lg[e]; }
    if (lane < 16) { float val = 0.f;
#pragma unroll
        for (int e = 0; e < 16; ++e) if (lane == e) val = lg[e];
        aff[row * 16 + lane] = val / sum; }
}
__global__ void __launch_bounds__(256) topk_rank(const float* aff, int* gidx, int* inv) {
    __shared__ float sa[S_];
    const int e = blockIdx.y, b = blockIdx.z;
    for (int s = threadIdx.x; s < S_; s += 256) sa[s] = aff[(long)(b * S_ + s) * 16 + e];
    __syncthreads();
    const int s = blockIdx.x * 256 + threadIdx.x;
    const float a = sa[s];
    int rank = 0;
    for (int s2 = 0; s2 < S_; ++s2) { const float a2 = sa[s2]; rank += (a2 > a || (a2 == a && s2 < s)) ? 1 : 0; }
    if (rank < CAP) gidx[e * ME + b * CAP + rank] = b * S_ + s;
    inv[(b * S_ + s) * 16 + e] = rank < CAP ? b * CAP + rank : -1;
}
__global__ void __launch_bounds__(256) combine_norm(float* H, const bf16* Y, const int* inv, const float* g, bf16* XN3) {
    const int row = blockIdx.x * 4 + (threadIdx.x >> 6), lane = threadIdx.x & 63;
    f32x4* xr = (f32x4*)(H + (long)row * D_) + lane;
    f32x4 v[4];
#pragma unroll
    for (int j = 0; j < 4; ++j) v[j] = xr[64 * j];
    for (int e = 0; e < 16; ++e) { const int sl = inv[row * 16 + e]; if (sl >= 0) { const bf16* yp = Y + ((long)e * ME + sl) * D_;
#pragma unroll
            for (int j = 0; j < 4; ++j) v[j] += ld_bf4(yp + 4 * (lane + 64 * j)); } }
    float s = 0.f;
#pragma unroll
    for (int j = 0; j < 4; ++j) { xr[64 * j] = v[j]; s += v[j].x * v[j].x + v[j].y * v[j].y + v[j].z * v[j].z + v[j].w * v[j].w; }
    const float r = 1.0f / sqrtf(wave_sum(s) * (1.0f / D_) + EPS);
#pragma unroll
    for (int j = 0; j < 4; ++j) st_bf4(XN3 + (long)row * D_ + 4 * (lane + 64 * j), v[j] * r * ((const f32x4*)g)[lane + 64 * j]);
}

static void P0(hipStream_t st, const Params& P) {
    hipLaunchKernelGGL(rmsnorm_rows<true>, dim3(T_ / 4), dim3(256), 0, st, P.x, P.norm_mix, (void*)(P.ws + WS_A0));
    hipLaunchKernelGGL(rope_table, dim3(T_ * 8 / 256), dim3(256), 0, st, P.pos, (float*)(P.ws + WS_ROPE));
}
static void P1(hipStream_t st, const Params& P) {
    const bf16* A0 = (const bf16*)(P.ws + WS_A0);
    launch_gemm<true>(st, A0, D_, nullptr, P.w_in + C_Q, IN_DIM, T_, 768, D_, EpiF32{P.out, 768, 0});
    hipLaunchKernelGGL(rope_cvt, dim3(T_ * 768 / 256), dim3(256), 0, st, P.out, (const float*)(P.ws + WS_ROPE), (bf16*)(P.ws + WS_QKV));
    launch_gemm<true>(st, A0, D_, nullptr, P.w_in + C_GQ, IN_DIM, T_, 1024, D_, EpiBf{(bf16*)(P.ws + WS_GQK), D_, GQSCALE, 512, 0});
    launch_gemm<true>(st, A0, D_, nullptr, P.w_in + C_GV, IN_DIM, T_, 1024, D_, EpiBf{(bf16*)(P.ws + WS_GV), D_, 1.f, 0, 0});
    launch_gemm<true>(st, A0, D_, nullptr, P.w_in + C_GR, IN_DIM, T_, 1024, D_, EpiBf{(bf16*)(P.ws + WS_GR), D_, 1.f, 0, 0});
    launch_gemm<true>(st, A0, D_, nullptr, P.w_in + C_GATT, IN_DIM, T_, 1024, D_, EpiBf{(bf16*)(P.ws + WS_GATT), D_, 1.f, 0, 0});
    launch_gemm<true>(st, A0, D_, nullptr, P.w_in + C_GGLA, IN_DIM, T_, 1024, D_, EpiBf{(bf16*)(P.ws + WS_GGLA), D_, 1.f, 0, 0});
    launch_gemm<true>(st, A0, D_, nullptr, P.w_in + C_ZF, IN_DIM, T_, 32, D_, EpiF32{(float*)(P.ws + WS_Z), 32, 0});
}
static void P2_attn(hipStream_t st, const Params& P) {
    hipLaunchKernelGGL(attn, dim3(T_ / 256, 8), dim3(256), 0, st, (const bf16*)(P.ws + WS_QKV), P.sink, (bf16*)(P.ws + WS_ATT));
}
static void P2_gla(hipStream_t st, const Params& P) {
    hipLaunchKernelGGL(gla_recur, dim3(32, 4, 4), dim3(256), 0, st, (const bf16*)(P.ws + WS_GQK), (const bf16*)(P.ws + WS_GV), (const float*)(P.ws + WS_Z), P.up_f, P.bias_f, (bf16*)(P.ws + WS_OF), 0);
    hipLaunchKernelGGL(gla_recur, dim3(32, 4, 4), dim3(256), 0, st, (const bf16*)(P.ws + WS_GQK), (const bf16*)(P.ws + WS_GV), (const float*)(P.ws + WS_Z), P.up_b, P.bias_b, (bf16*)(P.ws + WS_OB), 1);
}
static void P3(hipStream_t st, const Params& P) {
    hipLaunchKernelGGL(gla_post, dim3(T_), dim3(256), 0, st, (const bf16*)(P.ws + WS_OF), (const bf16*)(P.ws + WS_OB), (const bf16*)(P.ws + WS_GR), P.gla_norm, (bf16*)(P.ws + WS_GLAO));
    launch_gemm<true>(st, P.ws + WS_ATT, 512, nullptr, P.w_ba, D_, T_, D_, 512, EpiGate1{(const bf16*)(P.ws + WS_GATT), P.out});
    launch_gemm<true>(st, P.ws + WS_GLAO, D_, nullptr, P.w_bg, D_, T_, D_, D_, EpiGate2{(const bf16*)(P.ws + WS_GGLA), P.out, (bf16*)(P.ws + WS_MERGED)});
}
static void P4(hipStream_t st, const Params& P) {
    launch_gemm<true>(st, P.ws + WS_MERGED, D_, nullptr, P.w_out, D_, T_, D_, D_, EpiResid{P.x, (float*)(P.ws + WS_H)});
    hipLaunchKernelGGL(norm_router, dim3(T_ / 4), dim3(256), 0, st, (const float*)(P.ws + WS_H), P.norm_ffn, P.w_router, (bf16*)(P.ws + WS_XN), (float*)(P.ws + WS_AFF));
}
static void P5(hipStream_t st, const Params& P) {
    hipLaunchKernelGGL(topk_rank, dim3(S_ / 256, NE, B_), dim3(256), 0, st, (const float*)(P.ws + WS_AFF), (int*)(P.ws + WS_GIDX), (int*)(P.ws + WS_INV));
}
static void P6(hipStream_t st, const Params& P) {
    for (int e = 0; e < NE; ++e) { const size_t wo = (size_t)e * D_ * FF; const int* gi = (const int*)(P.ws + WS_GIDX) + e * ME;
        launch_gemm<true>(st, P.ws + WS_XN, D_, gi, P.w_eg + wo, FF, ME, FF, D_, EpiF32{P.out, FF, 0});
        launch_gemm<true>(st, P.ws + WS_XN, D_, gi, P.w_eu + wo, FF, ME, FF, D_, EpiSwiglu{P.out, (bf16*)(P.ws + WS_HID) + (size_t)e * ME * FF}); }
}
static void P7(hipStream_t st, const Params& P) {
    for (int e = 0; e < NE; ++e) { const size_t wo = (size_t)e * D_ * FF; const int* gi = (const int*)(P.ws + WS_GIDX) + e * ME;
        launch_gemm<true>(st, (bf16*)(P.ws + WS_HID) + (size_t)e * ME * FF, FF, nullptr, P.w_ed + wo, D_, ME, D_, FF, EpiRowScale{(const float*)(P.ws + WS_AFF), gi, (bf16*)P.out + (size_t)e * ME * D_, e, 0}); }
}
static void P8(hipStream_t st, const Params& P) {
    hipLaunchKernelGGL(combine_norm, dim3(T_ / 4), dim3(256), 0, st, (float*)(P.ws + WS_H), (const bf16*)P.out, (const int*)(P.ws + WS_INV), P.norm_ple, (bf16*)(P.ws + WS_XN3));
}
static void P9(hipStream_t st, const Params& P) {
    launch_gemm<false>(st, P.p, PLE, nullptr, P.w_ple, D_, T_, D_, PLE, EpiF32{(float*)(P.ws + WS_PLET), D_, 0});
    launch_gemm<true>(st, P.ws + WS_XN3, D_, nullptr, P.w_pg, D_, T_, D_, D_, EpiPle{(const float*)(P.ws + WS_PLET), (float*)(P.ws + WS_H)});
}
static void P10(hipStream_t st, const Params& P) {
    hipLaunchKernelGGL(rmsnorm_rows<false>, dim3(T_ / 4), dim3(256), 0, st, (const float*)(P.ws + WS_H), P.norm_final, (void*)P.out);
}
}
namespace pg8 {
#define PG8_LAS __attribute__((address_space(3)))
typedef short bf16x8 __attribute__((ext_vector_type(8)));
constexpr int BM = 256, BK = 64, HALF = 128, HTB = HALF * BK * 2  , STAGE_BYTES = 8 * HTB;

__host__ __device__ __forceinline__ int lds_byte(int r, int c) { const int st = (r >> 4) * 2 + (c >> 5), rr = r & 15, cc = c & 31, ob = rr * 64 + cc * 2; return st * 1024 + (ob ^ (((ob >> 9) & 1) << 5)); }
__host__ __device__ __forceinline__ void stage_rc(int b, int& R, int& C) { const int st = b / 1024, sb = b % 1024, swz = sb ^ (((sb >> 9) & 1) << 5); R = (st >> 1) * 16 + swz / 64; C = (st & 1) * 32 + (swz % 64) / 2; }
__host__ __device__ __forceinline__ int perm32(int rho) { const int n = rho >> 4, i = rho & 15; return 8 * (i >> 2) + 4 * n + (i & 3); }

struct Unit { const char* a; const char* b0; const char* b1; const int* gi; int pm, pn, e, pad; };

__device__ __forceinline__ unsigned cvt_pk_bf16(float lo, float hi) { unsigned r; asm volatile("v_cvt_pk_bf16_f32 %0, %1, %2" : "=v"(r) : "v"(lo), "v"(hi)); return r; }

template <class Epi, class Sched, bool GATHER, bool ALIGN_EPI>
__device__ __forceinline__ void gemm_phase(PG8_LAS unsigned char* lds, const int K, const Sched& S, const Epi& E) {
    const int tid = threadIdx.x, wid = __builtin_amdgcn_readfirstlane(tid >> 6), lane = tid & 63, wr = wid >> 2, wc = wid & 3, fr = lane & 15, fq = lane >> 4;
    const int nt = K / BK;
    int sR[2], sC[2];
    unsigned voffB[2], voffA[2][2];
#pragma unroll
    for (int i = 0; i < 2; ++i) { stage_rc(tid * 16 + i * 8192, sR[i], sC[i]); const int Rb = Epi::PERM ? ((sR[i] & ~31) + perm32(sR[i] & 31)) : sR[i];
        voffB[i] = (unsigned)(Rb * K + sC[i]) * 2u;
        voffA[0][i] = (unsigned)(sR[i] * K + sC[i]) * 2u; voffA[1][i] = (unsigned)((sR[i] + HALF) * K + sC[i]) * 2u; }
    const size_t kstep = (size_t)(BK * 2);
    const unsigned ldsw = (unsigned)wid * 1024u;
    const int aoff = lds_byte(wr * 64 + fr, fq * 8), boff = lds_byte(wc * 32 + fr, fq * 8);
#define PG8_SA(b, h) (((b) * 2 + (h)) * HTB)
#define PG8_SB(b, h) ((4 + (b) * 2 + (h)) * HTB)
#define PG8_STAGE(bufoff, gbase, voff) do { _Pragma("unroll") for (int _i = 0; _i < 2; ++_i) \
        __builtin_amdgcn_global_load_lds((const unsigned*)((const char*)(gbase) + (voff)[_i]), (PG8_LAS unsigned*)(lds + (bufoff) + ldsw + _i * 8192), 16, 0, 0); } while (0)
#define PG8_LDA(dst, b, h) do { _Pragma("unroll") for (int m = 0; m < 4; ++m) _Pragma("unroll") for (int k = 0; k < 2; ++k) dst[m][k] = *(const PG8_LAS bf16x8*)(lds + PG8_SA(b, h) + aoff + m * 2048 + k * 1024); } while (0)
#define PG8_LDB(dst, b, h) do { _Pragma("unroll") for (int n = 0; n < 2; ++n) _Pragma("unroll") for (int k = 0; k < 2; ++k) dst[n][k] = *(const PG8_LAS bf16x8*)(lds + PG8_SB(b, h) + boff + n * 2048 + k * 1024); } while (0)
#define PG8_MMA(ai, bj, At, Bt) do { __builtin_amdgcn_s_setprio(1); _Pragma("unroll") for (int m = 0; m < 4; ++m) _Pragma("unroll") for (int n = 0; n < 2; ++n) _Pragma("unroll") for (int k = 0; k < 2; ++k) \
        acc[ai][bj][m][n] = __builtin_amdgcn_mfma_f32_16x16x32_bf16(Bt[n][k], At[m][k], acc[ai][bj][m][n], 0, 0, 0); __builtin_amdgcn_s_setprio(0); } while (0)
#define PG8_WAIT_V(n) asm volatile("s_waitcnt vmcnt(" #n ")" ::: "memory")
#define PG8_WAIT_L(n) asm volatile("s_waitcnt lgkmcnt(" #n ")" ::: "memory")
#define PG8_BAR __builtin_amdgcn_s_barrier()
#define PG8_SCHED __builtin_amdgcn_sched_barrier(0)
    Unit cur, nxt; int ui = 0;
    if (!S.next(0, cur)) return;
    if constexpr (GATHER) {
#pragma unroll
        for (int h = 0; h < 2; ++h)
#pragma unroll
            for (int i = 0; i < 2; ++i) voffA[h][i] = (unsigned)(cur.gi[h * HALF + sR[i]] * K + sC[i]) * 2u;
    }
    f32x4 acc[2][2][4][2];
#pragma unroll
    for (int a = 0; a < 2; ++a)
#pragma unroll
        for (int b = 0; b < 2; ++b)
#pragma unroll
            for (int m = 0; m < 4; ++m)
#pragma unroll
                for (int n = 0; n < 2; ++n) acc[a][b][m][n] = (f32x4){0.f, 0.f, 0.f, 0.f};
    bf16x8 At[4][2], B0[2][2], B1[2][2];
    const char* cA = cur.a; const char* cB0 = cur.b0; const char* cB1 = cur.b1;
    PG8_STAGE(PG8_SB(0, 0), cB0, voffB); PG8_STAGE(PG8_SB(0, 1), cB1, voffB); PG8_STAGE(PG8_SA(0, 0), cA, voffA[0]); PG8_STAGE(PG8_SA(0, 1), cA, voffA[1]);
    if (wr == 1) PG8_BAR;
    PG8_WAIT_V(2); PG8_BAR;
    PG8_STAGE(PG8_SB(1, 0), cB0 + kstep, voffB); PG8_STAGE(PG8_SA(1, 0), cA + kstep, voffA[0]); PG8_STAGE(PG8_SB(1, 1), cB1 + kstep, voffB);
    PG8_WAIT_V(6); PG8_BAR;
    for (;;) {
        const bool has_next = S.next(ui + 1, nxt);
        unsigned voffN[2][2];
#pragma unroll
        for (int h = 0; h < 2; ++h)
#pragma unroll
            for (int i = 0; i < 2; ++i) voffN[h][i] = voffA[h][i];
        if constexpr (GATHER) { if (has_next) {
#pragma unroll
            for (int h = 0; h < 2; ++h)
#pragma unroll
                for (int i = 0; i < 2; ++i) voffN[h][i] = (unsigned)(nxt.gi[h * HALF + sR[i]] * K + sC[i]) * 2u; } }
        const char* nA = has_next ? nxt.a : cA; const char* nB0 = has_next ? nxt.b0 : cB0; const char* nB1 = has_next ? nxt.b1 : cB1;
        for (int t = 0; t < nt; t += 2) {
            const bool last = (t == nt - 2);
            const char* a1 = cA + (size_t)(t + 1) * kstep;
            const char* a2 = last ? nA : cA + (size_t)(t + 2) * kstep;
            const char* b20 = last ? nB0 : cB0 + (size_t)(t + 2) * kstep; const char* b21 = last ? nB1 : cB1 + (size_t)(t + 2) * kstep;
            const char* a3 = a2 + kstep; const char* b30 = b20 + kstep; const char* b31 = b21 + kstep;
            unsigned va0[2], va1[2];
#pragma unroll
            for (int i = 0; i < 2; ++i) { va0[i] = last ? voffN[0][i] : voffA[0][i]; va1[i] = last ? voffN[1][i] : voffA[1][i]; }
            PG8_LDB(B0, 0, 0); PG8_LDB(B1, 0, 1); PG8_SCHED; PG8_LDA(At, 0, 0); PG8_STAGE(PG8_SA(1, 1), a1, voffA[1]);
            PG8_WAIT_V(8); PG8_WAIT_L(0); PG8_BAR; PG8_MMA(0, 0, At, B0); PG8_MMA(0, 1, At, B1); PG8_BAR; PG8_SCHED;
            PG8_LDA(At, 0, 1); PG8_STAGE(PG8_SB(0, 0), b20, voffB); PG8_STAGE(PG8_SB(0, 1), b21, voffB); PG8_STAGE(PG8_SA(0, 0), a2, va0);
            PG8_WAIT_V(8); PG8_WAIT_L(0); PG8_BAR; PG8_MMA(1, 0, At, B0); PG8_MMA(1, 1, At, B1); PG8_BAR; PG8_SCHED;
            PG8_LDB(B0, 1, 0); PG8_LDB(B1, 1, 1); PG8_SCHED; PG8_LDA(At, 1, 0); PG8_STAGE(PG8_SA(0, 1), a2, va1);
            PG8_WAIT_V(8); PG8_WAIT_L(0); PG8_BAR; PG8_MMA(0, 0, At, B0); PG8_MMA(0, 1, At, B1); PG8_BAR; PG8_SCHED;
            PG8_LDA(At, 1, 1); PG8_STAGE(PG8_SB(1, 0), b30, voffB); PG8_STAGE(PG8_SB(1, 1), b31, voffB); PG8_STAGE(PG8_SA(1, 0), a3, va0);
            PG8_WAIT_V(8); PG8_WAIT_L(0); PG8_BAR; PG8_MMA(1, 0, At, B0); PG8_MMA(1, 1, At, B1); PG8_BAR; PG8_SCHED;
        }
        if constexpr (ALIGN_EPI) { if (wr == 0) PG8_BAR; }
        E(acc, cur, wr, wc, fr, fq);
        if (!has_next) break;
#pragma unroll
        for (int a = 0; a < 2; ++a)
#pragma unroll
            for (int b = 0; b < 2; ++b)
#pragma unroll
                for (int m = 0; m < 4; ++m)
#pragma unroll
                    for (int n = 0; n < 2; ++n) acc[a][b][m][n] = (f32x4){0.f, 0.f, 0.f, 0.f};
        cur = nxt; cA = nA; cB0 = nB0; cB1 = nB1; ++ui;
#pragma unroll
        for (int h = 0; h < 2; ++h)
#pragma unroll
            for (int i = 0; i < 2; ++i) voffA[h][i] = voffN[h][i];
        if constexpr (ALIGN_EPI) { if (wr == 1) PG8_BAR; }
    }
    PG8_WAIT_V(0);
    if constexpr (!ALIGN_EPI) { if (wr == 0) PG8_BAR; }
    PG8_BAR;
#undef PG8_SA
#undef PG8_SB
#undef PG8_STAGE
#undef PG8_LDA
#undef PG8_LDB
#undef PG8_MMA
#undef PG8_WAIT_V
#undef PG8_WAIT_L
#undef PG8_BAR
#undef PG8_SCHED
}

struct DenseOrder {
    const char* A; const char* Bt; int K, nM, nN, nwg, G, c;
    __device__ void init(const void* A_, const void* Bt_, int M, int N, int K_, int G_, int c_) { A = (const char*)A_; Bt = (const char*)Bt_; K = K_; nM = M / BM; nN = N / BM; nwg = nM * nN; G = G_; c = c_; }
    __device__ bool next(int i, Unit& u) const {
        const long L = (long)i * G + c; if (L >= nwg) return false;
        int wgid = (int)L; { const int q = nwg / 8, r = nwg % 8, xcd = wgid % 8, off = wgid / 8; wgid = (xcd < r ? xcd * (q + 1) : r * (q + 1) + (xcd - r) * q) + off; }
        const int nig = 8 * nN, gid = wgid / nig, fm = gid * 8, gsz = (nM - fm) < 8 ? (nM - fm) : 8;
        u.pm = fm + ((wgid % nig) % gsz); u.pn = (wgid % nig) / gsz; u.e = 0; u.pad = 0; u.gi = nullptr;
        u.a = A + (size_t)u.pm * BM * K * 2; u.b0 = Bt + (size_t)u.pn * BM * K * 2; u.b1 = u.b0 + (size_t)HALF * K * 2; return true;
    }
};
}
namespace mk {
constexpr int NWAVES = 8, NT = NWAVES * 64;
constexpr int RING_OFF = 0, RING_BYTES = 131072;
constexpr int LDSCTL_OFF = RING_BYTES, MISC_OFF = LDSCTL_OFF + 320;
constexpr int LDS_BYTES = 147456;
#define GAS __attribute__((address_space(1)))
#define LAS __attribute__((address_space(3)))
typedef GAS unsigned gu32;
#define RLX_AGENT __ATOMIC_RELAXED, __HIP_MEMORY_SCOPE_AGENT
#define LDS_WAIT() asm volatile("s_waitcnt lgkmcnt(0)" ::: "memory")
#define VM_WAIT() asm volatile("s_waitcnt vmcnt(0)" ::: "memory")

#define XB_TMO      128
#define XB_XCNT(j)  (256  + 64 * (j))
#define XB_XSUB(j)  (1280 + 64 * (j))
#define XB_XGEN(j)  (2304 + 64 * (j))
#define XB_TOP      3328
#define XB_TOPGEN   3392
#define XCD_BAR_WORDS 3456
#define XB_SPIN_CAP (1u << 18)
__device__ __forceinline__ unsigned xb_ld(unsigned* p)              { return __hip_atomic_load(p, __ATOMIC_RELAXED, __HIP_MEMORY_SCOPE_AGENT); }
__device__ __forceinline__ unsigned xb_add(unsigned* p, unsigned v) { return __hip_atomic_fetch_add(p, v, __ATOMIC_RELAXED, __HIP_MEMORY_SCOPE_AGENT); }
__device__ __forceinline__ unsigned xb_xcc_id() { return (unsigned)__builtin_amdgcn_s_getreg((3 << 11) | 20) & 0xFu; }
#define XB_SPIN(cond, bar) do { unsigned _sp = 0; while (cond) { __builtin_amdgcn_s_sleep(1); \
    if ((++_sp & 255u) == 0u) { if (xb_ld(&(bar)[XB_TMO])) break; if (_sp > XB_SPIN_CAP) { atomicAdd(&(bar)[XB_TMO], 1u); break; } } } } while (0)
struct XcdBarrier { unsigned* bar; unsigned x; volatile LAS unsigned* st; };
__device__ __forceinline__ XcdBarrier xcd_barrier_post(unsigned* bar, volatile LAS unsigned* st) {
    XcdBarrier b; b.bar = bar; b.x = xb_xcc_id(); b.st = st;
    if (threadIdx.x == 0) (void)xb_add(&bar[XB_XCNT(b.x)], 1u);
    return b;
}
__device__ __forceinline__ void xcd_barrier_complete(unsigned* bar, unsigned x, unsigned& nloc, unsigned& nx) {
    const unsigned G = gridDim.x * gridDim.y * gridDim.z;
    unsigned sum, cnt, mine, sp = 0u;
    for (;;) {
        sum = 0u; cnt = 0u; mine = 0u;
#pragma unroll
        for (unsigned j = 0; j < 16; ++j) { const unsigned c = xb_ld(&bar[XB_XCNT(j)]); sum += c; cnt += (c > 0u) ? 1u : 0u; mine = (j == x) ? c : mine; }
        if (sum == G) break;
        __builtin_amdgcn_s_sleep(1);
        if ((++sp & 255u) == 0u) { if (xb_ld(&bar[XB_TMO])) break; if (sp > XB_SPIN_CAP) { atomicAdd(&bar[XB_TMO], 1u); break; } }
    }
    nloc = mine > 0u ? mine : 1u; nx = cnt > 0u ? cnt : 1u;
}
__device__ __forceinline__ void xcd_barrier(const XcdBarrier& b) {
    asm volatile("s_waitcnt vmcnt(0)" ::: "memory");
    __syncthreads();
    if (threadIdx.x == 0) {
        unsigned* bar = b.bar;
        __builtin_amdgcn_s_waitcnt(0);
        unsigned nloc = b.st[0], nx = b.st[1];
        if (nloc == 0u) { xcd_barrier_complete(bar, b.x, nloc, nx); b.st[0] = nloc; b.st[1] = nx; }
        const unsigned old = xb_add(&bar[XB_XSUB(b.x)], 1u);
        const unsigned gen = old / nloc;
        if (old + 1u == (gen + 1u) * nloc) {
            __builtin_amdgcn_fence(__ATOMIC_RELEASE, "agent");
            asm volatile("s_waitcnt vmcnt(0)" ::: "memory");
            const unsigned og = xb_add(&bar[XB_TOP], 1u);
            const unsigned tg = og / nx;
            if (og + 1u == (tg + 1u) * nx) xb_add(&bar[XB_TOPGEN], 1u);
            else XB_SPIN(xb_ld(&bar[XB_TOPGEN]) == tg, bar);
            __builtin_amdgcn_fence(__ATOMIC_ACQUIRE, "agent");
            xb_add(&bar[XB_XGEN(b.x)], 1u);
            asm volatile("s_waitcnt vmcnt(0)" ::: "memory");
        } else {
            XB_SPIN(xb_ld(&bar[XB_XGEN(b.x)]) == gen, bar);
            __builtin_amdgcn_fence(__ATOMIC_ACQUIRE, "agent");
            asm volatile("s_waitcnt vmcnt(0)" ::: "memory");
        }
    }
    __syncthreads();
}

struct Frame {
    LAS unsigned char* lds; char* ws;
    int tid, lane, wave, vcu, G;
};

__device__ __forceinline__ void p0_transpose_item(const float* W, int K, int N, bf16* WT, int dst_row0, LAS float* scr, int k0, int n0, int lane) {
#pragma unroll 8
    for (int i = 0; i < 32; ++i) { const int kk = 2 * i + (lane >> 5); scr[kk * 33 + (lane & 31)] = W[(size_t)(k0 + kk) * N + n0 + (lane & 31)]; }
    LDS_WAIT(); asm volatile("" ::: "memory");
    const int c = lane & 7;
#pragma unroll
    for (int j = 0; j < 4; ++j) { const int n = (lane >> 3) + 8 * j; const LAS float* s = scr + (8 * c) * 33 + n;
        u32x4 o; o.x = pk2(s[0 * 33], s[1 * 33]); o.y = pk2(s[2 * 33], s[3 * 33]); o.z = pk2(s[4 * 33], s[5 * 33]); o.w = pk2(s[6 * 33], s[7 * 33]);
        *(GAS u32x4*)(WT + (size_t)(dst_row0 + n) * K + k0 + 8 * c) = o; }
    LDS_WAIT(); asm volatile("" ::: "memory");
}
__device__ __forceinline__ void p0_matrix(Frame& F, const float* W, int K, int N, bf16* WT, LAS float* scr, int it) {
    const int nblk = N / 32, kb = it / nblk, nb = it % nblk;
    p0_transpose_item(W, K, N, WT, 32 * nb, scr, 64 * kb, 32 * nb, F.lane);
}
__device__ __forceinline__ void phase0(Frame& F, const Params& P) {
    LAS float* scr = (LAS float*)(F.lds + RING_OFF + F.wave * 16384);
    const int gw = F.vcu * NWAVES + F.wave, NGW = F.G * NWAVES;
    constexpr int I_IN = 16 * 185, I_A = 8 * 32, I_SQ = 16 * 32, I_PLE = 4 * 32;
    constexpr int NITEMS = I_IN + I_A + 3 * I_SQ + I_PLE;
    for (int it = gw; it < NITEMS; it += NGW) {
        int r = it;
        if (r < I_IN) { const int kb = r / 185, nb = r % 185; const int dst = nb < 120 ? 32 * nb : (nb == 120 ? 5888 : 32 * nb - 32);
            p0_transpose_item(P.w_in, D_, IN_DIM, (bf16*)(F.ws + WS_WIN), dst, scr, 64 * kb, 32 * nb, F.lane); continue; } r -= I_IN;
        if (r < I_A) { p0_matrix(F, P.w_ba, 512, D_, (bf16*)(F.ws + WS_WA), scr, r); continue; } r -= I_A;
        if (r < I_SQ) { p0_matrix(F, P.w_bg, D_, D_, (bf16*)(F.ws + WS_WB), scr, r); continue; } r -= I_SQ;
        if (r < I_SQ) { p0_matrix(F, P.w_out, D_, D_, (bf16*)(F.ws + WS_WO), scr, r); continue; } r -= I_SQ;
        if (r < I_SQ) { p0_matrix(F, P.w_pg, D_, D_, (bf16*)(F.ws + WS_WPG), scr, r); continue; } r -= I_SQ;
        p0_matrix(F, P.w_ple, PLE, D_, (bf16*)(F.ws + WS_WPLE), scr, r);
    }
    for (int i = (F.vcu * NT + F.tid); i < 28672; i += F.G * NT) *((GAS u32x4*)(F.ws + WS_WIN + (size_t)5920 * 2048) + i) = (u32x4){0u, 0u, 0u, 0u};
    for (int m = gw; m < T_; m += NGW) {
        const GAS f32x4* xr = (const GAS f32x4*)(P.x + (size_t)m * D_) + F.lane;
        f32x4 v[4]; float s = 0.f;
#pragma unroll
        for (int j = 0; j < 4; ++j) { v[j] = xr[64 * j]; s += (v[j].x * v[j].x + v[j].y * v[j].y) + (v[j].z * v[j].z + v[j].w * v[j].w); }
        const float r = 1.0f / sqrtf(wave_sum(s) * (1.0f / D_) + EPS);
        GAS u32x2* o8 = (GAS u32x2*)(F.ws + WS_A0 + (size_t)m * D_ * 2) + F.lane;
#pragma unroll
        for (int j = 0; j < 4; ++j) { const f32x4 g = ((const GAS f32x4*)P.norm_mix)[F.lane + 64 * j]; const f32x4 y = v[j] * r * g; o8[64 * j] = (u32x2){pk2(y.x, y.y), pk2(y.z, y.w)}; }
    }
    for (int gid = F.vcu * NT + F.tid; gid < T_ * 8; gid += F.G * NT) {
        const int i = gid & 7, t = gid >> 3;
        const float invf = i == 0 ? 1.0f : i == 1 ? 0.1939227432012558f : i == 2 ? 0.03760603070259094f : i == 3 ? 0.007292664609849453f : i == 4 ? 0.0014142135623842478f : i == 5 ? 0.00027424818836152554f : i == 6 ? 5.3182957344688475e-05f : 1.0313385246263351e-05f;
        const float ang = (float)P.pos[t] * invf;
        float* RT = (float*)(F.ws + WS_ROPE);
        RT[t * 16 + i] = cosf(ang); RT[t * 16 + 8 + i] = sinf(ang);
    }
}

struct EpiInProj {
    static constexpr bool PERM = true;
    char* ws;
    __device__ __forceinline__ void operator()(const f32x4 (&acc)[2][2][4][2], const pg8::Unit& u, int wr, int wc, int fr, int fq) const {
        const int pn = u.pn; const int row0 = u.pm * 256 + wr * 64 + fr;
        if (pn == 23) {
            if (wc == 0) {
#pragma unroll
                for (int ai = 0; ai < 2; ++ai)
#pragma unroll
                    for (int m = 0; m < 4; ++m) { float* zp = (float*)(ws + WS_Z) + (size_t)(row0 + ai * 128 + m * 16) * 32 + 8 * fq; *(f32x4*)zp = acc[ai][0][m][0]; *(f32x4*)(zp + 4) = acc[ai][0][m][1]; }
            }
            return;
        }
        bf16* base; int ldc, ct; float sc = 1.f;
        if (pn < 3) { base = (bf16*)(ws + WS_QKV); ldc = 768; ct = pn * 256; if (pn < 2) sc = QSCALE; }
        else { const int g = (pn - 3) >> 2; ct = ((pn - 3) & 3) * 256; ldc = 1024; base = (bf16*)(ws + (g == 0 ? WS_GQK : g == 1 ? WS_GV : g == 2 ? WS_GR : g == 3 ? WS_GATT : WS_GGLA)); if (g == 0 && ct < 512) sc = GQSCALE; }
        const bool rope_wave = (pn < 3) && ((wc & 1) == 0);
        const float* RT = (const float*)(ws + WS_ROPE);
#pragma unroll
        for (int ai = 0; ai < 2; ++ai)
#pragma unroll
            for (int m = 0; m < 4; ++m) {
                const int r = row0 + ai * 128 + m * 16;
                f32x4 cs0, cs1, sn0, sn1;
                if (rope_wave) { const f32x4* rp = (const f32x4*)(RT + (size_t)r * 16); cs0 = rp[0]; cs1 = rp[1]; sn0 = rp[2]; sn1 = rp[3]; }
#pragma unroll
                for (int bj = 0; bj < 2; ++bj) {
                    f32x4 v0 = acc[ai][bj][m][0], v1 = acc[ai][bj][m][1];
                    if (rope_wave && !(pn == 2 && bj == 1)) {
                        f32x4 o0, o1;
#pragma unroll
                        for (int j = 0; j < 4; ++j) { o0[j] = __shfl_xor(v0[j], 16); o1[j] = __shfl_xor(v1[j], 16); }
                        if (fq == 0) { v0 = v0 * cs0 - o0 * sn0; v1 = v1 * cs1 - o1 * sn1; }
                        else if (fq == 1) { v0 = v0 * cs0 + o0 * sn0; v1 = v1 * cs1 + o1 * sn1; }
                    }
                    v0 = v0 * sc; v1 = v1 * sc;
                    u32x4 w; w.x = pg8::cvt_pk_bf16(v0[0], v0[1]); w.y = pg8::cvt_pk_bf16(v0[2], v0[3]); w.z = pg8::cvt_pk_bf16(v1[0], v1[1]); w.w = pg8::cvt_pk_bf16(v1[2], v1[3]);
                    *(u32x4*)(base + (size_t)r * ldc + ct + bj * 128 + wc * 32 + 8 * fq) = w;
                }
            }
    }
};
__device__ __forceinline__ void phase1(Frame& F, const Params& P) {
    pg8::DenseOrder S; S.init(F.ws + WS_A0, F.ws + WS_WIN, T_, 6144, D_, F.G, (int)blockIdx.x);
    EpiInProj E{F.ws};
    pg8::gemm_phase<EpiInProj, pg8::DenseOrder, false, true>(F.lds + RING_OFF, D_, S, E);
}


__device__ __forceinline__ f32x4 ldbf4(const bf16* p) { const u32x2 r = *(const u32x2*)p; return (f32x4){bf2f(r.x & 0xffffu), bf2f(r.x >> 16), bf2f(r.y & 0xffffu), bf2f(r.y >> 16)}; }
__device__ __forceinline__ void stbf4(bf16* p, f32x4 v) { *(u32x2*)p = (u32x2){pk2(v.x, v.y), pk2(v.z, v.w)}; }
__device__ __forceinline__ f32x4 sig4(f32x4 g) { return (f32x4){sigmoidf_(g.x), sigmoidf_(g.y), sigmoidf_(g.z), sigmoidf_(g.w)}; }

__device__ __forceinline__ void phase3_pre(Frame& F, const Params& P) {
    const bf16* OFp = (const bf16*)(F.ws + WS_OF); const bf16* OBp = (const bf16*)(F.ws + WS_OB); const bf16* GR = (const bf16*)(F.ws + WS_GR); bf16* GLAO = (bf16*)(F.ws + WS_GLAO);
    const int gw0 = F.vcu * NWAVES + F.wave, NGW = F.G * NWAVES;
    for (int gw = gw0; gw < T_ * 4; gw += NGW) {
        const int h = gw & 3; const long t = gw >> 2; const long off = t * 1024 + h * 256 + F.lane * 4;
        const f32x4 x = ldbf4(OFp + off) + ldbf4(OBp + off);
        const float s = wave_sum(x.x * x.x + x.y * x.y + x.z * x.z + x.w * x.w);
        const float r = 1.0f / sqrtf(s * (1.0f / 256.0f) + EPS);
        const f32x4 g = *(const f32x4*)(P.gla_norm + h * 256 + F.lane * 4); const f32x4 gr = ldbf4(GR + off);
        stbf4(GLAO + off, x * r * g * gr * sig4(gr));
    }
}
struct EpiGate1 {
    static constexpr bool PERM = false;
    const bf16* G; float* C;
    __device__ __forceinline__ void operator()(const f32x4 (&acc)[2][2][4][2], const pg8::Unit& u, int wr, int wc, int fr, int fq) const {
        const int row0 = u.pm * 256 + wr * 64 + fr, col0 = u.pn * 256 + wc * 32 + 4 * fq;
#pragma unroll
        for (int ai = 0; ai < 2; ++ai)
#pragma unroll
            for (int m = 0; m < 4; ++m) { const size_t ro = (size_t)(row0 + ai * 128 + m * 16) * D_ + col0;
#pragma unroll
                for (int bj = 0; bj < 2; ++bj)
#pragma unroll
                    for (int n = 0; n < 2; ++n) { const size_t o = ro + bj * 128 + n * 16; *(f32x4*)(C + o) = sig4(ldbf4(G + o)) * acc[ai][bj][m][n]; } }
    }
};
struct EpiGate2 {
    static constexpr bool PERM = true;
    const bf16* G; const float* Tm; bf16* C;
    __device__ __forceinline__ void operator()(const f32x4 (&acc)[2][2][4][2], const pg8::Unit& u, int wr, int wc, int fr, int fq) const {
        const int row0 = u.pm * 256 + wr * 64 + fr, col0 = u.pn * 256 + wc * 32 + 8 * fq;
#pragma unroll
        for (int ai = 0; ai < 2; ++ai)
#pragma unroll
            for (int m = 0; m < 4; ++m) { const size_t ro = (size_t)(row0 + ai * 128 + m * 16) * D_ + col0;
#pragma unroll
                for (int bj = 0; bj < 2; ++bj) { const size_t o = ro + bj * 128;
                    const f32x4 v0 = *(const f32x4*)(Tm + o) + sig4(ldbf4(G + o)) * acc[ai][bj][m][0], v1 = *(const f32x4*)(Tm + o + 4) + sig4(ldbf4(G + o + 4)) * acc[ai][bj][m][1];
                    u32x4 w; w.x = pg8::cvt_pk_bf16(v0[0], v0[1]); w.y = pg8::cvt_pk_bf16(v0[2], v0[3]); w.z = pg8::cvt_pk_bf16(v1[0], v1[1]); w.w = pg8::cvt_pk_bf16(v1[2], v1[3]);
                    *(u32x4*)(C + o) = w; } }
    }
};
__device__ __forceinline__ void phase3a(Frame& F, const Params& P) {
    pg8::DenseOrder S; S.init(F.ws + WS_ATT, F.ws + WS_WA, T_, D_, 512, F.G, (int)blockIdx.x);
    EpiGate1 E{(const bf16*)(F.ws + WS_GATT), P.out};
    pg8::gemm_phase<EpiGate1, pg8::DenseOrder, false, false>(F.lds + RING_OFF, 512, S, E);
}
__device__ __forceinline__ void phase3b(Frame& F, const Params& P) {
    pg8::DenseOrder S; S.init(F.ws + WS_GLAO, F.ws + WS_WB, T_, D_, D_, F.G, (int)blockIdx.x);
    EpiGate2 E{(const bf16*)(F.ws + WS_GGLA), P.out, (bf16*)(F.ws + WS_MERGED)};
    pg8::gemm_phase<EpiGate2, pg8::DenseOrder, false, false>(F.lds + RING_OFF, D_, S, E);
}
struct EpiResid {
    static constexpr bool PERM = false;
    const float* R; float* C;
    __device__ __forceinline__ void operator()(const f32x4 (&acc)[2][2][4][2], const pg8::Unit& u, int wr, int wc, int fr, int fq) const {
        const int row0 = u.pm * 256 + wr * 64 + fr, col0 = u.pn * 256 + wc * 32 + 4 * fq;
#pragma unroll
        for (int ai = 0; ai < 2; ++ai)
#pragma unroll
            for (int m = 0; m < 4; ++m) { const size_t ro = (size_t)(row0 + ai * 128 + m * 16) * D_ + col0;
#pragma unroll
                for (int bj = 0; bj < 2; ++bj)
#pragma unroll
                    for (int n = 0; n < 2; ++n) { const size_t o = ro + bj * 128 + n * 16; *(f32x4*)(C + o) = *(const f32x4*)(R + o) + acc[ai][bj][m][n]; } }
    }
};
__device__ __forceinline__ void phase4a(Frame& F, const Params& P) {
    pg8::DenseOrder S; S.init(F.ws + WS_MERGED, F.ws + WS_WO, T_, D_, D_, F.G, (int)blockIdx.x);
    EpiResid E{P.x, (float*)(F.ws + WS_H)};
    pg8::gemm_phase<EpiResid, pg8::DenseOrder, false, false>(F.lds + RING_OFF, D_, S, E);
}
__device__ __forceinline__ void phase4b(Frame& F, const Params& P) {
    const float* H = (const float*)(F.ws + WS_H); bf16* XN = (bf16*)(F.ws + WS_XN); float* aff = (float*)(F.ws + WS_AFF);
    const int gw0 = F.vcu * NWAVES + F.wave, NGW = F.G * NWAVES, lane = F.lane;
    for (int row = gw0; row < T_; row += NGW) {
        const f32x4* xr = (const f32x4*)(H + (long)row * D_) + lane;
        f32x4 v[4]; float s = 0.f;
#pragma unroll
        for (int j = 0; j < 4; ++j) { v[j] = xr[64 * j]; s += v[j].x * v[j].x + v[j].y * v[j].y + v[j].z * v[j].z + v[j].w * v[j].w; }
        const float r = 1.0f / sqrtf(wave_sum(s) * (1.0f / D_) + EPS);
        float lg[16];
#pragma unroll
        for (int e = 0; e < 16; ++e) lg[e] = 0.f;
#pragma unroll
        for (int j = 0; j < 4; ++j) { const f32x4 y = v[j] * r * ((const f32x4*)P.norm_ffn)[lane + 64 * j]; stbf4(XN + (long)row * D_ + 4 * (lane + 64 * j), y);
            const f32x4* wr = (const f32x4*)(P.w_router + (size_t)(4 * (lane + 64 * j)) * 16);
#pragma unroll
            for (int q = 0; q < 4; ++q) { const f32x4 w0 = wr[q], w1 = wr[4 + q], w2 = wr[8 + q], w3 = wr[12 + q];
#pragma unroll
                for (int c = 0; c < 4; ++c) lg[4 * q + c] += y.x * w0[c] + y.y * w1[c] + y.z * w2[c] + y.w * w3[c]; } }
        float m = -INFINITY;
#pragma unroll
        for (int e = 0; e < 16; ++e) { lg[e] = wave_sum(lg[e]); m = fmaxf(m, lg[e]); }
        float sum = 0.f;
#pragma unroll
        for (int e = 0; e < 16; ++e) { lg[e] = expf(lg[e] - m); sum += lg[e]; }
        float val = 0.f;
#pragma unroll
        for (int e = 0; e < 16; ++e) if (lane == e) val = lg[e];
        if (lane < 16) aff[row * 16 + lane] = val / sum;
    }
}
__device__ __forceinline__ void topk_item(Frame& F, int b, int e) {
    LAS unsigned* cnts = (LAS unsigned*)(F.lds + RING_OFF);
    const float* aff = (const float*)(F.ws + WS_AFF); int* gidx = (int*)(F.ws + WS_GIDX); int* inv = (int*)(F.ws + WS_INV);
    const int tid = F.tid, lane = F.lane, wave = F.wave;
    unsigned v[8];
#pragma unroll
    for (int j = 0; j < 8; ++j) v[j] = __builtin_bit_cast(unsigned, aff[(size_t)(b * S_ + tid * 8 + j) * 16 + e]);
    unsigned Tv = 0u;
    __syncthreads();
    for (int bit = 30; bit >= 0; --bit) {
        const unsigned cand = Tv | (1u << bit);
        unsigned c = 0;
#pragma unroll
        for (int j = 0; j < 8; ++j) c += (v[j] >= cand) ? 1u : 0u;
#pragma unroll
        for (int o = 1; o < 64; o <<= 1) c += __shfl_xor(c, o);
        LAS unsigned* slot = cnts + (bit & 1) * 8;
        if (lane == 0) slot[wave] = c;
        __syncthreads();
        unsigned tot = 0;
#pragma unroll
        for (int w = 0; w < 8; ++w) tot += slot[w];
        if (tot >= (unsigned)CAP) Tv = cand;
    }
    unsigned ngt = 0, neq = 0;
#pragma unroll
    for (int j = 0; j < 8; ++j) { ngt += (v[j] > Tv) ? 1u : 0u; neq += (v[j] == Tv) ? 1u : 0u; }
    unsigned pk = ngt | (neq << 16), incl = pk;
#pragma unroll
    for (int o = 1; o < 64; o <<= 1) { const unsigned t = __shfl_up(incl, o); if (lane >= o) incl += t; }
    __syncthreads();
    LAS unsigned* wtot = cnts + 16;
    if (lane == 63) wtot[wave] = incl;
    __syncthreads();
    unsigned base = 0, total = 0;
#pragma unroll
    for (int w = 0; w < 8; ++w) { const unsigned t = wtot[w]; if (w < wave) base += t; total += t; }
    const unsigned excl = base + incl - pk;
    const unsigned tot_gt = total & 0xffffu, need_eq = (unsigned)CAP - tot_gt;
    unsigned g_before = excl & 0xffffu, e_before = excl >> 16;
#pragma unroll
    for (int j = 0; j < 8; ++j) {
        const bool gt = v[j] > Tv, eq = v[j] == Tv;
        const bool sel = gt || (eq && e_before < need_eq);
        const unsigned slotc = g_before + (e_before < need_eq ? e_before : need_eq);
        const int tok = b * S_ + tid * 8 + j;
        if (sel) gidx[e * ME + b * CAP + (int)slotc] = tok;
        inv[tok * 16 + e] = sel ? (int)(b * CAP + slotc) : -1;
        g_before += gt ? 1u : 0u; e_before += eq ? 1u : 0u;
    }
    __syncthreads();
}
__device__ __forceinline__ void phase5(Frame& F, const Params& P) {
    if (blockIdx.x < 64) topk_item(F, (int)blockIdx.x >> 4, (int)blockIdx.x & 15);
    LAS float* scr = (LAS float*)(F.lds + RING_OFF + 1024 + F.wave * 16384);
    const int gw = F.vcu * NWAVES + F.wave, NGW = F.G * NWAVES;
    for (int it = gw; it < 3 * 16 * 512; it += NGW) {
        const int mat = it >> 9, r = it & 511, which = mat >> 4, e = mat & 15;
        const float* W = (which == 0 ? P.w_eg : which == 1 ? P.w_eu : P.w_ed) + (size_t)e * D_ * FF;
        bf16* WT = (bf16*)(F.ws + (which == 0 ? WS_WEG : which == 1 ? WS_WEU : WS_WED)) + (size_t)e * D_ * FF;
        p0_matrix(F, W, 1024, 1024, WT, scr, r);
    }
}
struct ExpertOrder1 {
    const char* XN; const char* WG; const char* WU; const int* gidx; int G, c;
    __device__ bool next(int i, pg8::Unit& u) const {
        const int L = i * G + c; if (L >= 1024) return false;
        const int e = L >> 6, r = L & 63; u.e = e; u.pm = r & 7; u.pn = r >> 3; u.pad = 0;
        u.a = XN; u.gi = gidx + e * ME + u.pm * 256;
        const size_t bo = ((size_t)e * FF + (size_t)u.pn * 128) * D_ * 2; u.b0 = WG + bo; u.b1 = WU + bo; return true;
    }
};
struct EpiSwiglu {
    static constexpr bool PERM = true;
    bf16* HID;
    __device__ __forceinline__ void operator()(const f32x4 (&acc)[2][2][4][2], const pg8::Unit& u, int wr, int wc, int fr, int fq) const {
        const int row0 = u.e * ME + u.pm * 256 + wr * 64 + fr, col0 = u.pn * 128 + wc * 32 + 8 * fq;
#pragma unroll
        for (int ai = 0; ai < 2; ++ai)
#pragma unroll
            for (int m = 0; m < 4; ++m) { const f32x4 g0 = acc[ai][0][m][0], g1 = acc[ai][0][m][1];
                const f32x4 v0 = g0 * sig4(g0) * acc[ai][1][m][0], v1 = g1 * sig4(g1) * acc[ai][1][m][1];
                u32x4 w; w.x = pg8::cvt_pk_bf16(v0[0], v0[1]); w.y = pg8::cvt_pk_bf16(v0[2], v0[3]); w.z = pg8::cvt_pk_bf16(v1[0], v1[1]); w.w = pg8::cvt_pk_bf16(v1[2], v1[3]);
                *(u32x4*)(HID + (size_t)(row0 + ai * 128 + m * 16) * FF + col0) = w; }
    }
};
__device__ __forceinline__ void phase6(Frame& F, const Params& P) {
    ExpertOrder1 S{F.ws + WS_XN, F.ws + WS_WEG, F.ws + WS_WEU, (const int*)(F.ws + WS_GIDX), F.G, F.vcu};
    EpiSwiglu E{(bf16*)(F.ws + WS_HID)};
    pg8::gemm_phase<EpiSwiglu, ExpertOrder1, true, true>(F.lds + RING_OFF, D_, S, E);
}
struct ExpertOrder2 {
    const char* HID; const char* WD; int G, c;
    __device__ bool next(int i, pg8::Unit& u) const {
        const int L = i * G + c; if (L >= 512) return false;
        const int e = L >> 5, r = L & 31; u.e = e; u.pm = r & 7; u.pn = r >> 3; u.pad = 0; u.gi = nullptr;
        u.a = HID + ((size_t)e * ME + (size_t)u.pm * 256) * FF * 2;
        u.b0 = WD + ((size_t)e * D_ + (size_t)u.pn * 256) * FF * 2; u.b1 = u.b0 + (size_t)128 * FF * 2; return true;
    }
};
struct EpiRowScale {
    static constexpr bool PERM = true;
    const float* aff; const int* gidx; bf16* Y;
    __device__ __forceinline__ void operator()(const f32x4 (&acc)[2][2][4][2], const pg8::Unit& u, int wr, int wc, int fr, int fq) const {
        const int row0 = u.e * ME + u.pm * 256 + wr * 64 + fr, col0 = u.pn * 256 + wc * 32 + 8 * fq;
#pragma unroll
        for (int ai = 0; ai < 2; ++ai)
#pragma unroll
            for (int m = 0; m < 4; ++m) { const int r = row0 + ai * 128 + m * 16; const float a = aff[gidx[r] * NE + u.e];
#pragma unroll
                for (int bj = 0; bj < 2; ++bj) { const f32x4 v0 = acc[ai][bj][m][0] * a, v1 = acc[ai][bj][m][1] * a;
                    u32x4 w; w.x = pg8::cvt_pk_bf16(v0[0], v0[1]); w.y = pg8::cvt_pk_bf16(v0[2], v0[3]); w.z = pg8::cvt_pk_bf16(v1[0], v1[1]); w.w = pg8::cvt_pk_bf16(v1[2], v1[3]);
                    *(u32x4*)(Y + (size_t)r * D_ + col0 + bj * 128) = w; } }
    }
};
__device__ __forceinline__ void phase7(Frame& F, const Params& P) {
    ExpertOrder2 S{F.ws + WS_HID, F.ws + WS_WED, F.G, F.vcu};
    EpiRowScale E{(const float*)(F.ws + WS_AFF), (const int*)(F.ws + WS_GIDX), (bf16*)P.out};
    pg8::gemm_phase<EpiRowScale, ExpertOrder2, false, true>(F.lds + RING_OFF, FF, S, E);
}
constexpr size_t WS_PB = WS_GGLA;
__device__ __forceinline__ void phase8(Frame& F, const Params& P) {
    float* H = (float*)(F.ws + WS_H); const bf16* Y = (const bf16*)P.out; const int* inv = (const int*)(F.ws + WS_INV); bf16* XN3 = (bf16*)(F.ws + WS_XN3); bf16* PB = (bf16*)(F.ws + WS_PB);
    const int gw0 = F.vcu * NWAVES + F.wave, NGW = F.G * NWAVES, lane = F.lane;
    for (int row = gw0; row < T_; row += NGW) {
        f32x4* xr = (f32x4*)(H + (long)row * D_) + lane;
        f32x4 v[4];
#pragma unroll
        for (int j = 0; j < 4; ++j) v[j] = xr[64 * j];
        const int myinv = lane < 16 ? inv[row * 16 + lane] : -1;
        for (int e = 0; e < 16; ++e) { const int sl = __shfl(myinv, e); if (sl >= 0) { const bf16* yp = Y + ((long)e * ME + sl) * D_;
#pragma unroll
                for (int j = 0; j < 4; ++j) v[j] += ldbf4(yp + 4 * (lane + 64 * j)); } }
        float s = 0.f;
#pragma unroll
        for (int j = 0; j < 4; ++j) { xr[64 * j] = v[j]; s += v[j].x * v[j].x + v[j].y * v[j].y + v[j].z * v[j].z + v[j].w * v[j].w; }
        const float r = 1.0f / sqrtf(wave_sum(s) * (1.0f / D_) + EPS);
#pragma unroll
        for (int j = 0; j < 4; ++j) stbf4(XN3 + (long)row * D_ + 4 * (lane + 64 * j), v[j] * r * ((const f32x4*)P.norm_ple)[lane + 64 * j]);
        stbf4(PB + (long)row * PLE + 4 * lane, *((const f32x4*)(P.p + (long)row * PLE) + lane));
    }
}
struct EpiStoreF32 {
    static constexpr bool PERM = false;
    float* C;
    __device__ __forceinline__ void operator()(const f32x4 (&acc)[2][2][4][2], const pg8::Unit& u, int wr, int wc, int fr, int fq) const {
        const int row0 = u.pm * 256 + wr * 64 + fr, col0 = u.pn * 256 + wc * 32 + 4 * fq;
#pragma unroll
        for (int ai = 0; ai < 2; ++ai)
#pragma unroll
            for (int m = 0; m < 4; ++m) { const size_t ro = (size_t)(row0 + ai * 128 + m * 16) * D_ + col0;
#pragma unroll
                for (int bj = 0; bj < 2; ++bj)
#pragma unroll
                    for (int n = 0; n < 2; ++n) *(f32x4*)(C + ro + bj * 128 + n * 16) = acc[ai][bj][m][n]; }
    }
};
struct EpiPle {
    static constexpr bool PERM = false;
    const float* Pt; float* H;
    __device__ __forceinline__ void operator()(const f32x4 (&acc)[2][2][4][2], const pg8::Unit& u, int wr, int wc, int fr, int fq) const {
        const int row0 = u.pm * 256 + wr * 64 + fr, col0 = u.pn * 256 + wc * 32 + 4 * fq;
#pragma unroll
        for (int ai = 0; ai < 2; ++ai)
#pragma unroll
            for (int m = 0; m < 4; ++m) { const size_t ro = (size_t)(row0 + ai * 128 + m * 16) * D_ + col0;
#pragma unroll
                for (int bj = 0; bj < 2; ++bj)
#pragma unroll
                    for (int n = 0; n < 2; ++n) { const size_t o = ro + bj * 128 + n * 16; *(f32x4*)(H + o) = *(const f32x4*)(H + o) + sig4(acc[ai][bj][m][n]) * *(const f32x4*)(Pt + o); } }
    }
};
__device__ __forceinline__ void phase9a(Frame& F, const Params& P) {
    pg8::DenseOrder S; S.init(F.ws + WS_PB, F.ws + WS_WPLE, T_, D_, PLE, F.G, (int)blockIdx.x);
    EpiStoreF32 E{(float*)(F.ws + WS_PLET)};
    pg8::gemm_phase<EpiStoreF32, pg8::DenseOrder, false, false>(F.lds + RING_OFF, PLE, S, E);
}
__device__ __forceinline__ void phase9b(Frame& F, const Params& P) {
    pg8::DenseOrder S; S.init(F.ws + WS_XN3, F.ws + WS_WPG, T_, D_, D_, F.G, (int)blockIdx.x);
    EpiPle E{(const float*)(F.ws + WS_PLET), (float*)(F.ws + WS_H)};
    pg8::gemm_phase<EpiPle, pg8::DenseOrder, false, false>(F.lds + RING_OFF, D_, S, E);
}
__device__ __forceinline__ void phase10(Frame& F, const Params& P) {
    const float* H = (const float*)(F.ws + WS_H);
    const int gw0 = F.vcu * NWAVES + F.wave, NGW = F.G * NWAVES, lane = F.lane;
    for (int row = gw0; row < T_; row += NGW) {
        const f32x4* xr = (const f32x4*)(H + (long)row * D_) + lane;
        f32x4 v[4]; float s = 0.f;
#pragma unroll
        for (int j = 0; j < 4; ++j) { v[j] = xr[64 * j]; s += v[j].x * v[j].x + v[j].y * v[j].y + v[j].z * v[j].z + v[j].w * v[j].w; }
        const float r = 1.0f / sqrtf(wave_sum(s) * (1.0f / D_) + EPS);
#pragma unroll
        for (int j = 0; j < 4; ++j) *((f32x4*)(P.out + (long)row * D_) + lane + 64 * j) = v[j] * r * ((const f32x4*)P.norm_final)[lane + 64 * j];
    }
}

template <int PH>
__global__ void __launch_bounds__(NT, 2) phase_k(Params P) {
    extern __shared__ __attribute__((aligned(16))) unsigned char lds[];
    Frame F; F.lds = (LAS unsigned char*)lds; F.ws = P.ws;
    F.tid = threadIdx.x; F.lane = F.tid & 63; F.wave = __builtin_amdgcn_readfirstlane(F.tid >> 6);
    F.G = gridDim.x; { const int bx = blockIdx.x; F.vcu = (F.G % 8 == 0) ? (bx % 8) * (F.G / 8) + bx / 8 : bx; }
    if constexpr (PH == 0) phase0(F, P);
    if constexpr (PH == 1) phase1(F, P);
    if constexpr (PH == 30) phase3_pre(F, P);
    if constexpr (PH == 31) phase3a(F, P);
    if constexpr (PH == 32) phase3b(F, P);
    if constexpr (PH == 40) phase4a(F, P);
    if constexpr (PH == 41) phase4b(F, P);
    if constexpr (PH == 5) phase5(F, P);
    if constexpr (PH == 6) phase6(F, P);
    if constexpr (PH == 7) phase7(F, P);
    if constexpr (PH == 8) phase8(F, P);
    if constexpr (PH == 90) phase9a(F, P);
    if constexpr (PH == 91) phase9b(F, P);
    if constexpr (PH == 10) phase10(F, P);
}
template <int PH> static void launch_phase(hipStream_t st, const Params& P) {
    static bool attr = false;
    if (!attr) { (void)hipFuncSetAttribute((const void*)phase_k<PH>, hipFuncAttributeMaxDynamicSharedMemorySize, LDS_BYTES); attr = true; }
    hipLaunchKernelGGL(phase_k<PH>, dim3(256), dim3(NT), LDS_BYTES, st, P);
}
}
#ifndef FAST_MASK
#define FAST_MASK 0x7fb
#endif
extern "C" void kernel_launch(void* const* d_in, const int* in_sizes, int n_in, void* d_out, int out_size, void* d_ws, size_t ws_size, hipStream_t stream) {
    Params P{};
    P.x = (const float*)d_in[0]; P.p = (const float*)d_in[1]; P.pos = (const int*)d_in[2]; P.norm_mix = (const float*)d_in[3]; P.w_in = (const float*)d_in[4];
    P.up_f = (const float*)d_in[5]; P.bias_f = (const float*)d_in[6]; P.up_b = (const float*)d_in[7]; P.bias_b = (const float*)d_in[8]; P.sink = (const float*)d_in[9];
    P.gla_norm = (const float*)d_in[10]; P.w_ba = (const float*)d_in[11]; P.w_bg = (const float*)d_in[12]; P.w_out = (const float*)d_in[13]; P.norm_ffn = (const float*)d_in[14];
    P.w_router = (const float*)d_in[15]; P.w_eg = (const float*)d_in[16]; P.w_eu = (const float*)d_in[17]; P.w_ed = (const float*)d_in[18]; P.norm_ple = (const float*)d_in[19];
    P.w_pg = (const float*)d_in[20]; P.w_ple = (const float*)d_in[21]; P.norm_final = (const float*)d_in[22];
    P.out = (float*)d_out; P.ws = (char*)d_ws;
    if (ws_size < WS_END) { fprintf(stderr, "workspace too small: %zu < %zu\n", ws_size, (size_t)WS_END); return; }
    (void)hipMemsetAsync((char*)d_ws + WS_CTL, 0, 1 * MiB, stream);
#define RUN(bit, FAST, NAIVE) do { if (FAST_MASK & (1u << (bit))) { FAST; } else { NAIVE; } } while (0)
    RUN(0, mk::launch_phase<0>(stream, P), nv::P0(stream, P));
    RUN(1, mk::launch_phase<1>(stream, P), nv::P1(stream, P));
    nv::P2_attn(stream, P); nv::P2_gla(stream, P);
    RUN(3, (mk::launch_phase<30>(stream, P), mk::launch_phase<31>(stream, P), mk::launch_phase<32>(stream, P)), nv::P3(stream, P));
    RUN(4, (mk::launch_phase<40>(stream, P), mk::launch_phase<41>(stream, P)), nv::P4(stream, P));
    RUN(5, mk::launch_phase<5>(stream, P), nv::P5(stream, P));
    RUN(6, mk::launch_phase<6>(stream, P), nv::P6(stream, P));
    RUN(7, mk::launch_phase<7>(stream, P), nv::P7(stream, P));
    RUN(8, mk::launch_phase<8>(stream, P), nv::P8(stream, P));
    RUN(9, (mk::launch_phase<90>(stream, P), mk::launch_phase<91>(stream, P)), nv::P9(stream, P));
    RUN(10, mk::launch_phase<10>(stream, P), nv::P10(stream, P));
}
```

```cpp
#include <hip/hip_runtime.h>
#include <cstdio>
#include <cstdint>

constexpr int B_ = 4, S_ = 4096, D_ = 1024, T_ = B_ * S_;
constexpr int IN_DIM = 5920;
constexpr int C_Q = 0, C_K = 512, C_V = 640, C_GQ = 768, C_GK = 1280, C_GV = 1792, C_GR = 2816, C_ZF = 3840, C_ZB = 3856, C_GATT = 3872, C_GGLA = 4896;
constexpr int NE = 16, CAP = 512, FF = 1024, PLE = 256, ME = B_ * CAP;
constexpr float EPS = 1e-6f;
constexpr float LOG2E = 1.4426950408889634f;
constexpr float QSCALE = 0.125f * LOG2E;
constexpr float GQSCALE = 0.08838834764831845f;

typedef float f32x4 __attribute__((ext_vector_type(4)));
typedef float f32x2 __attribute__((ext_vector_type(2)));
typedef unsigned short bf16;
typedef unsigned u32x4 __attribute__((ext_vector_type(4)));
typedef unsigned u32x2 __attribute__((ext_vector_type(2)));

constexpr size_t MiB = 1u << 20;
constexpr size_t WS_CTL = 0, WS_ROPE = 1 * MiB, WS_AFF = 2 * MiB, WS_INV = 3 * MiB, WS_GIDX = 4 * MiB, WS_Z = 5 * MiB;
constexpr size_t WS_WIN = 8 * MiB, WS_WA = 20 * MiB, WS_WB = 21 * MiB, WS_WO = 23 * MiB, WS_WPG = 25 * MiB, WS_WPLE = 27 * MiB;
constexpr size_t WS_A0 = 28 * MiB;
constexpr size_t WS_QKV = 60 * MiB;
constexpr size_t WS_GQK = 84 * MiB;
constexpr size_t WS_GV = 116 * MiB;
constexpr size_t WS_GR = 148 * MiB;
constexpr size_t WS_GATT = 180 * MiB;
constexpr size_t WS_GGLA = 212 * MiB;
constexpr size_t WS_OB = 244 * MiB;
constexpr size_t WS_ATT = 276 * MiB;
constexpr size_t WS_OF = WS_A0, WS_XN = WS_A0, WS_XN3 = WS_A0, WS_GLAO = WS_GQK, WS_MERGED = WS_GV, WS_H = WS_GR, WS_HID = WS_QKV, WS_PLET = WS_QKV;
constexpr size_t WS_WEG = 212 * MiB, WS_WEU = 244 * MiB, WS_WED = 276 * MiB, WS_END = 308 * MiB;

__device__ __forceinline__ unsigned f2bf(float f) { unsigned u = __builtin_bit_cast(unsigned, f); return (u + 0x7fffu + ((u >> 16) & 1u)) >> 16; }
__device__ __forceinline__ float bf2f(unsigned h) { return __builtin_bit_cast(float, h << 16); }
__device__ __forceinline__ unsigned pk2(float lo, float hi) { return f2bf(lo) | (f2bf(hi) << 16); }
__device__ __forceinline__ float sigmoidf_(float x) { return 1.0f / (1.0f + __expf(-x)); }
__device__ __forceinline__ float wave_sum(float v) {
#pragma unroll
    for (int o = 1; o < 64; o <<= 1) v += __shfl_xor(v, o);
    return v;
}

struct Params {
    const float *x, *p; const int* pos; const float *norm_mix, *w_in, *up_f, *bias_f, *up_b, *bias_b, *sink, *gla_norm, *w_ba, *w_bg, *w_out,
        *norm_ffn, *w_router, *w_eg, *w_eu, *w_ed, *norm_ple, *w_pg, *w_ple, *norm_final;
    float* out; char* ws;
};
namespace nv {

template <bool ABF, class Epi>
__global__ void __launch_bounds__(256) gemm(const void* Av, int lda, const int* gidx, const float* Bm, int ldb, int M, int N, int K, Epi E) {
    __shared__ float As[8][128 + 4];
    __shared__ float Bs[8][128 + 4];
    const int tid = threadIdx.x, tx = tid & 15, ty = tid >> 4;
    const int m0 = blockIdx.y * 128, n0 = blockIdx.x * 128;
    float acc[8][8];
#pragma unroll
    for (int i = 0; i < 8; ++i)
#pragma unroll
        for (int j = 0; j < 8; ++j) acc[i][j] = 0.f;
    const int arow_l = tid >> 1, akoff = (tid & 1) * 4;
    const int am = m0 + arow_l;
    const long arow = gidx ? (long)gidx[am] : (long)am;
    const int bk = tid >> 5, bn = (tid & 31) * 4;
    const bool bok = (n0 + bn) < N;
    const float* Bp = Bm + (long)bk * ldb + n0 + bn;
    for (int k0 = 0; k0 < K; k0 += 8) {
        f32x4 av;
        if (ABF) { const u32x2 r = *(const u32x2*)((const bf16*)Av + arow * lda + akoff + k0); av = (f32x4){bf2f(r.x & 0xffffu), bf2f(r.x >> 16), bf2f(r.y & 0xffffu), bf2f(r.y >> 16)}; }
        else av = *(const f32x4*)((const float*)Av + arow * lda + akoff + k0);
        f32x4 bv = (f32x4){0.f, 0.f, 0.f, 0.f};
        if (bok) bv = *(const f32x4*)(Bp + (long)k0 * ldb);
        __syncthreads();
        As[akoff + 0][arow_l] = av.x; As[akoff + 1][arow_l] = av.y; As[akoff + 2][arow_l] = av.z; As[akoff + 3][arow_l] = av.w;
        *(f32x4*)&Bs[bk][bn] = bv;
        __syncthreads();
#pragma unroll
        for (int kk = 0; kk < 8; ++kk) {
            float a[8], b[8];
            const f32x4 a0 = *(const f32x4*)&As[kk][ty * 4], a1 = *(const f32x4*)&As[kk][64 + ty * 4];
            const f32x4 b0 = *(const f32x4*)&Bs[kk][tx * 4], b1 = *(const f32x4*)&Bs[kk][64 + tx * 4];
            a[0] = a0.x; a[1] = a0.y; a[2] = a0.z; a[3] = a0.w; a[4] = a1.x; a[5] = a1.y; a[6] = a1.z; a[7] = a1.w;
            b[0] = b0.x; b[1] = b0.y; b[2] = b0.z; b[3] = b0.w; b[4] = b1.x; b[5] = b1.y; b[6] = b1.z; b[7] = b1.w;
#pragma unroll
            for (int i = 0; i < 8; ++i)
#pragma unroll
                for (int j = 0; j < 8; ++j) acc[i][j] = fmaf(a[i], b[j], acc[i][j]);
        }
    }
#pragma unroll
    for (int i = 0; i < 8; ++i) {
        const int m = m0 + (i < 4 ? ty * 4 + i : 64 + ty * 4 + (i - 4));
#pragma unroll
        for (int jh = 0; jh < 2; ++jh) {
            const int n = n0 + jh * 64 + tx * 4;
            if (n < N) E(m, n, (f32x4){acc[i][jh * 4 + 0], acc[i][jh * 4 + 1], acc[i][jh * 4 + 2], acc[i][jh * 4 + 3]});
        }
    }
}
template <bool ABF, class Epi>
static void launch_gemm(hipStream_t st, const void* A, int lda, const int* gidx, const float* Bm, int ldb, int M, int N, int K, Epi E) {
    hipLaunchKernelGGL((gemm<ABF, Epi>), dim3((N + 127) / 128, M / 128), dim3(256), 0, st, A, lda, gidx, Bm, ldb, M, N, K, E);
}
__device__ __forceinline__ void st_bf4(bf16* p, f32x4 v) { *(u32x2*)p = (u32x2){pk2(v.x, v.y), pk2(v.z, v.w)}; }
__device__ __forceinline__ f32x4 ld_bf4(const bf16* p) { const u32x2 r = *(const u32x2*)p; return (f32x4){bf2f(r.x & 0xffffu), bf2f(r.x >> 16), bf2f(r.y & 0xffffu), bf2f(r.y >> 16)}; }

struct EpiF32 { float* C; int ldc; int pad; __device__ void operator()(int m, int n, f32x4 v) const { *(f32x4*)(C + (long)m * ldc + n) = v; } };
struct EpiBf { bf16* C; int ldc; float scale; int scale_cols; int pad; __device__ void operator()(int m, int n, f32x4 v) const { if (n < scale_cols) v = v * scale; st_bf4(C + (long)m * ldc + n, v); } };
struct EpiGate1 { const bf16* G; float* C; __device__ void operator()(int m, int n, f32x4 v) const { const f32x4 g = ld_bf4(G + (long)m * D_ + n);
    *(f32x4*)(C + (long)m * D_ + n) = (f32x4){sigmoidf_(g.x) * v.x, sigmoidf_(g.y) * v.y, sigmoidf_(g.z) * v.z, sigmoidf_(g.w) * v.w}; } };
struct EpiGate2 { const bf16* G; const float* Tm; bf16* C; __device__ void operator()(int m, int n, f32x4 v) const { const f32x4 g = ld_bf4(G + (long)m * D_ + n); const f32x4 t = *(const f32x4*)(Tm + (long)m * D_ + n);
    st_bf4(C + (long)m * D_ + n, (f32x4){t.x + sigmoidf_(g.x) * v.x, t.y + sigmoidf_(g.y) * v.y, t.z + sigmoidf_(g.z) * v.z, t.w + sigmoidf_(g.w) * v.w}); } };
struct EpiResid { const float* R; float* C; __device__ void operator()(int m, int n, f32x4 v) const { *(f32x4*)(C + (long)m * D_ + n) = *(const f32x4*)(R + (long)m * D_ + n) + v; } };
struct EpiSwiglu { const float* G; bf16* C; __device__ void operator()(int m, int n, f32x4 v) const { const f32x4 g = *(const f32x4*)(G + (long)m * FF + n);
    st_bf4(C + (long)m * FF + n, (f32x4){g.x * sigmoidf_(g.x) * v.x, g.y * sigmoidf_(g.y) * v.y, g.z * sigmoidf_(g.z) * v.z, g.w * sigmoidf_(g.w) * v.w}); } };
struct EpiRowScale { const float* aff; const int* gidx; bf16* C; int e; int pad; __device__ void operator()(int m, int n, f32x4 v) const { const float a = aff[gidx[m] * NE + e]; st_bf4(C + (long)m * D_ + n, v * a); } };
struct EpiPle { const float* Pt; float* Hh; __device__ void operator()(int m, int n, f32x4 v) const { const f32x4 t = *(const f32x4*)(Pt + (long)m * D_ + n); f32x4 h = *(const f32x4*)(Hh + (long)m * D_ + n);
    h += (f32x4){sigmoidf_(v.x) * t.x, sigmoidf_(v.y) * t.y, sigmoidf_(v.z) * t.z, sigmoidf_(v.w) * t.w}; *(f32x4*)(Hh + (long)m * D_ + n) = h; } };

template <bool OBF>
__global__ void __launch_bounds__(256) rmsnorm_rows(const float* X, const float* g, void* Y) {
    const int row = blockIdx.x * 4 + (threadIdx.x >> 6), lane = threadIdx.x & 63;
    const f32x4* xr = (const f32x4*)(X + (long)row * D_) + lane;
    f32x4 v[4]; float s = 0.f;
#pragma unroll
    for (int j = 0; j < 4; ++j) { v[j] = xr[64 * j]; s += v[j].x * v[j].x + v[j].y * v[j].y + v[j].z * v[j].z + v[j].w * v[j].w; }
    const float r = 1.0f / sqrtf(wave_sum(s) * (1.0f / D_) + EPS);
    const f32x4* gr = (const f32x4*)g + lane;
#pragma unroll
    for (int j = 0; j < 4; ++j) { const f32x4 y = v[j] * r * gr[64 * j];
        if (OBF) st_bf4((bf16*)Y + (long)row * D_ + 4 * (lane + 64 * j), y); else *((f32x4*)((float*)Y + (long)row * D_) + lane + 64 * j) = y; }
}
__global__ void __launch_bounds__(256) rope_table(const int* pos, float* RT) {
    const int gid = blockIdx.x * 256 + threadIdx.x; if (gid >= T_ * 8) return;
    const int i = gid & 7, t = gid >> 3;
    const float invf[8] = {1.0f, 0.1939227432012558f, 0.03760603070259094f, 0.007292664609849453f, 0.0014142135623842478f, 0.00027424818836152554f, 5.3182957344688475e-05f, 1.0313385246263351e-05f};
    const float ang = (float)pos[t] * invf[i];
    RT[t * 16 + i] = cosf(ang); RT[t * 16 + 8 + i] = sinf(ang);
}
__global__ void __launch_bounds__(256) rope_cvt(const float* qkv, const float* RT, bf16* O) {
    const long gid = (long)blockIdx.x * 256 + threadIdx.x; if (gid >= (long)T_ * 768) return;
    const int c = gid % 768; const long t = gid / 768;
    float v = qkv[gid];
    if (c < 640) { const int dd = c & 63; if (dd < 16) { const int i = dd & 7; const float cs = RT[t * 16 + i], sn = RT[t * 16 + 8 + i];
            if (dd < 8) v = v * cs - qkv[gid + 8] * sn; else v = v * cs + qkv[gid - 8] * sn; } }
    if (c < 512) v *= QSCALE;
    O[gid] = (bf16)f2bf(v);
}
__global__ void __launch_bounds__(256) attn(const bf16* qkv, const float* sink, bf16* out) {
    const int h = blockIdx.y, t = blockIdx.x * 256 + threadIdx.x;
    const int b = t / S_, i = t % S_, kvh = h >> 2;
    float q[64];
    const bf16* qp = qkv + (long)t * 768 + h * 64;
#pragma unroll
    for (int d = 0; d < 64; ++d) q[d] = bf2f(qp[d]);
    const int j0 = max(0, i - 128), j1 = min(S_ - 1, i + 128);
    const float sk = sink[h] * LOG2E;
    float m = sk;
    for (int j = j0; j <= j1; ++j) {
        const bf16* kp = qkv + (long)(b * S_ + j) * 768 + 512 + kvh * 64;
        float s = 0.f;
#pragma unroll
        for (int d = 0; d < 64; ++d) s = fmaf(q[d], bf2f(kp[d]), s);
        m = fmaxf(m, s);
    }
    float o[64];
#pragma unroll
    for (int d = 0; d < 64; ++d) o[d] = 0.f;
    float l = exp2f(sk - m);
    for (int j = j0; j <= j1; ++j) {
        const bf16* kp = qkv + (long)(b * S_ + j) * 768 + 512 + kvh * 64;
        const bf16* vp = kp + 128;
        float s = 0.f;
#pragma unroll
        for (int d = 0; d < 64; ++d) s = fmaf(q[d], bf2f(kp[d]), s);
        const float p = exp2f(s - m);
        l += p;
#pragma unroll
        for (int d = 0; d < 64; ++d) o[d] = fmaf(p, bf2f(vp[d]), o[d]);
    }
    const float rl = 1.0f / l;
    bf16* op = out + (long)t * 512 + h * 64;
#pragma unroll
    for (int d = 0; d < 64; ++d) op[d] = (bf16)f2bf(o[d] * rl);
}
__global__ void __launch_bounds__(256) gla_recur(const bf16* qk, const bf16* v, const float* z, const float* up, const float* bias, bf16* o, int dir) {
    __shared__ float sq[32][128], sk[32][128], sa[32][128];
    __shared__ float sv[32][8], so[32][8];
    const int tid = threadIdx.x, w = tid >> 6, lane = tid & 63;
    const int es = blockIdx.x, h = blockIdx.y, b = blockIdx.z, e0 = es * 8;
    const int el = w * 2 + (lane >> 5), dg = lane & 31, d0 = dg * 4;
    float S[4] = {0.f, 0.f, 0.f, 0.f};
    for (int c = 0; c < S_ / 32; ++c) {
        __syncthreads();
        for (int idx = tid; idx < 32 * 128; idx += 256) {
            const int j = idx >> 7, d = idx & 127;
            const int il = c * 32 + j; const int t = dir ? (S_ - 1 - il) : il;
            const long row = (long)(b * S_ + t);
            sq[j][d] = bf2f(qk[row * 1024 + h * 128 + d]); sk[j][d] = bf2f(qk[row * 1024 + 512 + h * 128 + d]);
            float x = bias[h * 128 + d];
#pragma unroll
            for (int r = 0; r < 16; ++r) x = fmaf(z[row * 32 + dir * 16 + r], up[r * 512 + h * 128 + d], x);
            const float ls = fminf(x, 0.f) - log1pf(expf(-fabsf(x)));
            sa[j][d] = expf(ls * (1.0f / 16.0f));
        }
        {
            const int j = tid >> 3, e = tid & 7;
            const int il = c * 32 + j; const int t = dir ? (S_ - 1 - il) : il;
            sv[j][e] = bf2f(v[(long)(b * S_ + t) * 1024 + h * 256 + e0 + e]);
        }
        __syncthreads();
        for (int j = 0; j < 32; ++j) {
            const f32x4 a4 = *(const f32x4*)&sa[j][d0], k4 = *(const f32x4*)&sk[j][d0], q4 = *(const f32x4*)&sq[j][d0];
            const float vv = sv[j][el];
            float part;
            if (!dir) {
                S[0] = fmaf(a4.x, S[0], k4.x * vv); S[1] = fmaf(a4.y, S[1], k4.y * vv); S[2] = fmaf(a4.z, S[2], k4.z * vv); S[3] = fmaf(a4.w, S[3], k4.w * vv);
                part = q4.x * S[0] + q4.y * S[1] + q4.z * S[2] + q4.w * S[3];
            } else {
                S[0] *= a4.x; S[1] *= a4.y; S[2] *= a4.z; S[3] *= a4.w;
                part = q4.x * S[0] + q4.y * S[1] + q4.z * S[2] + q4.w * S[3];
                S[0] = fmaf(k4.x, vv, S[0]); S[1] = fmaf(k4.y, vv, S[1]); S[2] = fmaf(k4.z, vv, S[2]); S[3] = fmaf(k4.w, vv, S[3]);
            }
#pragma unroll
            for (int off = 1; off < 32; off <<= 1) part += __shfl_xor(part, off);
            if (dg == 0) so[j][el] = part;
        }
        __syncthreads();
        {
            const int j = tid >> 3, e = tid & 7;
            const int il = c * 32 + j; const int t = dir ? (S_ - 1 - il) : il;
            o[(long)(b * S_ + t) * 1024 + h * 256 + e0 + e] = (bf16)f2bf(so[j][e]);
        }
    }
}
__global__ void __launch_bounds__(256) gla_post(const bf16* OF, const bf16* OB, const bf16* GR, const float* gain, bf16* GLAO) {
    const int gw = blockIdx.x * 4 + (threadIdx.x >> 6), lane = threadIdx.x & 63;
    const int h = gw & 3; const long t = gw >> 2; const long off = t * 1024 + h * 256 + lane * 4;
    const f32x4 x = ld_bf4(OF + off) + ld_bf4(OB + off);
    const float s = wave_sum(x.x * x.x + x.y * x.y + x.z * x.z + x.w * x.w);
    const float r = 1.0f / sqrtf(s * (1.0f / 256.0f) + EPS);
    const f32x4 g = *(const f32x4*)(gain + h * 256 + lane * 4); const f32x4 gr = ld_bf4(GR + off);
    st_bf4(GLAO + off, (f32x4){x.x * r * g.x * gr.x * sigmoidf_(gr.x), x.y * r * g.y * gr.y * sigmoidf_(gr.y), x.z * r * g.z * gr.z * sigmoidf_(gr.z), x.w * r * g.w * gr.w * sigmoidf_(gr.w)});
}
__global__ void __launch_bounds__(256) norm_router(const float* H, const float* g, const float* wr, bf16* XN, float* aff) {
    const int row = blockIdx.x * 4 + (threadIdx.x >> 6), lane = threadIdx.x & 63;
    const f32x4* xr = (const f32x4*)(H + (long)row * D_) + lane;
    f32x4 v[4]; float s = 0.f;
#pragma unroll
    for (int j = 0; j < 4; ++j) { v[j] = xr[64 * j]; s += v[j].x * v[j].x + v[j].y * v[j].y + v[j].z * v[j].z + v[j].w * v[j].w; }
    const float r = 1.0f / sqrtf(wave_sum(s) * (1.0f / D_) + EPS);
    float lg[16];
#pragma unroll
    for (int e = 0; e < 16; ++e) lg[e] = 0.f;
#pragma unroll
    for (int j = 0; j < 4; ++j) { const f32x4 y = v[j] * r * ((const f32x4*)g)[lane + 64 * j]; st_bf4(XN + (long)row * D_ + 4 * (lane + 64 * j), y);
        const int k = 4 * (lane + 64 * j);
#pragma unroll
        for (int e = 0; e < 16; ++e) lg[e] += y.x * wr[(k + 0) * 16 + e] + y.y * wr[(k + 1) * 16 + e] + y.z * wr[(k + 2) * 16 + e] + y.w * wr[(k + 3) * 16 + e]; }
    float m = -INFINITY;
#pragma unroll
    for (int e = 0; e < 16; ++e) { lg[e] = wave_sum(lg[e]); m = fmaxf(m, lg[e]); }
    float sum = 0.f;
#pragma unroll
    for (int e = 0; e < 16; ++e) { lg[e] = expf(lg[e] - m); sum += lg[e]; }
    if (lane < 16) { float val = 0.f;
#pragma unroll
        for (int e = 0; e < 16; ++e) if (lane == e) val = lg[e];
        aff[row * 16 + lane] = val / sum; }
}
__global__ void __launch_bounds__(256) topk_rank(const float* aff, int* gidx, int* inv) {
    __shared__ float sa[S_];
    const int e = blockIdx.y, b = blockIdx.z;
    for (int s = threadIdx.x; s < S_; s += 256) sa[s] = aff[(long)(b * S_ + s) * 16 + e];
    __syncthreads();
    const int s = blockIdx.x * 256 + threadIdx.x;
    const float a = sa[s];
    int rank = 0;
    for (int s2 = 0; s2 < S_; ++s2) { const float a2 = sa[s2]; rank += (a2 > a || (a2 == a && s2 < s)) ? 1 : 0; }
    if (rank < CAP) gidx[e * ME + b * CAP + rank] = b * S_ + s;
    inv[(b * S_ + s) * 16 + e] = rank < CAP ? b * CAP + rank : -1;
}
__global__ void __launch_bounds__(256) combine_norm(float* H, const bf16* Y, const int* inv, const float* g, bf16* XN3) {
    const int row = blockIdx.x * 4 + (threadIdx.x >> 6), lane = threadIdx.x & 63;
    f32x4* xr = (f32x4*)(H + (long)row * D_) + lane;
    f32x4 v[4];
#pragma unroll
    for (int j = 0; j < 4; ++j) v[j] = xr[64 * j];
    for (int e = 0; e < 16; ++e) { const int sl = inv[row * 16 + e]; if (sl >= 0) { const bf16* yp = Y + ((long)e * ME + sl) * D_;
#pragma unroll
            for (int j = 0; j < 4; ++j) v[j] += ld_bf4(yp + 4 * (lane + 64 * j)); } }
    float s = 0.f;
#pragma unroll
    for (int j = 0; j < 4; ++j) { xr[64 * j] = v[j]; s += v[j].x * v[j].x + v[j].y * v[j].y + v[j].z * v[j].z + v[j].w * v[j].w; }
    const float r = 1.0f / sqrtf(wave_sum(s) * (1.0f / D_) + EPS);
#pragma unroll
    for (int j = 0; j < 4; ++j) st_bf4(XN3 + (long)row * D_ + 4 * (lane + 64 * j), v[j] * r * ((const f32x4*)g)[lane + 64 * j]);
}

static void P0(hipStream_t st, const Params& P) {
    hipLaunchKernelGGL(rmsnorm_rows<true>, dim3(T_ / 4), dim3(256), 0, st, P.x, P.norm_mix, (void*)(P.ws + WS_A0));
    hipLaunchKernelGGL(rope_table, dim3(T_ * 8 / 256), dim3(256), 0, st, P.pos, (float*)(P.ws + WS_ROPE));
}
static void P1(hipStream_t st, const Params& P) {
    const bf16* A0 = (const bf16*)(P.ws + WS_A0);
    launch_gemm<true>(st, A0, D_, nullptr, P.w_in + C_Q, IN_DIM, T_, 768, D_, EpiF32{P.out, 768, 0});
    hipLaunchKernelGGL(rope_cvt, dim3(T_ * 768 / 256), dim3(256), 0, st, P.out, (const float*)(P.ws + WS_ROPE), (bf16*)(P.ws + WS_QKV));
    launch_gemm<true>(st, A0, D_, nullptr, P.w_in + C_GQ, IN_DIM, T_, 1024, D_, EpiBf{(bf16*)(P.ws + WS_GQK), D_, GQSCALE, 512, 0});
    launch_gemm<true>(st, A0, D_, nullptr, P.w_in + C_GV, IN_DIM, T_, 1024, D_, EpiBf{(bf16*)(P.ws + WS_GV), D_, 1.f, 0, 0});
    launch_gemm<true>(st, A0, D_, nullptr, P.w_in + C_GR, IN_DIM, T_, 1024, D_, EpiBf{(bf16*)(P.ws + WS_GR), D_, 1.f, 0, 0});
    launch_gemm<true>(st, A0, D_, nullptr, P.w_in + C_GATT, IN_DIM, T_, 1024, D_, EpiBf{(bf16*)(P.ws + WS_GATT), D_, 1.f, 0, 0});
    launch_gemm<true>(st, A0, D_, nullptr, P.w_in + C_GGLA, IN_DIM, T_, 1024, D_, EpiBf{(bf16*)(P.ws + WS_GGLA), D_, 1.f, 0, 0});
    launch_gemm<true>(st, A0, D_, nullptr, P.w_in + C_ZF, IN_DIM, T_, 32, D_, EpiF32{(float*)(P.ws + WS_Z), 32, 0});
}
static void P2_attn(hipStream_t st, const Params& P) {
    hipLaunchKernelGGL(attn, dim3(T_ / 256, 8), dim3(256), 0, st, (const bf16*)(P.ws + WS_QKV), P.sink, (bf16*)(P.ws + WS_ATT));
}
static void P2_gla(hipStream_t st, const Params& P) {
    hipLaunchKernelGGL(gla_recur, dim3(32, 4, 4), dim3(256), 0, st, (const bf16*)(P.ws + WS_GQK), (const bf16*)(P.ws + WS_GV), (const float*)(P.ws + WS_Z), P.up_f, P.bias_f, (bf16*)(P.ws + WS_OF), 0);
    hipLaunchKernelGGL(gla_recur, dim3(32, 4, 4), dim3(256), 0, st, (const bf16*)(P.ws + WS_GQK), (const bf16*)(P.ws + WS_GV), (const float*)(P.ws + WS_Z), P.up_b, P.bias_b, (bf16*)(P.ws + WS_OB), 1);
}
static void P3(hipStream_t st, const Params& P) {
    hipLaunchKernelGGL(gla_post, dim3(T_), dim3(256), 0, st, (const bf16*)(P.ws + WS_OF), (const bf16*)(P.ws + WS_OB), (const bf16*)(P.ws + WS_GR), P.gla_norm, (bf16*)(P.ws + WS_GLAO));
    launch_gemm<true>(st, P.ws + WS_ATT, 512, nullptr, P.w_ba, D_, T_, D_, 512, EpiGate1{(const bf16*)(P.ws + WS_GATT), P.out});
    launch_gemm<true>(st, P.ws + WS_GLAO, D_, nullptr, P.w_bg, D_, T_, D_, D_, EpiGate2{(const bf16*)(P.ws + WS_GGLA), P.out, (bf16*)(P.ws + WS_MERGED)});
}
static void P4(hipStream_t st, const Params& P) {
    launch_gemm<true>(st, P.ws + WS_MERGED, D_, nullptr, P.w_out, D_, T_, D_, D_, EpiResid{P.x, (float*)(P.ws + WS_H)});
    hipLaunchKernelGGL(norm_router, dim3(T_ / 4), dim3(256), 0, st, (const float*)(P.ws + WS_H), P.norm_ffn, P.w_router, (bf16*)(P.ws + WS_XN), (float*)(P.ws + WS_AFF));
}
static void P5(hipStream_t st, const Params& P) {
    hipLaunchKernelGGL(topk_rank, dim3(S_ / 256, NE, B_), dim3(256), 0, st, (const float*)(P.ws + WS_AFF), (int*)(P.ws + WS_GIDX), (int*)(P.ws + WS_INV));
}
static void P6(hipStream_t st, const Params& P) {
    for (int e = 0; e < NE; ++e) { const size_t wo = (size_t)e * D_ * FF; const int* gi = (const int*)(P.ws + WS_GIDX) + e * ME;
        launch_gemm<true>(st, P.ws + WS_XN, D_, gi, P.w_eg + wo, FF, ME, FF, D_, EpiF32{P.out, FF, 0});
        launch_gemm<true>(st, P.ws + WS_XN, D_, gi, P.w_eu + wo, FF, ME, FF, D_, EpiSwiglu{P.out, (bf16*)(P.ws + WS_HID) + (size_t)e * ME * FF}); }
}
static void P7(hipStream_t st, const Params& P) {
    for (int e = 0; e < NE; ++e) { const size_t wo = (size_t)e * D_ * FF; const int* gi = (const int*)(P.ws + WS_GIDX) + e * ME;
        launch_gemm<true>(st, (bf16*)(P.ws + WS_HID) + (size_t)e * ME * FF, FF, nullptr, P.w_ed + wo, D_, ME, D_, FF, EpiRowScale{(const float*)(P.ws + WS_AFF), gi, (bf16*)P.out + (size_t)e * ME * D_, e, 0}); }
}
static void P8(hipStream_t st, const Params& P) {
    hipLaunchKernelGGL(combine_norm, dim3(T_ / 4), dim3(256), 0, st, (float*)(P.ws + WS_H), (const bf16*)P.out, (const int*)(P.ws + WS_INV), P.norm_ple, (bf16*)(P.ws + WS_XN3));
}
static void P9(hipStream_t st, const Params& P) {
    launch_gemm<false>(st, P.p, PLE, nullptr, P.w_ple, D_, T_, D_, PLE, EpiF32{(float*)(P.ws + WS_PLET), D_, 0});
    launch_gemm<true>(st, P.ws + WS_XN3, D_, nullptr, P.w_pg, D_, T_, D_, D_, EpiPle{(const float*)(P.ws + WS_PLET), (float*)(P.ws + WS_H)});
}
static void P10(hipStream_t st, const Params& P) {
    hipLaunchKernelGGL(rmsnorm_rows<false>, dim3(T_ / 4), dim3(256), 0, st, (const float*)(P.ws + WS_H), P.norm_final, (void*)P.out);
}
}
namespace pg8 {
#define PG8_LAS __attribute__((address_space(3)))
typedef short bf16x8 __attribute__((ext_vector_type(8)));
constexpr int BM = 256, BK = 64, HALF = 128, HTB = HALF * BK * 2  , STAGE_BYTES = 8 * HTB;

__host__ __device__ __forceinline__ int lds_byte(int r, int c) { const int st = (r >> 4) * 2 + (c >> 5), rr = r & 15, cc = c & 31, ob = rr * 64 + cc * 2; return st * 1024 + (ob ^ (((ob >> 9) & 1) << 5)); }
__host__ __device__ __forceinline__ void stage_rc(int b, int& R, int& C) { const int st = b / 1024, sb = b % 1024, swz = sb ^ (((sb >> 9) & 1) << 5); R = (st >> 1) * 16 + swz / 64; C = (st & 1) * 32 + (swz % 64) / 2; }
__host__ __device__ __forceinline__ int perm32(int rho) { const int n = rho >> 4, i = rho & 15; return 8 * (i >> 2) + 4 * n + (i & 3); }

struct Unit { const char* a; const char* b0; const char* b1; const int* gi; int pm, pn, e, pad; };

__device__ __forceinline__ unsigned cvt_pk_bf16(float lo, float hi) { unsigned r; asm volatile("v_cvt_pk_bf16_f32 %0, %1, %2" : "=v"(r) : "v"(lo), "v"(hi)); return r; }

template <class Epi, class Sched, bool GATHER, bool ALIGN_EPI>
__device__ __forceinline__ void gemm_phase(PG8_LAS unsigned char* lds, const int K, const Sched& S, const Epi& E) {
    const int tid = threadIdx.x, wid = __builtin_amdgcn_readfirstlane(tid >> 6), lane = tid & 63, wr = wid >> 2, wc = wid & 3, fr = lane & 15, fq = lane >> 4;
    const int nt = K / BK;
    int sR[2], sC[2];
    unsigned voffB[2], voffA[2][2];
#pragma unroll
    for (int i = 0; i < 2; ++i) { stage_rc(tid * 16 + i * 8192, sR[i], sC[i]); const int Rb = Epi::PERM ? ((sR[i] & ~31) + perm32(sR[i] & 31)) : sR[i];
        voffB[i] = (unsigned)(Rb * K + sC[i]) * 2u;
        voffA[0][i] = (unsigned)(sR[i] * K + sC[i]) * 2u; voffA[1][i] = (unsigned)((sR[i] + HALF) * K + sC[i]) * 2u; }
    const size_t kstep = (size_t)(BK * 2);
    const unsigned ldsw = (unsigned)wid * 1024u;
    const int aoff = lds_byte(wr * 64 + fr, fq * 8), boff = lds_byte(wc * 32 + fr, fq * 8);
#define PG8_SA(b, h) (((b) * 2 + (h)) * HTB)
#define PG8_SB(b, h) ((4 + (b) * 2 + (h)) * HTB)
#define PG8_STAGE(bufoff, gbase, voff) do { _Pragma("unroll") for (int _i = 0; _i < 2; ++_i) \
        __builtin_amdgcn_global_load_lds((const unsigned*)((const char*)(gbase) + (voff)[_i]), (PG8_LAS unsigned*)(lds + (bufoff) + ldsw + _i * 8192), 16, 0, 0); } while (0)
#define PG8_LDA(dst, b, h) do { _Pragma("unroll") for (int m = 0; m < 4; ++m) _Pragma("unroll") for (int k = 0; k < 2; ++k) dst[m][k] = *(const PG8_LAS bf16x8*)(lds + PG8_SA(b, h) + aoff + m * 2048 + k * 1024); } while (0)
#define PG8_LDB(dst, b, h) do { _Pragma("unroll") for (int n = 0; n < 2; ++n) _Pragma("unroll") for (int k = 0; k < 2; ++k) dst[n][k] = *(const PG8_LAS bf16x8*)(lds + PG8_SB(b, h) + boff + n * 2048 + k * 1024); } while (0)
#define PG8_MMA(ai, bj, At, Bt) do { __builtin_amdgcn_s_setprio(1); _Pragma("unroll") for (int m = 0; m < 4; ++m) _Pragma("unroll") for (int n = 0; n < 2; ++n) _Pragma("unroll") for (int k = 0; k < 2; ++k) \
        acc[ai][bj][m][n] = __builtin_amdgcn_mfma_f32_16x16x32_bf16(Bt[n][k], At[m][k], acc[ai][bj][m][n], 0, 0, 0); __builtin_amdgcn_s_setprio(0); } while (0)
#define PG8_WAIT_V(n) asm volatile("s_waitcnt vmcnt(" #n ")" ::: "memory")
#define PG8_WAIT_L(n) asm volatile("s_waitcnt lgkmcnt(" #n ")" ::: "memory")
#define PG8_BAR __builtin_amdgcn_s_barrier()
#define PG8_SCHED __builtin_amdgcn_sched_barrier(0)
    Unit cur, nxt; int ui = 0;
    if (!S.next(0, cur)) return;
    if constexpr (GATHER) {
#pragma unroll
        for (int h = 0; h < 2; ++h)
#pragma unroll
            for (int i = 0; i < 2; ++i) voffA[h][i] = (unsigned)(cur.gi[h * HALF + sR[i]] * K + sC[i]) * 2u;
    }
    f32x4 acc[2][2][4][2];
#pragma unroll
    for (int a = 0; a < 2; ++a)
#pragma unroll
        for (int b = 0; b < 2; ++b)
#pragma unroll
            for (int m = 0; m < 4; ++m)
#pragma unroll
                for (int n = 0; n < 2; ++n) acc[a][b][m][n] = (f32x4){0.f, 0.f, 0.f, 0.f};
    bf16x8 At[4][2], B0[2][2], B1[2][2];
    const char* cA = cur.a; const char* cB0 = cur.b0; const char* cB1 = cur.b1;
    PG8_STAGE(PG8_SB(0, 0), cB0, voffB); PG8_STAGE(PG8_SB(0, 1), cB1, voffB); PG8_STAGE(PG8_SA(0, 0), cA, voffA[0]); PG8_STAGE(PG8_SA(0, 1), cA, voffA[1]);
    if (wr == 1) PG8_BAR;
    PG8_WAIT_V(2); PG8_BAR;
    PG8_STAGE(PG8_SB(1, 0), cB0 + kstep, voffB); PG8_STAGE(PG8_SA(1, 0), cA + kstep, voffA[0]); PG8_STAGE(PG8_SB(1, 1), cB1 + kstep, voffB);
    PG8_WAIT_V(6); PG8_BAR;
    for (;;) {
        const bool has_next = S.next(ui + 1, nxt);
        unsigned voffN[2][2];
#pragma unroll
        for (int h = 0; h < 2; ++h)
#pragma unroll
            for (int i = 0; i < 2; ++i) voffN[h][i] = voffA[h][i];
        if constexpr (GATHER) { if (has_next) {
#pragma unroll
            for (int h = 0; h < 2; ++h)
#pragma unroll
                for (int i = 0; i < 2; ++i) voffN[h][i] = (unsigned)(nxt.gi[h * HALF + sR[i]] * K + sC[i]) * 2u; } }
        const char* nA = has_next ? nxt.a : cA; const char* nB0 = has_next ? nxt.b0 : cB0; const char* nB1 = has_next ? nxt.b1 : cB1;
        for (int t = 0; t < nt; t += 2) {
            const bool last = (t == nt - 2);
            const char* a1 = cA + (size_t)(t + 1) * kstep;
            const char* a2 = last ? nA : cA + (size_t)(t + 2) * kstep;
            const char* b20 = last ? nB0 : cB0 + (size_t)(t + 2) * kstep; const char* b21 = last ? nB1 : cB1 + (size_t)(t + 2) * kstep;
            const char* a3 = a2 + kstep; const char* b30 = b20 + kstep; const char* b31 = b21 + kstep;
            unsigned va0[2], va1[2];
#pragma unroll
            for (int i = 0; i < 2; ++i) { va0[i] = last ? voffN[0][i] : voffA[0][i]; va1[i] = last ? voffN[1][i] : voffA[1][i]; }
            PG8_LDB(B0, 0, 0); PG8_LDB(B1, 0, 1); PG8_SCHED; PG8_LDA(At, 0, 0); PG8_STAGE(PG8_SA(1, 1), a1, voffA[1]);
            PG8_WAIT_V(8); PG8_WAIT_L(0); PG8_BAR; PG8_MMA(0, 0, At, B0); PG8_MMA(0, 1, At, B1); PG8_BAR; PG8_SCHED;
            PG8_LDA(At, 0, 1); PG8_STAGE(PG8_SB(0, 0), b20, voffB); PG8_STAGE(PG8_SB(0, 1), b21, voffB); PG8_STAGE(PG8_SA(0, 0), a2, va0);
            PG8_WAIT_V(8); PG8_WAIT_L(0); PG8_BAR; PG8_MMA(1, 0, At, B0); PG8_MMA(1, 1, At, B1); PG8_BAR; PG8_SCHED;
            PG8_LDB(B0, 1, 0); PG8_LDB(B1, 1, 1); PG8_SCHED; PG8_LDA(At, 1, 0); PG8_STAGE(PG8_SA(0, 1), a2, va1);
            PG8_WAIT_V(8); PG8_WAIT_L(0); PG8_BAR; PG8_MMA(0, 0, At, B0); PG8_MMA(0, 1, At, B1); PG8_BAR; PG8_SCHED;
            PG8_LDA(At, 1, 1); PG8_STAGE(PG8_SB(1, 0), b30, voffB); PG8_STAGE(PG8_SB(1, 1), b31, voffB); PG8_STAGE(PG8_SA(1, 0), a3, va0);
            PG8_WAIT_V(8); PG8_WAIT_L(0); PG8_BAR; PG8_MMA(1, 0, At, B0); PG8_MMA(1, 1, At, B1); PG8_BAR; PG8_SCHED;
        }
        if constexpr (ALIGN_EPI) { if (wr == 0) PG8_BAR; }
        E(acc, cur, wr, wc, fr, fq);
        if (!has_next) break;
#pragma unroll
        for (int a = 0; a < 2; ++a)
#pragma unroll
            for (int b = 0; b < 2; ++b)
#pragma unroll
                for (int m = 0; m < 4; ++m)
#pragma unroll
                    for (int n = 0; n < 2; ++n) acc[a][b][m][n] = (f32x4){0.f, 0.f, 0.f, 0.f};
        cur = nxt; cA = nA; cB0 = nB0; cB1 = nB1; ++ui;
#pragma unroll
        for (int h = 0; h < 2; ++h)
#pragma unroll
            for (int i = 0; i < 2; ++i) voffA[h][i] = voffN[h][i];
        if constexpr (ALIGN_EPI) { if (wr == 1) PG8_BAR; }
    }
    PG8_WAIT_V(0);
    if constexpr (!ALIGN_EPI) { if (wr == 0) PG8_BAR; }
    PG8_BAR;
#undef PG8_SA
#undef PG8_SB
#undef PG8_STAGE
#undef PG8_LDA
#undef PG8_LDB
#undef PG8_MMA
#undef PG8_WAIT_V
#undef PG8_WAIT_L
#undef PG8_BAR
#undef PG8_SCHED
}

struct DenseOrder {
    const char* A; const char* Bt; int K, nM, nN, nwg, G, c;
    __device__ void init(const void* A_, const void* Bt_, int M, int N, int K_, int G_, int c_) { A = (const char*)A_; Bt = (const char*)Bt_; K = K_; nM = M / BM; nN = N / BM; nwg = nM * nN; G = G_; c = c_; }
    __device__ bool next(int i, Unit& u) const {
        const long L = (long)i * G + c; if (L >= nwg) return false;
        int wgid = (int)L; { const int q = nwg / 8, r = nwg % 8, xcd = wgid % 8, off = wgid / 8; wgid = (xcd < r ? xcd * (q + 1) : r * (q + 1) + (xcd - r) * q) + off; }
        const int nig = 8 * nN, gid = wgid / nig, fm = gid * 8, gsz = (nM - fm) < 8 ? (nM - fm) : 8;
        u.pm = fm + ((wgid % nig) % gsz); u.pn = (wgid % nig) / gsz; u.e = 0; u.pad = 0; u.gi = nullptr;
        u.a = A + (size_t)u.pm * BM * K * 2; u.b0 = Bt + (size_t)u.pn * BM * K * 2; u.b1 = u.b0 + (size_t)HALF * K * 2; return true;
    }
};
}
namespace mk {
constexpr int NWAVES = 8, NT = NWAVES * 64;
constexpr int RING_OFF = 0, RING_BYTES = 131072;
constexpr int LDSCTL_OFF = RING_BYTES, MISC_OFF = LDSCTL_OFF + 320;
constexpr int LDS_BYTES = 147456;
#define GAS __attribute__((address_space(1)))
#define LAS __attribute__((address_space(3)))
typedef GAS unsigned gu32;
#define RLX_AGENT __ATOMIC_RELAXED, __HIP_MEMORY_SCOPE_AGENT
#define LDS_WAIT() asm volatile("s_waitcnt lgkmcnt(0)" ::: "memory")
#define VM_WAIT() asm volatile("s_waitcnt vmcnt(0)" ::: "memory")

#define XB_TMO      128
#define XB_XCNT(j)  (256  + 64 * (j))
#define XB_XSUB(j)  (1280 + 64 * (j))
#define XB_XGEN(j)  (2304 + 64 * (j))
#define XB_TOP      3328
#define XB_TOPGEN   3392
#define XCD_BAR_WORDS 3456
#define XB_SPIN_CAP (1u << 18)
__device__ __forceinline__ unsigned xb_ld(unsigned* p)              { return __hip_atomic_load(p, __ATOMIC_RELAXED, __HIP_MEMORY_SCOPE_AGENT); }
__device__ __forceinline__ unsigned xb_add(unsigned* p, unsigned v) { return __hip_atomic_fetch_add(p, v, __ATOMIC_RELAXED, __HIP_MEMORY_SCOPE_AGENT); }
__device__ __forceinline__ unsigned xb_xcc_id() { return (unsigned)__builtin_amdgcn_s_getreg((3 << 11) | 20) & 0xFu; }
#define XB_SPIN(cond, bar) do { unsigned _sp = 0; while (cond) { __builtin_amdgcn_s_sleep(1); \
    if ((++_sp & 255u) == 0u) { if (xb_ld(&(bar)[XB_TMO])) break; if (_sp > XB_SPIN_CAP) { atomicAdd(&(bar)[XB_TMO], 1u); break; } } } } while (0)
struct XcdBarrier { unsigned* bar; unsigned x; volatile LAS unsigned* st; };
__device__ __forceinline__ XcdBarrier xcd_barrier_post(unsigned* bar, volatile LAS unsigned* st) {
    XcdBarrier b; b.bar = bar; b.x = xb_xcc_id(); b.st = st;
    if (threadIdx.x == 0) (void)xb_add(&bar[XB_XCNT(b.x)], 1u);
    return b;
}
__device__ __forceinline__ void xcd_barrier_complete(unsigned* bar, unsigned x, unsigned& nloc, unsigned& nx) {
    const unsigned G = gridDim.x * gridDim.y * gridDim.z;
    unsigned sum, cnt, mine, sp = 0u;
    for (;;) {
        sum = 0u; cnt = 0u; mine = 0u;
#pragma unroll
        for (unsigned j = 0; j < 16; ++j) { const unsigned c = xb_ld(&bar[XB_XCNT(j)]); sum += c; cnt += (c > 0u) ? 1u : 0u; mine = (j == x) ? c : mine; }
        if (sum == G) break;
        __builtin_amdgcn_s_sleep(1);
        if ((++sp & 255u) == 0u) { if (xb_ld(&bar[XB_TMO])) break; if (sp > XB_SPIN_CAP) { atomicAdd(&bar[XB_TMO], 1u); break; } }
    }
    nloc = mine > 0u ? mine : 1u; nx = cnt > 0u ? cnt : 1u;
}
__device__ __forceinline__ void xcd_barrier(const XcdBarrier& b) {
    asm volatile("s_waitcnt vmcnt(0)" ::: "memory");
    __syncthreads();
    if (threadIdx.x == 0) {
        unsigned* bar = b.bar;
        __builtin_amdgcn_s_waitcnt(0);
        unsigned nloc = b.st[0], nx = b.st[1];
        if (nloc == 0u) { xcd_barrier_complete(bar, b.x, nloc, nx); b.st[0] = nloc; b.st[1] = nx; }
        const unsigned old = xb_add(&bar[XB_XSUB(b.x)], 1u);
        const unsigned gen = old / nloc;
        if (old + 1u == (gen + 1u) * nloc) {
            __builtin_amdgcn_fence(__ATOMIC_RELEASE, "agent");
            asm volatile("s_waitcnt vmcnt(0)" ::: "memory");
            const unsigned og = xb_add(&bar[XB_TOP], 1u);
            const unsigned tg = og / nx;
            if (og + 1u == (tg + 1u) * nx) xb_add(&bar[XB_TOPGEN], 1u);
            else XB_SPIN(xb_ld(&bar[XB_TOPGEN]) == tg, bar);
            __builtin_amdgcn_fence(__ATOMIC_ACQUIRE, "agent");
            xb_add(&bar[XB_XGEN(b.x)], 1u);
            asm volatile("s_waitcnt vmcnt(0)" ::: "memory");
        } else {
            XB_SPIN(xb_ld(&bar[XB_XGEN(b.x)]) == gen, bar);
            __builtin_amdgcn_fence(__ATOMIC_ACQUIRE, "agent");
            asm volatile("s_waitcnt vmcnt(0)" ::: "memory");
        }
    }
    __syncthreads();
}

struct Frame {
    LAS unsigned char* lds; char* ws;
    int tid, lane, wave, vcu, G;
};

__device__ __forceinline__ void p0_transpose_item(const float* W, int K, int N, bf16* WT, int dst_row0, LAS float* scr, int k0, int n0, int lane) {
#pragma unroll 8
    for (int i = 0; i < 32; ++i) { const int kk = 2 * i + (lane >> 5); scr[kk * 33 + (lane & 31)] = W[(size_t)(k0 + kk) * N + n0 + (lane & 31)]; }
    LDS_WAIT(); asm volatile("" ::: "memory");
    const int c = lane & 7;
#pragma unroll
    for (int j = 0; j < 4; ++j) { const int n = (lane >> 3) + 8 * j; const LAS float* s = scr + (8 * c) * 33 + n;
        u32x4 o; o.x = pk2(s[0 * 33], s[1 * 33]); o.y = pk2(s[2 * 33], s[3 * 33]); o.z = pk2(s[4 * 33], s[5 * 33]); o.w = pk2(s[6 * 33], s[7 * 33]);
        *(GAS u32x4*)(WT + (size_t)(dst_row0 + n) * K + k0 + 8 * c) = o; }
    LDS_WAIT(); asm volatile("" ::: "memory");
}
__device__ __forceinline__ void p0_matrix(Frame& F, const float* W, int K, int N, bf16* WT, LAS float* scr, int it) {
    const int nblk = N / 32, kb = it / nblk, nb = it % nblk;
    p0_transpose_item(W, K, N, WT, 32 * nb, scr, 64 * kb, 32 * nb, F.lane);
}
__device__ __forceinline__ void phase0(Frame& F, const Params& P) {
    LAS float* scr = (LAS float*)(F.lds + RING_OFF + F.wave * 16384);
    const int gw = F.vcu * NWAVES + F.wave, NGW = F.G * NWAVES;
    constexpr int I_IN = 16 * 185, I_A = 8 * 32, I_SQ = 16 * 32, I_PLE = 4 * 32;
    constexpr int NITEMS = I_IN + I_A + 3 * I_SQ + I_PLE;
    for (int it = gw; it < NITEMS; it += NGW) {
        int r = it;
        if (r < I_IN) { const int kb = r / 185, nb = r % 185; const int dst = nb < 120 ? 32 * nb : (nb == 120 ? 5888 : 32 * nb - 32);
            p0_transpose_item(P.w_in, D_, IN_DIM, (bf16*)(F.ws + WS_WIN), dst, scr, 64 * kb, 32 * nb, F.lane); continue; } r -= I_IN;
        if (r < I_A) { p0_matrix(F, P.w_ba, 512, D_, (bf16*)(F.ws + WS_WA), scr, r); continue; } r -= I_A;
        if (r < I_SQ) { p0_matrix(F, P.w_bg, D_, D_, (bf16*)(F.ws + WS_WB), scr, r); continue; } r -= I_SQ;
        if (r < I_SQ) { p0_matrix(F, P.w_out, D_, D_, (bf16*)(F.ws + WS_WO), scr, r); continue; } r -= I_SQ;
        if (r < I_SQ) { p0_matrix(F, P.w_pg, D_, D_, (bf16*)(F.ws + WS_WPG), scr, r); continue; } r -= I_SQ;
        p0_matrix(F, P.w_ple, PLE, D_, (bf16*)(F.ws + WS_WPLE), scr, r);
    }
    for (int i = (F.vcu * NT + F.tid); i < 28672; i += F.G * NT) *((GAS u32x4*)(F.ws + WS_WIN + (size_t)5920 * 2048) + i) = (u32x4){0u, 0u, 0u, 0u};
    for (int m = gw; m < T_; m += NGW) {
        const GAS f32x4* xr = (const GAS f32x4*)(P.x + (size_t)m * D_) + F.lane;
        f32x4 v[4]; float s = 0.f;
#pragma unroll
        for (int j = 0; j < 4; ++j) { v[j] = xr[64 * j]; s += (v[j].x * v[j].x + v[j].y * v[j].y) + (v[j].z * v[j].z + v[j].w * v[j].w); }
        const float r = 1.0f / sqrtf(wave_sum(s) * (1.0f / D_) + EPS);
        GAS u32x2* o8 = (GAS u32x2*)(F.ws + WS_A0 + (size_t)m * D_ * 2) + F.lane;
#pragma unroll
        for (int j = 0; j < 4; ++j) { const f32x4 g = ((const GAS f32x4*)P.norm_mix)[F.lane + 64 * j]; const f32x4 y = v[j] * r * g; o8[64 * j] = (u32x2){pk2(y.x, y.y), pk2(y.z, y.w)}; }
    }
    for (int gid = F.vcu * NT + F.tid; gid < T_ * 8; gid += F.G * NT) {
        const int i = gid & 7, t = gid >> 3;
        const float invf = i == 0 ? 1.0f : i == 1 ? 0.1939227432012558f : i == 2 ? 0.03760603070259094f : i == 3 ? 0.007292664609849453f : i == 4 ? 0.0014142135623842478f : i == 5 ? 0.00027424818836152554f : i == 6 ? 5.3182957344688475e-05f : 1.0313385246263351e-05f;
        const float ang = (float)P.pos[t] * invf;
        float* RT = (float*)(F.ws + WS_ROPE);
        RT[t * 16 + i] = cosf(ang); RT[t * 16 + 8 + i] = sinf(ang);
    }
}

struct EpiInProj {
    static constexpr bool PERM = true;
    char* ws;
    __device__ __forceinline__ void operator()(const f32x4 (&acc)[2][2][4][2], const pg8::Unit& u, int wr, int wc, int fr, int fq) const {
        const int pn = u.pn; const int row0 = u.pm * 256 + wr * 64 + fr;
        if (pn == 23) {
            if (wc == 0) {
#pragma unroll
                for (int ai = 0; ai < 2; ++ai)
#pragma unroll
                    for (int m = 0; m < 4; ++m) { float* zp = (float*)(ws + WS_Z) + (size_t)(row0 + ai * 128 + m * 16) * 32 + 8 * fq; *(f32x4*)zp = acc[ai][0][m][0]; *(f32x4*)(zp + 4) = acc[ai][0][m][1]; }
            }
            return;
        }
        bf16* base; int ldc, ct; float sc = 1.f;
        if (pn < 3) { base = (bf16*)(ws + WS_QKV); ldc = 768; ct = pn * 256; if (pn < 2) sc = QSCALE; }
        else { const int g = (pn - 3) >> 2; ct = ((pn - 3) & 3) * 256; ldc = 1024; base = (bf16*)(ws + (g == 0 ? WS_GQK : g == 1 ? WS_GV : g == 2 ? WS_GR : g == 3 ? WS_GATT : WS_GGLA)); if (g == 0 && ct < 512) sc = GQSCALE; }
        const bool rope_wave = (pn < 3) && ((wc & 1) == 0);
        const float* RT = (const float*)(ws + WS_ROPE);
#pragma unroll
        for (int ai = 0; ai < 2; ++ai)
#pragma unroll
            for (int m = 0; m < 4; ++m) {
                const int r = row0 + ai * 128 + m * 16;
                f32x4 cs0, cs1, sn0, sn1;
                if (rope_wave) { const f32x4* rp = (const f32x4*)(RT + (size_t)r * 16); cs0 = rp[0]; cs1 = rp[1]; sn0 = rp[2]; sn1 = rp[3]; }
#pragma unroll
                for (int bj = 0; bj < 2; ++bj) {
                    f32x4 v0 = acc[ai][bj][m][0], v1 = acc[ai][bj][m][1];
                    if (rope_wave && !(pn == 2 && bj == 1)) {
                        f32x4 o0, o1;
#pragma unroll
                        for (int j = 0; j < 4; ++j) { o0[j] = __shfl_xor(v0[j], 16); o1[j] = __shfl_xor(v1[j], 16); }
                        if (fq == 0) { v0 = v0 * cs0 - o0 * sn0; v1 = v1 * cs1 - o1 * sn1; }
                        else if (fq == 1) { v0 = v0 * cs0 + o0 * sn0; v1 = v1 * cs1 + o1 * sn1; }
                    }
                    v0 = v0 * sc; v1 = v1 * sc;
                    u32x4 w; w.x = pg8::cvt_pk_bf16(v0[0], v0[1]); w.y = pg8::cvt_pk_bf16(v0[2], v0[3]); w.z = pg8::cvt_pk_bf16(v1[0], v1[1]); w.w = pg8::cvt_pk_bf16(v1[2], v1[3]);
                    *(u32x4*)(base + (size_t)r * ldc + ct + bj * 128 + wc * 32 + 8 * fq) = w;
                }
            }
    }
};
__device__ __forceinline__ void phase1(Frame& F, const Params& P) {
    pg8::DenseOrder S; S.init(F.ws + WS_A0, F.ws + WS_WIN, T_, 6144, D_, F.G, (int)blockIdx.x);
    EpiInProj E{F.ws};
    pg8::gemm_phase<EpiInProj, pg8::DenseOrder, false, true>(F.lds + RING_OFF, D_, S, E);
}


__device__ __forceinline__ f32x4 ldbf4(const bf16* p) { const u32x2 r = *(const u32x2*)p; return (f32x4){bf2f(r.x & 0xffffu), bf2f(r.x >> 16), bf2f(r.y & 0xffffu), bf2f(r.y >> 16)}; }
__device__ __forceinline__ void stbf4(bf16* p, f32x4 v) { *(u32x2*)p = (u32x2){pk2(v.x, v.y), pk2(v.z, v.w)}; }
__device__ __forceinline__ f32x4 sig4(f32x4 g) { return (f32x4){sigmoidf_(g.x), sigmoidf_(g.y), sigmoidf_(g.z), sigmoidf_(g.w)}; }

__device__ __forceinline__ void phase3_pre(Frame& F, const Params& P) {
    const bf16* OFp = (const bf16*)(F.ws + WS_OF); const bf16* OBp = (const bf16*)(F.ws + WS_OB); const bf16* GR = (const bf16*)(F.ws + WS_GR); bf16* GLAO = (bf16*)(F.ws + WS_GLAO);
    const int gw0 = F.vcu * NWAVES + F.wave, NGW = F.G * NWAVES;
    for (int gw = gw0; gw < T_ * 4; gw += NGW) {
        const int h = gw & 3; const long t = gw >> 2; const long off = t * 1024 + h * 256 + F.lane * 4;
        const f32x4 x = ldbf4(OFp + off) + ldbf4(OBp + off);
        const float s = wave_sum(x.x * x.x + x.y * x.y + x.z * x.z + x.w * x.w);
        const float r = 1.0f / sqrtf(s * (1.0f / 256.0f) + EPS);
        const f32x4 g = *(const f32x4*)(P.gla_norm + h * 256 + F.lane * 4); const f32x4 gr = ldbf4(GR + off);
        stbf4(GLAO + off, x * r * g * gr * sig4(gr));
    }
}
struct EpiGate1 {
    static constexpr bool PERM = false;
    const bf16* G; float* C;
    __device__ __forceinline__ void operator()(const f32x4 (&acc)[2][2][4][2], const pg8::Unit& u, int wr, int wc, int fr, int fq) const {
        const int row0 = u.pm * 256 + wr * 64 + fr, col0 = u.pn * 256 + wc * 32 + 4 * fq;
#pragma unroll
        for (int ai = 0; ai < 2; ++ai)
#pragma unroll
            for (int m = 0; m < 4; ++m) { const size_t ro = (size_t)(row0 + ai * 128 + m * 16) * D_ + col0;
#pragma unroll
                for (int bj = 0; bj < 2; ++bj)
#pragma unroll
                    for (int n = 0; n < 2; ++n) { const size_t o = ro + bj * 128 + n * 16; *(f32x4*)(C + o) = sig4(ldbf4(G + o)) * acc[ai][bj][m][n]; } }
    }
};
struct EpiGate2 {
    static constexpr bool PERM = true;
    const bf16* G; const float* Tm; bf16* C;
    __device__ __forceinline__ void operator()(const f32x4 (&acc)[2][2][4][2], const pg8::Unit& u, int wr, int wc, int fr, int fq) const {
        const int row0 = u.pm * 256 + wr * 64 + fr, col0 = u.pn * 256 + wc * 32 + 8 * fq;
#pragma unroll
        for (int ai = 0; ai < 2; ++ai)
#pragma unroll
            for (int m = 0; m < 4; ++m) { const size_t ro = (size_t)(row0 + ai * 128 + m * 16) * D_ + col0;
#pragma unroll
                for (int bj = 0; bj < 2; ++bj) { const size_t o = ro + bj * 128;
                    const f32x4 v0 = *(const f32x4*)(Tm + o) + sig4(ldbf4(G + o)) * acc[ai][bj][m][0], v1 = *(const f32x4*)(Tm + o + 4) + sig4(ldbf4(G + o + 4)) * acc[ai][bj][m][1];
                    u32x4 w; w.x = pg8::cvt_pk_bf16(v0[0], v0[1]); w.y = pg8::cvt_pk_bf16(v0[2], v0[3]); w.z = pg8::cvt_pk_bf16(v1[0], v1[1]); w.w = pg8::cvt_pk_bf16(v1[2], v1[3]);
                    *(u32x4*)(C + o) = w; } }
    }
};
__device__ __forceinline__ void phase3a(Frame& F, const Params& P) {
    pg8::DenseOrder S; S.init(F.ws + WS_ATT, F.ws + WS_WA, T_, D_, 512, F.G, (int)blockIdx.x);
    EpiGate1 E{(const bf16*)(F.ws + WS_GATT), P.out};
    pg8::gemm_phase<EpiGate1, pg8::DenseOrder, false, false>(F.lds + RING_OFF, 512, S, E);
}
__device__ __forceinline__ void phase3b(Frame& F, const Params& P) {
    pg8::DenseOrder S; S.init(F.ws + WS_GLAO, F.ws + WS_WB, T_, D_, D_, F.G, (int)blockIdx.x);
    EpiGate2 E{(const bf16*)(F.ws + WS_GGLA), P.out, (bf16*)(F.ws + WS_MERGED)};
    pg8::gemm_phase<EpiGate2, pg8::DenseOrder, false, false>(F.lds + RING_OFF, D_, S, E);
}
struct EpiResid {
    static constexpr bool PERM = false;
    const float* R; float* C;
    __device__ __forceinline__ void operator()(const f32x4 (&acc)[2][2][4][2], const pg8::Unit& u, int wr, int wc, int fr, int fq) const {
        const int row0 = u.pm * 256 + wr * 64 + fr, col0 = u.pn * 256 + wc * 32 + 4 * fq;
#pragma unroll
        for (int ai = 0; ai < 2; ++ai)
#pragma unroll
            for (int m = 0; m < 4; ++m) { const size_t ro = (size_t)(row0 + ai * 128 + m * 16) * D_ + col0;
#pragma unroll
                for (int bj = 0; bj < 2; ++bj)
#pragma unroll
                    for (int n = 0; n < 2; ++n) { const size_t o = ro + bj * 128 + n * 16; *(f32x4*)(C + o) = *(const f32x4*)(R + o) + acc[ai][bj][m][n]; } }
    }
};
__device__ __forceinline__ void phase4a(Frame& F, const Params& P) {
    pg8::DenseOrder S; S.init(F.ws + WS_MERGED, F.ws + WS_WO, T_, D_, D_, F.G, (int)blockIdx.x);
    EpiResid E{P.x, (float*)(F.ws + WS_H)};
    pg8::gemm_phase<EpiResid, pg8::DenseOrder, false, false>(F.lds + RING_OFF, D_, S, E);
}
__device__ __forceinline__ void phase4b(Frame& F, const Params& P) {
    const float* H = (const float*)(F.ws + WS_H); bf16* XN = (bf16*)(F.ws + WS_XN); float* aff = (float*)(F.ws + WS_AFF);
    const int gw0 = F.vcu * NWAVES + F.wave, NGW = F.G * NWAVES, lane = F.lane;
    for (int row = gw0; row < T_; row += NGW) {
        const f32x4* xr = (const f32x4*)(H + (long)row * D_) + lane;
        f32x4 v[4]; float s = 0.f;
#pragma unroll
        for (int j = 0; j < 4; ++j) { v[j] = xr[64 * j]; s += v[j].x * v[j].x + v[j].y * v[j].y + v[j].z * v[j].z + v[j].w * v[j].w; }
        const float r = 1.0f / sqrtf(wave_sum(s) * (1.0f / D_) + EPS);
        float lg[16];
#pragma unroll
        for (int e = 0; e < 16; ++e) lg[e] = 0.f;
#pragma unroll
        for (int j = 0; j < 4; ++j) { const f32x4 y = v[j] * r * ((const f32x4*)P.norm_ffn)[lane + 64 * j]; stbf4(XN + (long)row * D_ + 4 * (lane + 64 * j), y);
            const f32x4* wr = (const f32x4*)(P.w_router + (size_t)(4 * (lane + 64 * j)) * 16);
#pragma unroll
            for (int q = 0; q < 4; ++q) { const f32x4 w0 = wr[q], w1 = wr[4 + q], w2 = wr[8 + q], w3 = wr[12 + q];
#pragma unroll
                for (int c = 0; c < 4; ++c) lg[4 * q + c] += y.x * w0[c] + y.y * w1[c] + y.z * w2[c] + y.w * w3[c]; } }
        float m = -INFINITY;
#pragma unroll
        for (int e = 0; e < 16; ++e) { lg[e] = wave_sum(lg[e]); m = fmaxf(m, lg[e]); }
        float sum = 0.f;
#pragma unroll
        for (int e = 0; e < 16; ++e) { lg[e] = expf(lg[e] - m); sum += lg[e]; }
        float val = 0.f;
#pragma unroll
        for (int e = 0; e < 16; ++e) if (lane == e) val = lg[e];
        if (lane < 16) aff[row * 16 + lane] = val / sum;
    }
}
__device__ __forceinline__ void topk_item(Frame& F, int b, int e) {
    LAS unsigned* cnts = (LAS unsigned*)(F.lds + RING_OFF);
    const float* aff = (const float*)(F.ws + WS_AFF); int* gidx = (int*)(F.ws + WS_GIDX); int* inv = (int*)(F.ws + WS_INV);
    const int tid = F.tid, lane = F.lane, wave = F.wave;
    unsigned v[8];
#pragma unroll
    for (int j = 0; j < 8; ++j) v[j] = __builtin_bit_cast(unsigned, aff[(size_t)(b * S_ + tid * 8 + j) * 16 + e]);
    unsigned Tv = 0u;
    __syncthreads();
    for (int bit = 30; bit >= 0; --bit) {
        const unsigned cand = Tv | (1u << bit);
        unsigned c = 0;
#pragma unroll
        for (int j = 0; j < 8; ++j) c += (v[j] >= cand) ? 1u : 0u;
#pragma unroll
        for (int o = 1; o < 64; o <<= 1) c += __shfl_xor(c, o);
        LAS unsigned* slot = cnts + (bit & 1) * 8;
        if (lane == 0) slot[wave] = c;
        __syncthreads();
        unsigned tot = 0;
#pragma unroll
        for (int w = 0; w < 8; ++w) tot += slot[w];
        if (tot >= (unsigned)CAP) Tv = cand;
    }
    unsigned ngt = 0, neq = 0;
#pragma unroll
    for (int j = 0; j < 8; ++j) { ngt += (v[j] > Tv) ? 1u : 0u; neq += (v[j] == Tv) ? 1u : 0u; }
    unsigned pk = ngt | (neq << 16), incl = pk;
#pragma unroll
    for (int o = 1; o < 64; o <<= 1) { const unsigned t = __shfl_up(incl, o); if (lane >= o) incl += t; }
    __syncthreads();
    LAS unsigned* wtot = cnts + 16;
    if (lane == 63) wtot[wave] = incl;
    __syncthreads();
    unsigned base = 0, total = 0;
#pragma unroll
    for (int w = 0; w < 8; ++w) { const unsigned t = wtot[w]; if (w < wave) base += t; total += t; }
    const unsigned excl = base + incl - pk;
    const unsigned tot_gt = total & 0xffffu, need_eq = (unsigned)CAP - tot_gt;
    unsigned g_before = excl & 0xffffu, e_before = excl >> 16;
#pragma unroll
    for (int j = 0; j < 8; ++j) {
        const bool gt = v[j] > Tv, eq = v[j] == Tv;
        const bool sel = gt || (eq && e_before < need_eq);
        const unsigned slotc = g_before + (e_before < need_eq ? e_before : need_eq);
        const int tok = b * S_ + tid * 8 + j;
        if (sel) gidx[e * ME + b * CAP + (int)slotc] = tok;
        inv[tok * 16 + e] = sel ? (int)(b * CAP + slotc) : -1;
        g_before += gt ? 1u : 0u; e_before += eq ? 1u : 0u;
    }
    __syncthreads();
}
__device__ __forceinline__ void phase5(Frame& F, const Params& P) {
    if (blockIdx.x < 64) topk_item(F, (int)blockIdx.x >> 4, (int)blockIdx.x & 15);
    LAS float* scr = (LAS float*)(F.lds + RING_OFF + 1024 + F.wave * 16384);
    const int gw = F.vcu * NWAVES + F.wave, NGW = F.G * NWAVES;
    for (int it = gw; it < 3 * 16 * 512; it += NGW) {
        const int mat = it >> 9, r = it & 511, which = mat >> 4, e = mat & 15;
        const float* W = (which == 0 ? P.w_eg : which == 1 ? P.w_eu : P.w_ed) + (size_t)e * D_ * FF;
        bf16* WT = (bf16*)(F.ws + (which == 0 ? WS_WEG : which == 1 ? WS_WEU : WS_WED)) + (size_t)e * D_ * FF;
        p0_matrix(F, W, 1024, 1024, WT, scr, r);
    }
}
struct ExpertOrder1 {
    const char* XN; const char* WG; const char* WU; const int* gidx; int G, c;
    __device__ bool next(int i, pg8::Unit& u) const {
        const int L = i * G + c; if (L >= 1024) return false;
        const int e = L >> 6, r = L & 63; u.e = e; u.pm = r & 7; u.pn = r >> 3; u.pad = 0;
        u.a = XN; u.gi = gidx + e * ME + u.pm * 256;
        const size_t bo = ((size_t)e * FF + (size_t)u.pn * 128) * D_ * 2; u.b0 = WG + bo; u.b1 = WU + bo; return true;
    }
};
struct EpiSwiglu {
    static constexpr bool PERM = true;
    bf16* HID;
    __device__ __forceinline__ void operator()(const f32x4 (&acc)[2][2][4][2], const pg8::Unit& u, int wr, int wc, int fr, int fq) const {
        const int row0 = u.e * ME + u.pm * 256 + wr * 64 + fr, col0 = u.pn * 128 + wc * 32 + 8 * fq;
#pragma unroll
        for (int ai = 0; ai < 2; ++ai)
#pragma unroll
            for (int m = 0; m < 4; ++m) { const f32x4 g0 = acc[ai][0][m][0], g1 = acc[ai][0][m][1];
                const f32x4 v0 = g0 * sig4(g0) * acc[ai][1][m][0], v1 = g1 * sig4(g1) * acc[ai][1][m][1];
                u32x4 w; w.x = pg8::cvt_pk_bf16(v0[0], v0[1]); w.y = pg8::cvt_pk_bf16(v0[2], v0[3]); w.z = pg8::cvt_pk_bf16(v1[0], v1[1]); w.w = pg8::cvt_pk_bf16(v1[2], v1[3]);
                *(u32x4*)(HID + (size_t)(row0 + ai * 128 + m * 16) * FF + col0) = w; }
    }
};
__device__ __forceinline__ void phase6(Frame& F, const Params& P) {
    ExpertOrder1 S{F.ws + WS_XN, F.ws + WS_WEG, F.ws + WS_WEU, (const int*)(F.ws + WS_GIDX), F.G, F.vcu};
    EpiSwiglu E{(bf16*)(F.ws + WS_HID)};
    pg8::gemm_phase<EpiSwiglu, ExpertOrder1, true, true>(F.lds + RING_OFF, D_, S, E);
}
struct ExpertOrder2 {
    const char* HID; const char* WD; int G, c;
    __device__ bool next(int i, pg8::Unit& u) const {
        const int L = i * G + c; if (L >= 512) return false;
        const int e = L >> 5, r = L & 31; u.e = e; u.pm = r & 7; u.pn = r >> 3; u.pad = 0; u.gi = nullptr;
        u.a = HID + ((size_t)e * ME + (size_t)u.pm * 256) * FF * 2;
        u.b0 = WD + ((size_t)e * D_ + (size_t)u.pn * 256) * FF * 2; u.b1 = u.b0 + (size_t)128 * FF * 2; return true;
    }
};
struct EpiRowScale {
    static constexpr bool PERM = true;
    const float* aff; const int* gidx; bf16* Y;
    __device__ __forceinline__ void operator()(const f32x4 (&acc)[2][2][4][2], const pg8::Unit& u, int wr, int wc, int fr, int fq) const {
        const int row0 = u.e * ME + u.pm * 256 + wr * 64 + fr, col0 = u.pn * 256 + wc * 32 + 8 * fq;
#pragma unroll
        for (int ai = 0; ai < 2; ++ai)
#pragma unroll
            for (int m = 0; m < 4; ++m) { const int r = row0 + ai * 128 + m * 16; const float a = aff[gidx[r] * NE + u.e];
#pragma unroll
                for (int bj = 0; bj < 2; ++bj) { const f32x4 v0 = acc[ai][bj][m][0] * a, v1 = acc[ai][bj][m][1] * a;
                    u32x4 w; w.x = pg8::cvt_pk_bf16(v0[0], v0[1]); w.y = pg8::cvt_pk_bf16(v0[2], v0[3]); w.z = pg8::cvt_pk_bf16(v1[0], v1[1]); w.w = pg8::cvt_pk_bf16(v1[2], v1[3]);
                    *(u32x4*)(Y + (size_t)r * D_ + col0 + bj * 128) = w; } }
    }
};
__device__ __forceinline__ void phase7(Frame& F, const Params& P) {
    ExpertOrder2 S{F.ws + WS_HID, F.ws + WS_WED, F.G, F.vcu};
    EpiRowScale E{(const float*)(F.ws + WS_AFF), (const int*)(F.ws + WS_GIDX), (bf16*)P.out};
    pg8::gemm_phase<EpiRowScale, ExpertOrder2, false, true>(F.lds + RING_OFF, FF, S, E);
}
constexpr size_t WS_PB = WS_GGLA;
__device__ __forceinline__ void phase8(Frame& F, const Params& P) {
    float* H = (float*)(F.ws + WS_H); const bf16* Y = (const bf16*)P.out; const int* inv = (const int*)(F.ws + WS_INV); bf16* XN3 = (bf16*)(F.ws + WS_XN3); bf16* PB = (bf16*)(F.ws + WS_PB);
    const int gw0 = F.vcu * NWAVES + F.wave, NGW = F.G * NWAVES, lane = F.lane;
    for (int row = gw0; row < T_; row += NGW) {
        f32x4* xr = (f32x4*)(H + (long)row * D_) + lane;
        f32x4 v[4];
#pragma unroll
        for (int j = 0; j < 4; ++j) v[j] = xr[64 * j];
        const int myinv = lane < 16 ? inv[row * 16 + lane] : -1;
        for (int e = 0; e < 16; ++e) { const int sl = __shfl(myinv, e); if (sl >= 0) { const bf16* yp = Y + ((long)e * ME + sl) * D_;
#pragma unroll
                for (int j = 0; j < 4; ++j) v[j] += ldbf4(yp + 4 * (lane + 64 * j)); } }
        float s = 0.f;
#pragma unroll
        for (int j = 0; j < 4; ++j) { xr[64 * j] = v[j]; s += v[j].x * v[j].x + v[j].y * v[j].y + v[j].z * v[j].z + v[j].w * v[j].w; }
        const float r = 1.0f / sqrtf(wave_sum(s) * (1.0f / D_) + EPS);
#pragma unroll
        for (int j = 0; j < 4; ++j) stbf4(XN3 + (long)row * D_ + 4 * (lane + 64 * j), v[j] * r * ((const f32x4*)P.norm_ple)[lane + 64 * j]);
        stbf4(PB + (long)row * PLE + 4 * lane, *((const f32x4*)(P.p + (long)row * PLE) + lane));
    }
}
struct EpiStoreF32 {
    static constexpr bool PERM = false;
    float* C;
    __device__ __forceinline__ void operator()(const f32x4 (&acc)[2][2][4][2], const pg8::Unit& u, int wr, int wc, int fr, int fq) const {
        const int row0 = u.pm * 256 + wr * 64 + fr, col0 = u.pn * 256 + wc * 32 + 4 * fq;
#pragma unroll
        for (int ai = 0; ai < 2; ++ai)
#pragma unroll
            for (int m = 0; m < 4; ++m) { const size_t ro = (size_t)(row0 + ai * 128 + m * 16) * D_ + col0;
#pragma unroll
                for (int bj = 0; bj < 2; ++bj)
#pragma unroll
                    for (int n = 0; n < 2; ++n) *(f32x4*)(C + ro + bj * 128 + n * 16) = acc[ai][bj][m][n]; }
    }
};
struct EpiPle {
    static constexpr bool PERM = false;
    const float* Pt; float* H;
    __device__ __forceinline__ void operator()(const f32x4 (&acc)[2][2][4][2], const pg8::Unit& u, int wr, int wc, int fr, int fq) const {
        const int row0 = u.pm * 256 + wr * 64 + fr, col0 = u.pn * 256 + wc * 32 + 4 * fq;
#pragma unroll
        for (int ai = 0; ai < 2; ++ai)
#pragma unroll
            for (int m = 0; m < 4; ++m) { const size_t ro = (size_t)(row0 + ai * 128 + m * 16) * D_ + col0;
#pragma unroll
                for (int bj = 0; bj < 2; ++bj)
#pragma unroll
                    for (int n = 0; n < 2; ++n) { const size_t o = ro + bj * 128 + n * 16; *(f32x4*)(H + o) = *(const f32x4*)(H + o) + sig4(acc[ai][bj][m][n]) * *(const f32x4*)(Pt + o); } }
    }
};
__device__ __forceinline__ void phase9a(Frame& F, const Params& P) {
    pg8::DenseOrder S; S.init(F.ws + WS_PB, F.ws + WS_WPLE, T_, D_, PLE, F.G, (int)blockIdx.x);
    EpiStoreF32 E{(float*)(F.ws + WS_PLET)};
    pg8::gemm_phase<EpiStoreF32, pg8::DenseOrder, false, false>(F.lds + RING_OFF, PLE, S, E);
}
__device__ __forceinline__ void phase9b(Frame& F, const Params& P) {
    pg8::DenseOrder S; S.init(F.ws + WS_XN3, F.ws + WS_WPG, T_, D_, D_, F.G, (int)blockIdx.x);
    EpiPle E{(const float*)(F.ws + WS_PLET), (float*)(F.ws + WS_H)};
    pg8::gemm_phase<EpiPle, pg8::DenseOrder, false, false>(F.lds + RING_OFF, D_, S, E);
}
__device__ __forceinline__ void phase10(Frame& F, const Params& P) {
    const float* H = (const float*)(F.ws + WS_H);
    const int gw0 = F.vcu * NWAVES + F.wave, NGW = F.G * NWAVES, lane = F.lane;
    for (int row = gw0; row < T_; row += NGW) {
        const f32x4* xr = (const f32x4*)(H + (long)row * D_) + lane;
        f32x4 v[4]; float s = 0.f;
#pragma unroll
        for (int j = 0; j < 4; ++j) { v[j] = xr[64 * j]; s += v[j].x * v[j].x + v[j].y * v[j].y + v[j].z * v[j].z + v[j].w * v[j].w; }
        const float r = 1.0f / sqrtf(wave_sum(s) * (1.0f / D_) + EPS);
#pragma unroll
        for (int j = 0; j < 4; ++j) *((f32x4*)(P.out + (long)row * D_) + lane + 64 * j) = v[j] * r * ((const f32x4*)P.norm_final)[lane + 64 * j];
    }
}

}
namespace mk {
typedef float f32x16 __attribute__((ext_vector_type(16)));
typedef short s16x8 __attribute__((ext_vector_type(8)));
typedef short s16x4 __attribute__((ext_vector_type(4)));
__device__ __forceinline__ int crow(int r, int hi) { return (r & 3) + 8 * (r >> 2) + 4 * hi; }
__device__ __forceinline__ s16x4 tr16(LAS const void* p) { return __builtin_bit_cast(s16x4, __builtin_amdgcn_ds_read_tr16_b64_v4i16((LAS s16x4*)p)); }
__device__ __forceinline__ unsigned cvtpk(float lo, float hi) { f32x2 v = {lo, hi}; typedef __bf16 bf2 __attribute__((ext_vector_type(2))); bf2 b = __builtin_convertvector(v, bf2); return __builtin_bit_cast(unsigned, b); }

constexpr int ATT_K = 0, ATT_V = 49152;

__device__ __forceinline__ void attn_unit(Frame& F, const Params& P, int b, int kvh, int nb) {
    const bf16* QKV = (const bf16*)(F.ws + WS_QKV); bf16* ATT = (bf16*)(F.ws + WS_ATT);
    LAS unsigned char* lds = F.lds + RING_OFF;
    const int tid = F.tid, lane = F.lane, wave = F.wave;
#pragma unroll
    for (int i = 0; i < 6; ++i) {
        const int idx = tid + NT * i, row = idx >> 3, ch = idx & 7;
        const int pos = (nb - 1) * 128 + row;
        u32x4 kv = (u32x4){0u, 0u, 0u, 0u}, vv = (u32x4){0u, 0u, 0u, 0u};
        if (pos >= 0 && pos < S_) { const bf16* src = QKV + (size_t)(b * S_ + pos) * 768 + 512 + kvh * 64 + ch * 8; kv = *(const u32x4*)src; vv = *(const u32x4*)(src + 128); }
        *(LAS u32x4*)(lds + ATT_K + row * 128 + ((ch ^ (row & 7)) * 16)) = kv;
        *(LAS u32x4*)(lds + ATT_V + row * 128 + ch * 16) = vv;
    }
    __syncthreads();
    const int g = wave >> 1, qh = wave & 1, hq = kvh * 4 + g;
    const int ql = lane & 31, hi = lane >> 5;
    const float sink2 = P.sink[hq] * LOG2E;
    const bool edge = (nb == 0) || (nb == S_ / 128 - 1);
    for (int sb = 0; sb < 2; ++sb) {
        const int q0 = qh * 64 + sb * 32;
        const size_t tok = (size_t)b * S_ + nb * 128 + q0 + ql;
        s16x8 qr[4];
#pragma unroll
        for (int d0 = 0; d0 < 4; ++d0) qr[d0] = *(const s16x8*)(QKV + tok * 768 + hq * 64 + d0 * 16 + hi * 8);
        float m = sink2, l = 0.f;
        f32x16 o0 = {}, o1 = {};
        for (int kt = 0; kt < 9; ++kt) {
            const int kr0 = q0 + 32 * kt;
            f32x16 p = {};
            { const int krow = kr0 + ql; LAS const unsigned char* kb = lds + ATT_K + krow * 128; const int sw = krow & 7;
#pragma unroll
                for (int d0 = 0; d0 < 4; ++d0) { const s16x8 kf = *(LAS const s16x8*)(kb + (((2 * d0 + hi) ^ sw) * 16)); p = __builtin_amdgcn_mfma_f32_32x32x16_bf16(kf, qr[d0], p, 0, 0, 0); } }
            if (kt == 0 || kt == 8 || edge) {
#pragma unroll
                for (int r = 0; r < 16; ++r) { const int krow = kr0 + crow(r, hi); const int rel = krow - (q0 + ql); const int pos = (nb - 1) * 128 + krow;
                    if (rel < 0 || rel > 256 || pos < 0 || pos >= S_) p[r] = -INFINITY; }
            }
            float tm = p[0];
#pragma unroll
            for (int r = 1; r < 16; ++r) tm = fmaxf(tm, p[r]);
            tm = fmaxf(tm, __shfl_xor(tm, 32));
            const float mn = fmaxf(m, tm), alpha = exp2f(m - mn);
            float ps = 0.f;
#pragma unroll
            for (int r = 0; r < 16; ++r) { p[r] = exp2f(p[r] - mn); ps += p[r]; }
            l = l * alpha + ps; m = mn;
#pragma unroll
            for (int r = 0; r < 16; ++r) { o0[r] *= alpha; o1[r] *= alpha; }
            LAS const unsigned char* vb = lds + ATT_V + (kr0 + 4 * hi + ((lane & 15) >> 2)) * 128 + (16 * ((lane >> 4) & 1) + 4 * (lane & 3)) * 2;
#pragma unroll
            for (int s = 0; s < 2; ++s) {
                u32x4 pw; pw.x = cvtpk(p[8 * s + 0], p[8 * s + 1]); pw.y = cvtpk(p[8 * s + 2], p[8 * s + 3]); pw.z = cvtpk(p[8 * s + 4], p[8 * s + 5]); pw.w = cvtpk(p[8 * s + 6], p[8 * s + 7]);
                const s16x8 pf = __builtin_bit_cast(s16x8, pw);
#pragma unroll
                for (int dd = 0; dd < 2; ++dd) {
                    const s16x4 lo = tr16(vb + (16 * s) * 128 + dd * 64), hi4 = tr16(vb + (16 * s + 8) * 128 + dd * 64);
                    const s16x8 vf = (s16x8){lo[0], lo[1], lo[2], lo[3], hi4[0], hi4[1], hi4[2], hi4[3]};
                    if (dd == 0) o0 = __builtin_amdgcn_mfma_f32_32x32x16_bf16(vf, pf, o0, 0, 0, 0); else o1 = __builtin_amdgcn_mfma_f32_32x32x16_bf16(vf, pf, o1, 0, 0, 0);
                }
            }
        }
        l += __shfl_xor(l, 32);
        l += exp2f(sink2 - m);
        const float rl = 1.0f / l;
        bf16* op = ATT + tok * 512 + hq * 64;
#pragma unroll
        for (int dd = 0; dd < 2; ++dd)
#pragma unroll
            for (int rg = 0; rg < 4; ++rg) { const f32x16& o = dd ? o1 : o0; const int d = 32 * dd + 8 * rg + 4 * hi;
                *(u32x2*)(op + d) = (u32x2){cvtpk(o[4 * rg + 0] * rl, o[4 * rg + 1] * rl), cvtpk(o[4 * rg + 2] * rl, o[4 * rg + 3] * rl)}; }
    }
    __syncthreads();
}
__device__ __forceinline__ void phase2_attn(Frame& F, const Params& P, int first, int nwg) {
    for (int L = (int)blockIdx.x - first; L < 256; L += nwg) { if (L < 0) break; attn_unit(F, P, L >> 6, (L >> 5) & 1, L & 31); }
}
}
namespace mk {
constexpr int GL_QT = 0, GL_QS = 272;
constexpr int GL_KT = 17408;
constexpr int GL_KE = 34816, GL_KES = 320;
constexpr int GL_VV = 55296, GL_VS = 576;
constexpr int GL_AT = 92160, GL_AS = 144;
constexpr int GL_ZZ = 101376;
constexpr int GL_SEG = 105472;
constexpr int GL_DEC = 107520;
constexpr int GL_END = 108032;
constexpr int GLA_STATE_FLOATS = 128 * 256;

__device__ __forceinline__ float logsig(float x) { return fminf(x, 0.f) - log1pf(expf(-fabsf(x))); }

__device__ __forceinline__ void gla_unit(Frame& F, const Params& P, int b, int h, int dir, int c0, int nc, const float* Sin, float* Sout, float* Gout, bool write_o) {
    const bf16* GQK = (const bf16*)(F.ws + WS_GQK); const bf16* GV = (const bf16*)(F.ws + WS_GV); const float* Z = (const float*)(F.ws + WS_Z);
    bf16* OUT = (bf16*)(F.ws + (dir ? WS_OB : WS_OF));
    const float* up = dir ? P.up_b : P.up_f; const float* bias = dir ? P.bias_b : P.bias_f;
    LAS unsigned char* lds = F.lds + RING_OFF;
    const int tid = F.tid, lane = F.lane, w = F.wave, lr = lane & 31, hi = lane >> 5;
    const int d = tid & 127, ls = tid >> 7;
    float upr[16];
#pragma unroll
    for (int r = 0; r < 16; ++r) upr[r] = up[r * 512 + h * 128 + d];
    const float bias_d = bias[h * 128 + d];
    float gacc = 0.f;
    f32x16 S[4];
#pragma unroll
    for (int k = 0; k < 4; ++k) {
        if (Sin) {
#pragma unroll
            for (int r = 0; r < 16; ++r) S[k][r] = Sin[((w * 4 + k) * 16 + r) * 64 + lane];
        } else S[k] = (f32x16){};
    }
    const int trq = (lane & 15) >> 2, trp = lane & 3, trg = (lane >> 4) & 1;
    for (int ci = 0; ci < nc; ++ci) {
        const int c = c0 + ci;
        if (tid < 256) { const int l = tid >> 2, r4 = tid & 3; const int il = 64 * c + l, t = dir ? (S_ - 1 - il) : il;
            *(LAS f32x4*)(lds + GL_ZZ + l * 64 + r4 * 16) = *(const f32x4*)(Z + (size_t)(b * S_ + t) * 32 + dir * 16 + 4 * r4); }
#pragma unroll
        for (int i = 0; i < 4; ++i) { const int idx = tid + NT * i, l = idx >> 5, ch = idx & 31; const int il = 64 * c + l, t = dir ? (S_ - 1 - il) : il;
            *(LAS u32x4*)(lds + GL_VV + l * GL_VS + ch * 16) = *(const u32x4*)(GV + (size_t)(b * S_ + t) * 1024 + h * 256 + ch * 8); }
        float qv[16], kv[16];
#pragma unroll
        for (int li = 0; li < 16; ++li) { const int il = 64 * c + 16 * ls + li, t = dir ? (S_ - 1 - il) : il; const bf16* row = GQK + (size_t)(b * S_ + t) * 1024 + h * 128 + d;
            qv[li] = bf2f(row[0]); kv[li] = bf2f(row[512]); }
        __syncthreads();
        float bl[16];
        { float run = 0.f;
#pragma unroll
            for (int li = 0; li < 16; ++li) { const LAS f32x4* zr = (const LAS f32x4*)(lds + GL_ZZ + (16 * ls + li) * 64);
                float x = bias_d;
#pragma unroll
                for (int q = 0; q < 4; ++q) { const f32x4 zz = zr[q]; x += zz.x * upr[4 * q] + zz.y * upr[4 * q + 1] + zz.z * upr[4 * q + 2] + zz.w * upr[4 * q + 3]; }
                run += logsig(x) * (1.0f / 16.0f); bl[li] = run; } }
        ((LAS float*)(lds + GL_SEG))[ls * 128 + d] = bl[15];
        __syncthreads();
        float off = 0.f, gtot = 0.f;
#pragma unroll
        for (int q = 0; q < 4; ++q) { const float sgv = ((LAS const float*)(lds + GL_SEG))[q * 128 + d]; gtot += sgv; if (q < ls) off += sgv; }
        gacc += gtot;
        if (ls == 0) ((LAS float*)(lds + GL_DEC))[d] = expf(gtot);
#pragma unroll
        for (int li = 0; li < 16; ++li) { const int l = 16 * ls + li; const float bb = off + bl[li]; const float eb = expf(bb), ieb = expf(-bb), ee = expf(gtot - bb);
            *(LAS bf16*)(lds + GL_QT + l * GL_QS + d * 2) = (bf16)f2bf(qv[li] * eb);
            *(LAS bf16*)(lds + GL_KT + l * GL_QS + d * 2) = (bf16)f2bf(kv[li] * ieb);
            *(LAS bf16*)(lds + GL_KE + l * GL_KES + d * 2) = (bf16)f2bf(kv[li] * ee); }
        __syncthreads();
        if (write_o && w < 3) {
            const int li_ = (w + 1) >> 1, mi = w >> 1;
            f32x16 a = {};
#pragma unroll
            for (int s = 0; s < 8; ++s) { const s16x8 kf = *(LAS const s16x8*)(lds + GL_KT + (32 * mi + lr) * GL_QS + (16 * s + 8 * hi) * 2);
                const s16x8 qf = *(LAS const s16x8*)(lds + GL_QT + (32 * li_ + lr) * GL_QS + (16 * s + 8 * hi) * 2);
                a = __builtin_amdgcn_mfma_f32_32x32x16_bf16(kf, qf, a, 0, 0, 0); }
            const int l = 32 * li_ + lr;
#pragma unroll
            for (int rg = 0; rg < 4; ++rg) { const int m0 = 32 * mi + 8 * rg + 4 * hi; float v4[4];
#pragma unroll
                for (int j = 0; j < 4; ++j) { const int m = m0 + j; const bool keep = dir ? (m < l) : (m <= l); v4[j] = keep ? a[4 * rg + j] : 0.f; }
                *(LAS u32x2*)(lds + GL_AT + l * GL_AS + m0 * 2) = (u32x2){cvtpk(v4[0], v4[1]), cvtpk(v4[2], v4[3])}; }
        }
        __syncthreads();
        s16x8 vf[4];
        { LAS const unsigned char* vb = lds + GL_VV + (8 * hi + trq) * GL_VS + (32 * w + 16 * trg + 4 * trp) * 2;
#pragma unroll
            for (int s = 0; s < 4; ++s) { const s16x4 lo = tr16(vb + (16 * s) * GL_VS), hh = tr16(vb + (16 * s + 4) * GL_VS);
                vf[s] = (s16x8){lo[0], lo[1], lo[2], lo[3], hh[0], hh[1], hh[2], hh[3]}; } }
        if (write_o) {
            s16x8 sp[4][2];
#pragma unroll
            for (int k = 0; k < 4; ++k)
#pragma unroll
                for (int s2 = 0; s2 < 2; ++s2) { u32x4 pw; pw.x = cvtpk(S[k][8 * s2 + 0], S[k][8 * s2 + 1]); pw.y = cvtpk(S[k][8 * s2 + 2], S[k][8 * s2 + 3]); pw.z = cvtpk(S[k][8 * s2 + 4], S[k][8 * s2 + 5]); pw.w = cvtpk(S[k][8 * s2 + 6], S[k][8 * s2 + 7]);
                    sp[k][s2] = __builtin_bit_cast(s16x8, pw); }
#pragma unroll
            for (int lb = 0; lb < 2; ++lb) {
                f32x16 O = {};
                LAS const unsigned char* qrow = lds + GL_QT + (32 * lb + lr) * GL_QS;
#pragma unroll
                for (int k = 0; k < 4; ++k)
#pragma unroll
                    for (int s2 = 0; s2 < 2; ++s2) { const int dc = 32 * k + 16 * s2 + 4 * hi;
                        const s16x4 a0 = *(LAS const s16x4*)(qrow + dc * 2), a1 = *(LAS const s16x4*)(qrow + (dc + 8) * 2);
                        const s16x8 af = (s16x8){a0[0], a0[1], a0[2], a0[3], a1[0], a1[1], a1[2], a1[3]};
                        O = __builtin_amdgcn_mfma_f32_32x32x16_bf16(af, sp[k][s2], O, 0, 0, 0); }
                LAS const unsigned char* arow = lds + GL_AT + (32 * lb + lr) * GL_AS;
#pragma unroll
                for (int s = 0; s < 4; ++s) { if (lb == 0 && s >= 2) continue;
                    const s16x8 af = *(LAS const s16x8*)(arow + (16 * s + 8 * hi) * 2);
                    O = __builtin_amdgcn_mfma_f32_32x32x16_bf16(af, vf[s], O, 0, 0, 0); }
#pragma unroll
                for (int r = 0; r < 16; ++r) { const int l = 32 * lb + crow(r, hi); const int il = 64 * c + l, t = dir ? (S_ - 1 - il) : il;
                    OUT[(size_t)(b * S_ + t) * 1024 + h * 256 + 32 * w + lr] = (bf16)f2bf(O[r]); }
            }
        }
#pragma unroll
        for (int k = 0; k < 4; ++k) {
#pragma unroll
            for (int rg = 0; rg < 4; ++rg) { const f32x4 dc = *(LAS const f32x4*)(lds + GL_DEC + (32 * k + 8 * rg + 4 * hi) * 4);
                S[k][4 * rg + 0] *= dc.x; S[k][4 * rg + 1] *= dc.y; S[k][4 * rg + 2] *= dc.z; S[k][4 * rg + 3] *= dc.w; }
            LAS const unsigned char* kb = lds + GL_KE + (8 * hi + trq) * GL_KES + (32 * k + 16 * trg + 4 * trp) * 2;
#pragma unroll
            for (int s = 0; s < 4; ++s) { const s16x4 lo = tr16(kb + (16 * s) * GL_KES), hh = tr16(kb + (16 * s + 4) * GL_KES);
                const s16x8 kf = (s16x8){lo[0], lo[1], lo[2], lo[3], hh[0], hh[1], hh[2], hh[3]};
                S[k] = __builtin_amdgcn_mfma_f32_32x32x16_bf16(kf, vf[s], S[k], 0, 0, 0); }
        }
        __syncthreads();
    }
    if (Sout) {
#pragma unroll
        for (int k = 0; k < 4; ++k)
#pragma unroll
            for (int r = 0; r < 16; ++r) Sout[((w * 4 + k) * 16 + r) * 64 + lane] = S[k][r];
    }
    if (Gout && ls == 0) Gout[d] = gacc;
}
__device__ __forceinline__ void phase2_gla_simple(Frame& F, const Params& P) {
    const int u = (int)blockIdx.x; if (u >= 32) return;
    gla_unit(F, P, u >> 3, (u >> 1) & 3, u & 1, 0, 64, nullptr, nullptr, nullptr, true);
}
}
namespace mk {
template <int PH>
__global__ void __launch_bounds__(NT, 2) phase_k(Params P) {
    extern __shared__ __attribute__((aligned(16))) unsigned char lds[];
    Frame F; F.lds = (LAS unsigned char*)lds; F.ws = P.ws;
    F.tid = threadIdx.x; F.lane = F.tid & 63; F.wave = __builtin_amdgcn_readfirstlane(F.tid >> 6);
    F.G = gridDim.x; { const int bx = blockIdx.x; F.vcu = (F.G % 8 == 0) ? (bx % 8) * (F.G / 8) + bx / 8 : bx; }
    if constexpr (PH == 0) phase0(F, P);
    if constexpr (PH == 1) phase1(F, P);
    if constexpr (PH == 20) phase2_attn(F, P, 0, 256);
    if constexpr (PH == 21) phase2_gla_simple(F, P);
    if constexpr (PH == 30) phase3_pre(F, P);
    if constexpr (PH == 31) phase3a(F, P);
    if constexpr (PH == 32) phase3b(F, P);
    if constexpr (PH == 40) phase4a(F, P);
    if constexpr (PH == 41) phase4b(F, P);
    if constexpr (PH == 5) phase5(F, P);
    if constexpr (PH == 6) phase6(F, P);
    if constexpr (PH == 7) phase7(F, P);
    if constexpr (PH == 8) phase8(F, P);
    if constexpr (PH == 90) phase9a(F, P);
    if constexpr (PH == 91) phase9b(F, P);
    if constexpr (PH == 10) phase10(F, P);
}
template <int PH> static void launch_phase(hipStream_t st, const Params& P) {
    static bool attr = false;
    if (!attr) { (void)hipFuncSetAttribute((const void*)phase_k<PH>, hipFuncAttributeMaxDynamicSharedMemorySize, LDS_BYTES); attr = true; }
    hipLaunchKernelGGL(phase_k<PH>, dim3(256), dim3(NT), LDS_BYTES, st, P);
}
}
#ifndef FAST_MASK
#define FAST_MASK 0xfff
#endif
extern "C" void kernel_launch(void* const* d_in, const int* in_sizes, int n_in, void* d_out, int out_size, void* d_ws, size_t ws_size, hipStream_t stream) {
    Params P{};
    P.x = (const float*)d_in[0]; P.p = (const float*)d_in[1]; P.pos = (const int*)d_in[2]; P.norm_mix = (const float*)d_in[3]; P.w_in = (const float*)d_in[4];
    P.up_f = (const float*)d_in[5]; P.bias_f = (const float*)d_in[6]; P.up_b = (const float*)d_in[7]; P.bias_b = (const float*)d_in[8]; P.sink = (const float*)d_in[9];
    P.gla_norm = (const float*)d_in[10]; P.w_ba = (const float*)d_in[11]; P.w_bg = (const float*)d_in[12]; P.w_out = (const float*)d_in[13]; P.norm_ffn = (const float*)d_in[14];
    P.w_router = (const float*)d_in[15]; P.w_eg = (const float*)d_in[16]; P.w_eu = (const float*)d_in[17]; P.w_ed = (const float*)d_in[18]; P.norm_ple = (const float*)d_in[19];
    P.w_pg = (const float*)d_in[20]; P.w_ple = (const float*)d_in[21]; P.norm_final = (const float*)d_in[22];
    P.out = (float*)d_out; P.ws = (char*)d_ws;
    if (ws_size < WS_END) { fprintf(stderr, "workspace too small: %zu < %zu\n", ws_size, (size_t)WS_END); return; }
    (void)hipMemsetAsync((char*)d_ws + WS_CTL, 0, 1 * MiB, stream);
#define RUN(bit, FAST, NAIVE) do { if (FAST_MASK & (1u << (bit))) { FAST; } else { NAIVE; } } while (0)
    RUN(0, mk::launch_phase<0>(stream, P), nv::P0(stream, P));
    RUN(1, mk::launch_phase<1>(stream, P), nv::P1(stream, P));
    RUN(2, mk::launch_phase<20>(stream, P), nv::P2_attn(stream, P));
    RUN(11, mk::launch_phase<21>(stream, P), nv::P2_gla(stream, P));
    RUN(3, (mk::launch_phase<30>(stream, P), mk::launch_phase<31>(stream, P), mk::launch_phase<32>(stream, P)), nv::P3(stream, P));
    RUN(4, (mk::launch_phase<40>(stream, P), mk::launch_phase<41>(stream, P)), nv::P4(stream, P));
    RUN(5, mk::launch_phase<5>(stream, P), nv::P5(stream, P));
    RUN(6, mk::launch_phase<6>(stream, P), nv::P6(stream, P));
    RUN(7, mk::launch_phase<7>(stream, P), nv::P7(stream, P));
    RUN(8, mk::launch_phase<8>(stream, P), nv::P8(stream, P));
    RUN(9, (mk::launch_phase<90>(stream, P), mk::launch_phase<91>(stream, P)), nv::P9(stream, P));
    RUN(10, mk::launch_phase<10>(stream, P), nv::P10(stream, P));
}
```

```cpp
#include <hip/hip_runtime.h>
#include <cstdio>
#include <cstdint>

constexpr int B_ = 4, S_ = 4096, D_ = 1024, T_ = B_ * S_;
constexpr int IN_DIM = 5920;
constexpr int C_Q = 0, C_K = 512, C_V = 640, C_GQ = 768, C_GK = 1280, C_GV = 1792, C_GR = 2816, C_ZF = 3840, C_ZB = 3856, C_GATT = 3872, C_GGLA = 4896;
constexpr int NE = 16, CAP = 512, FF = 1024, PLE = 256, ME = B_ * CAP;
constexpr float EPS = 1e-6f;
constexpr float LOG2E = 1.4426950408889634f;
constexpr float QSCALE = 0.125f * LOG2E;
constexpr float GQSCALE = 0.08838834764831845f;

typedef float f32x4 __attribute__((ext_vector_type(4)));
typedef float f32x2 __attribute__((ext_vector_type(2)));
typedef unsigned short bf16;
typedef unsigned u32x4 __attribute__((ext_vector_type(4)));
typedef unsigned u32x2 __attribute__((ext_vector_type(2)));

constexpr size_t MiB = 1u << 20;
constexpr size_t WS_CTL = 0, WS_ROPE = 1 * MiB, WS_AFF = 2 * MiB, WS_INV = 3 * MiB, WS_GIDX = 4 * MiB, WS_Z = 5 * MiB;
constexpr size_t WS_WIN = 8 * MiB, WS_WA = 20 * MiB, WS_WB = 21 * MiB, WS_WO = 23 * MiB, WS_WPG = 25 * MiB, WS_WPLE = 27 * MiB;
constexpr size_t WS_A0 = 28 * MiB;
constexpr size_t WS_QKV = 60 * MiB;
constexpr size_t WS_GQK = 84 * MiB;
constexpr size_t WS_GV = 116 * MiB;
constexpr size_t WS_GR = 148 * MiB;
constexpr size_t WS_GATT = 180 * MiB;
constexpr size_t WS_GGLA = 212 * MiB;
constexpr size_t WS_OB = 244 * MiB;
constexpr size_t WS_ATT = 276 * MiB;
constexpr size_t WS_OF = WS_A0, WS_XN = WS_A0, WS_XN3 = WS_A0, WS_GLAO = WS_GQK, WS_MERGED = WS_GV, WS_H = WS_GR, WS_HID = WS_QKV, WS_PLET = WS_QKV;
constexpr size_t WS_WEG = 212 * MiB, WS_WEU = 244 * MiB, WS_WED = 276 * MiB, WS_END = 308 * MiB;

__device__ __forceinline__ unsigned f2bf(float f) { unsigned u = __builtin_bit_cast(unsigned, f); return (u + 0x7fffu + ((u >> 16) & 1u)) >> 16; }
__device__ __forceinline__ float bf2f(unsigned h) { return __builtin_bit_cast(float, h << 16); }
__device__ __forceinline__ unsigned pk2(float lo, float hi) { return f2bf(lo) | (f2bf(hi) << 16); }
__device__ __forceinline__ float sigmoidf_(float x) { return 1.0f / (1.0f + __expf(-x)); }
__device__ __forceinline__ float wave_sum(float v) {
#pragma unroll
    for (int o = 1; o < 64; o <<= 1) v += __shfl_xor(v, o);
    return v;
}

struct Params {
    const float *x, *p; const int* pos; const float *norm_mix, *w_in, *up_f, *bias_f, *up_b, *bias_b, *sink, *gla_norm, *w_ba, *w_bg, *w_out,
        *norm_ffn, *w_router, *w_eg, *w_eu, *w_ed, *norm_ple, *w_pg, *w_ple, *norm_final;
    float* out; char* ws;
};
namespace pg8 {
#define PG8_LAS __attribute__((address_space(3)))
typedef short bf16x8 __attribute__((ext_vector_type(8)));
constexpr int BM = 256, BK = 64, HALF = 128, HTB = HALF * BK * 2  , STAGE_BYTES = 8 * HTB;

__host__ __device__ __forceinline__ int lds_byte(int r, int c) { const int st = (r >> 4) * 2 + (c >> 5), rr = r & 15, cc = c & 31, ob = rr * 64 + cc * 2; return st * 1024 + (ob ^ (((ob >> 9) & 1) << 5)); }
__host__ __device__ __forceinline__ void stage_rc(int b, int& R, int& C) { const int st = b / 1024, sb = b % 1024, swz = sb ^ (((sb >> 9) & 1) << 5); R = (st >> 1) * 16 + swz / 64; C = (st & 1) * 32 + (swz % 64) / 2; }
__host__ __device__ __forceinline__ int perm32(int rho) { const int n = rho >> 4, i = rho & 15; return 8 * (i >> 2) + 4 * n + (i & 3); }

struct Unit { const char* a; const char* b0; const char* b1; const int* gi; int pm, pn, e, pad; };

__device__ __forceinline__ unsigned cvt_pk_bf16(float lo, float hi) { unsigned r; asm volatile("v_cvt_pk_bf16_f32 %0, %1, %2" : "=v"(r) : "v"(lo), "v"(hi)); return r; }

template <class Epi, class Sched, bool GATHER, bool ALIGN_EPI>
__device__ __forceinline__ void gemm_phase(PG8_LAS unsigned char* lds, const int K, const Sched& S, const Epi& E) {
    int tid_ = threadIdx.x; asm volatile("" : "+v"(tid_));
    const int tid = tid_, wid = __builtin_amdgcn_readfirstlane(tid >> 6), lane = tid & 63, wr = wid >> 2, wc = wid & 3, fr = lane & 15, fq = lane >> 4;
    const int nt = K / BK;
    int sR[2], sC[2];
    unsigned voffB[2], voffA[2][2];
#pragma unroll
    for (int i = 0; i < 2; ++i) { stage_rc(tid * 16 + i * 8192, sR[i], sC[i]); const int Rb = Epi::PERM ? ((sR[i] & ~31) + perm32(sR[i] & 31)) : sR[i];
        voffB[i] = (unsigned)(Rb * K + sC[i]) * 2u;
        voffA[0][i] = (unsigned)(sR[i] * K + sC[i]) * 2u; voffA[1][i] = (unsigned)((sR[i] + HALF) * K + sC[i]) * 2u; }
    const size_t kstep = (size_t)(BK * 2);
    const unsigned ldsw = (unsigned)wid * 1024u;
    const int aoff = lds_byte(wr * 64 + fr, fq * 8), boff = lds_byte(wc * 32 + fr, fq * 8);
#define PG8_SA(b, h) (((b) * 2 + (h)) * HTB)
#define PG8_SB(b, h) ((4 + (b) * 2 + (h)) * HTB)
#define PG8_STAGE(bufoff, gbase, voff) do { _Pragma("unroll") for (int _i = 0; _i < 2; ++_i) \
        __builtin_amdgcn_global_load_lds((const unsigned*)((const char*)(gbase) + (voff)[_i]), (PG8_LAS unsigned*)(lds + (bufoff) + ldsw + _i * 8192), 16, 0, 0); } while (0)
#define PG8_LDA(dst, b, h) do { _Pragma("unroll") for (int m = 0; m < 4; ++m) _Pragma("unroll") for (int k = 0; k < 2; ++k) dst[m][k] = *(const PG8_LAS bf16x8*)(lds + PG8_SA(b, h) + aoff + m * 2048 + k * 1024); } while (0)
#define PG8_LDB(dst, b, h) do { _Pragma("unroll") for (int n = 0; n < 2; ++n) _Pragma("unroll") for (int k = 0; k < 2; ++k) dst[n][k] = *(const PG8_LAS bf16x8*)(lds + PG8_SB(b, h) + boff + n * 2048 + k * 1024); } while (0)
#define PG8_MMA(ai, bj, At, Bt) do { __builtin_amdgcn_s_setprio(1); _Pragma("unroll") for (int m = 0; m < 4; ++m) _Pragma("unroll") for (int n = 0; n < 2; ++n) _Pragma("unroll") for (int k = 0; k < 2; ++k) \
        acc[ai][bj][m][n] = __builtin_amdgcn_mfma_f32_16x16x32_bf16(Bt[n][k], At[m][k], acc[ai][bj][m][n], 0, 0, 0); __builtin_amdgcn_s_setprio(0); } while (0)
#define PG8_WAIT_V(n) asm volatile("s_waitcnt vmcnt(" #n ")" ::: "memory")
#define PG8_WAIT_L(n) asm volatile("s_waitcnt lgkmcnt(" #n ")" ::: "memory")
#define PG8_BAR __builtin_amdgcn_s_barrier()
#define PG8_SCHED __builtin_amdgcn_sched_barrier(0)
    Unit cur, nxt; int ui = 0;
    if (!S.next(0, cur)) return;
    if constexpr (GATHER) {
#pragma unroll
        for (int h = 0; h < 2; ++h)
#pragma unroll
            for (int i = 0; i < 2; ++i) voffA[h][i] = (unsigned)(cur.gi[h * HALF + sR[i]] * K + sC[i]) * 2u;
    }
    f32x4 acc[2][2][4][2];
#pragma unroll
    for (int a = 0; a < 2; ++a)
#pragma unroll
        for (int b = 0; b < 2; ++b)
#pragma unroll
            for (int m = 0; m < 4; ++m)
#pragma unroll
                for (int n = 0; n < 2; ++n) acc[a][b][m][n] = (f32x4){0.f, 0.f, 0.f, 0.f};
    bf16x8 At[4][2], B0[2][2], B1[2][2];
    const char* cA = cur.a; const char* cB0 = cur.b0; const char* cB1 = cur.b1;
    PG8_STAGE(PG8_SB(0, 0), cB0, voffB); PG8_STAGE(PG8_SB(0, 1), cB1, voffB); PG8_STAGE(PG8_SA(0, 0), cA, voffA[0]); PG8_STAGE(PG8_SA(0, 1), cA, voffA[1]);
    if (wr == 1) PG8_BAR;
    PG8_WAIT_V(2); PG8_BAR;
    PG8_STAGE(PG8_SB(1, 0), cB0 + kstep, voffB); PG8_STAGE(PG8_SA(1, 0), cA + kstep, voffA[0]); PG8_STAGE(PG8_SB(1, 1), cB1 + kstep, voffB);
    PG8_WAIT_V(6); PG8_BAR;
    for (;;) {
        const bool has_next = S.next(ui + 1, nxt);
        unsigned voffN[2][2];
#pragma unroll
        for (int h = 0; h < 2; ++h)
#pragma unroll
            for (int i = 0; i < 2; ++i) voffN[h][i] = voffA[h][i];
        if constexpr (GATHER) { if (has_next) {
#pragma unroll
            for (int h = 0; h < 2; ++h)
#pragma unroll
                for (int i = 0; i < 2; ++i) voffN[h][i] = (unsigned)(nxt.gi[h * HALF + sR[i]] * K + sC[i]) * 2u; } }
        const char* nA = has_next ? nxt.a : cA; const char* nB0 = has_next ? nxt.b0 : cB0; const char* nB1 = has_next ? nxt.b1 : cB1;
        for (int t = 0; t < nt; t += 2) {
            const bool last = (t == nt - 2);
            const char* a1 = cA + (size_t)(t + 1) * kstep;
            const char* a2 = last ? nA : cA + (size_t)(t + 2) * kstep;
            const char* b20 = last ? nB0 : cB0 + (size_t)(t + 2) * kstep; const char* b21 = last ? nB1 : cB1 + (size_t)(t + 2) * kstep;
            const char* a3 = a2 + kstep; const char* b30 = b20 + kstep; const char* b31 = b21 + kstep;
            unsigned va0[2], va1[2];
#pragma unroll
            for (int i = 0; i < 2; ++i) { va0[i] = last ? voffN[0][i] : voffA[0][i]; va1[i] = last ? voffN[1][i] : voffA[1][i]; }
            PG8_LDB(B0, 0, 0); PG8_LDB(B1, 0, 1); PG8_SCHED; PG8_LDA(At, 0, 0); PG8_STAGE(PG8_SA(1, 1), a1, voffA[1]);
            PG8_WAIT_V(8); PG8_WAIT_L(0); PG8_BAR; PG8_MMA(0, 0, At, B0); PG8_MMA(0, 1, At, B1); PG8_BAR; PG8_SCHED;
            PG8_LDA(At, 0, 1); PG8_STAGE(PG8_SB(0, 0), b20, voffB); PG8_STAGE(PG8_SB(0, 1), b21, voffB); PG8_STAGE(PG8_SA(0, 0), a2, va0);
            PG8_WAIT_V(8); PG8_WAIT_L(0); PG8_BAR; PG8_MMA(1, 0, At, B0); PG8_MMA(1, 1, At, B1); PG8_BAR; PG8_SCHED;
            PG8_LDB(B0, 1, 0); PG8_LDB(B1, 1, 1); PG8_SCHED; PG8_LDA(At, 1, 0); PG8_STAGE(PG8_SA(0, 1), a2, va1);
            PG8_WAIT_V(8); PG8_WAIT_L(0); PG8_BAR; PG8_MMA(0, 0, At, B0); PG8_MMA(0, 1, At, B1); PG8_BAR; PG8_SCHED;
            PG8_LDA(At, 1, 1); PG8_STAGE(PG8_SB(1, 0), b30, voffB); PG8_STAGE(PG8_SB(1, 1), b31, voffB); PG8_STAGE(PG8_SA(1, 0), a3, va0);
            PG8_WAIT_V(8); PG8_WAIT_L(0); PG8_BAR; PG8_MMA(1, 0, At, B0); PG8_MMA(1, 1, At, B1); PG8_BAR; PG8_SCHED;
        }
        if constexpr (ALIGN_EPI) { if (wr == 0) PG8_BAR; }
        E(acc, cur, wr, wc, fr, fq);
        if (!has_next) break;
#pragma unroll
        for (int a = 0; a < 2; ++a)
#pragma unroll
            for (int b = 0; b < 2; ++b)
#pragma unroll
                for (int m = 0; m < 4; ++m)
#pragma unroll
                    for (int n = 0; n < 2; ++n) acc[a][b][m][n] = (f32x4){0.f, 0.f, 0.f, 0.f};
        cur = nxt; cA = nA; cB0 = nB0; cB1 = nB1; ++ui;
#pragma unroll
        for (int h = 0; h < 2; ++h)
#pragma unroll
            for (int i = 0; i < 2; ++i) voffA[h][i] = voffN[h][i];
        if constexpr (ALIGN_EPI) { if (wr == 1) PG8_BAR; }
    }
    PG8_WAIT_V(0);
    if constexpr (!ALIGN_EPI) { if (wr == 0) PG8_BAR; }
    PG8_BAR;
#undef PG8_SA
#undef PG8_SB
#undef PG8_STAGE
#undef PG8_LDA
#undef PG8_LDB
#undef PG8_MMA
#undef PG8_WAIT_V
#undef PG8_WAIT_L
#undef PG8_BAR
#undef PG8_SCHED
}

struct DenseOrder {
    const char* A; const char* Bt; int K, nM, nN, nwg, G, c;
    __device__ void init(const void* A_, const void* Bt_, int M, int N, int K_, int G_, int c_) { A = (const char*)A_; Bt = (const char*)Bt_; K = K_; nM = M / BM; nN = N / BM; nwg = nM * nN; G = G_; c = c_; }
    __device__ bool next(int i, Unit& u) const {
        const long L = (long)i * G + c; if (L >= nwg) return false;
        int wgid = (int)L; { const int q = nwg / 8, r = nwg % 8, xcd = wgid % 8, off = wgid / 8; wgid = (xcd < r ? xcd * (q + 1) : r * (q + 1) + (xcd - r) * q) + off; }
        const int nig = 8 * nN, gid = wgid / nig, fm = gid * 8, gsz = (nM - fm) < 8 ? (nM - fm) : 8;
        u.pm = fm + ((wgid % nig) % gsz); u.pn = (wgid % nig) / gsz; u.e = 0; u.pad = 0; u.gi = nullptr;
        u.a = A + (size_t)u.pm * BM * K * 2; u.b0 = Bt + (size_t)u.pn * BM * K * 2; u.b1 = u.b0 + (size_t)HALF * K * 2; return true;
    }
};
}
namespace mk {
constexpr int NWAVES = 8, NT = NWAVES * 64;
constexpr int RING_OFF = 0, RING_BYTES = 131072;
constexpr int LDSCTL_OFF = RING_BYTES, MISC_OFF = LDSCTL_OFF + 320;
constexpr int LDS_BYTES = 147456;
#define GAS __attribute__((address_space(1)))
#define LAS __attribute__((address_space(3)))
typedef GAS unsigned gu32;
#define RLX_AGENT __ATOMIC_RELAXED, __HIP_MEMORY_SCOPE_AGENT
#define LDS_WAIT() asm volatile("s_waitcnt lgkmcnt(0)" ::: "memory")
#define VM_WAIT() asm volatile("s_waitcnt vmcnt(0)" ::: "memory")

#define XB_TMO      128
#define XB_XCNT(j)  (256  + 64 * (j))
#define XB_XSUB(j)  (1280 + 64 * (j))
#define XB_XGEN(j)  (2304 + 64 * (j))
#define XB_TOP      3328
#define XB_TOPGEN   3392
#define XCD_BAR_WORDS 3456
#define XB_SPIN_CAP (1u << 18)
__device__ __forceinline__ unsigned xb_ld(unsigned* p)              { return __hip_atomic_load(p, __ATOMIC_RELAXED, __HIP_MEMORY_SCOPE_AGENT); }
__device__ __forceinline__ unsigned xb_add(unsigned* p, unsigned v) { return __hip_atomic_fetch_add(p, v, __ATOMIC_RELAXED, __HIP_MEMORY_SCOPE_AGENT); }
__device__ __forceinline__ unsigned xb_xcc_id() { return (unsigned)__builtin_amdgcn_s_getreg((3 << 11) | 20) & 0xFu; }
#define XB_SPIN(cond, bar) do { unsigned _sp = 0; while (cond) { __builtin_amdgcn_s_sleep(1); \
    if ((++_sp & 255u) == 0u) { if (xb_ld(&(bar)[XB_TMO])) break; if (_sp > XB_SPIN_CAP) { atomicAdd(&(bar)[XB_TMO], 1u); break; } } } } while (0)
struct XcdBarrier { unsigned* bar; unsigned x; volatile LAS unsigned* st; };
__device__ __forceinline__ XcdBarrier xcd_barrier_post(unsigned* bar, volatile LAS unsigned* st) {
    XcdBarrier b; b.bar = bar; b.x = xb_xcc_id(); b.st = st;
    if (threadIdx.x == 0) (void)xb_add(&bar[XB_XCNT(b.x)], 1u);
    return b;
}
__device__ __forceinline__ void xcd_barrier_complete(unsigned* bar, unsigned x, unsigned& nloc, unsigned& nx) {
    const unsigned G = gridDim.x * gridDim.y * gridDim.z;
    unsigned sum, cnt, mine, sp = 0u;
    for (;;) {
        sum = 0u; cnt = 0u; mine = 0u;
#pragma unroll
        for (unsigned j = 0; j < 16; ++j) { const unsigned c = xb_ld(&bar[XB_XCNT(j)]); sum += c; cnt += (c > 0u) ? 1u : 0u; mine = (j == x) ? c : mine; }
        if (sum == G) break;
        __builtin_amdgcn_s_sleep(1);
        if ((++sp & 255u) == 0u) { if (xb_ld(&bar[XB_TMO])) break; if (sp > XB_SPIN_CAP) { atomicAdd(&bar[XB_TMO], 1u); break; } }
    }
    nloc = mine > 0u ? mine : 1u; nx = cnt > 0u ? cnt : 1u;
}
__device__ __forceinline__ void xcd_barrier(const XcdBarrier& b) {
    asm volatile("s_waitcnt vmcnt(0)" ::: "memory");
    __syncthreads();
    if (threadIdx.x == 0) {
        unsigned* bar = b.bar;
        __builtin_amdgcn_s_waitcnt(0);
        unsigned nloc = b.st[0], nx = b.st[1];
        if (nloc == 0u) { xcd_barrier_complete(bar, b.x, nloc, nx); b.st[0] = nloc; b.st[1] = nx; }
        const unsigned old = xb_add(&bar[XB_XSUB(b.x)], 1u);
        const unsigned gen = old / nloc;
        if (old + 1u == (gen + 1u) * nloc) {
            __builtin_amdgcn_fence(__ATOMIC_RELEASE, "agent");
            asm volatile("s_waitcnt vmcnt(0)" ::: "memory");
            const unsigned og = xb_add(&bar[XB_TOP], 1u);
            const unsigned tg = og / nx;
            if (og + 1u == (tg + 1u) * nx) xb_add(&bar[XB_TOPGEN], 1u);
            else XB_SPIN(xb_ld(&bar[XB_TOPGEN]) == tg, bar);
            __builtin_amdgcn_fence(__ATOMIC_ACQUIRE, "agent");
            xb_add(&bar[XB_XGEN(b.x)], 1u);
            asm volatile("s_waitcnt vmcnt(0)" ::: "memory");
        } else {
            XB_SPIN(xb_ld(&bar[XB_XGEN(b.x)]) == gen, bar);
            __builtin_amdgcn_fence(__ATOMIC_ACQUIRE, "agent");
            asm volatile("s_waitcnt vmcnt(0)" ::: "memory");
        }
    }
    __syncthreads();
}

struct Frame {
    LAS unsigned char* lds; char* ws;
    int tid, lane, wave, vcu, G;
};

__device__ __forceinline__ void p0_transpose_item(const float* W, int K, int N, bf16* WT, int dst_row0, LAS float* scr, int k0, int n0, int lane) {
#pragma unroll 8
    for (int i = 0; i < 32; ++i) { const int kk = 2 * i + (lane >> 5); scr[kk * 33 + (lane & 31)] = W[(size_t)(k0 + kk) * N + n0 + (lane & 31)]; }
    LDS_WAIT(); asm volatile("" ::: "memory");
    const int c = lane & 7;
#pragma unroll
    for (int j = 0; j < 4; ++j) { const int n = (lane >> 3) + 8 * j; const LAS float* s = scr + (8 * c) * 33 + n;
        u32x4 o; o.x = pk2(s[0 * 33], s[1 * 33]); o.y = pk2(s[2 * 33], s[3 * 33]); o.z = pk2(s[4 * 33], s[5 * 33]); o.w = pk2(s[6 * 33], s[7 * 33]);
        *(GAS u32x4*)(WT + (size_t)(dst_row0 + n) * K + k0 + 8 * c) = o; }
    LDS_WAIT(); asm volatile("" ::: "memory");
}
__device__ __forceinline__ void p0_matrix(Frame& F, const float* W, int K, int N, bf16* WT, LAS float* scr, int it) {
    const int nblk = N / 32, kb = it / nblk, nb = it % nblk;
    p0_transpose_item(W, K, N, WT, 32 * nb, scr, 64 * kb, 32 * nb, F.lane);
}
__device__ __forceinline__ void phase0(Frame& F, const Params& P) {
    LAS float* scr = (LAS float*)(F.lds + RING_OFF + F.wave * 16384);
    const int gw = F.vcu * NWAVES + F.wave, NGW = F.G * NWAVES;
    constexpr int I_IN = 16 * 185, I_A = 8 * 32, I_SQ = 16 * 32, I_PLE = 4 * 32;
    constexpr int NITEMS = I_IN + I_A + 3 * I_SQ + I_PLE;
    for (int it = gw; it < NITEMS; it += NGW) {
        int r = it;
        if (r < I_IN) { const int kb = r / 185, nb = r % 185; const int dst = nb < 120 ? 32 * nb : (nb == 120 ? 5888 : 32 * nb - 32);
            p0_transpose_item(P.w_in, D_, IN_DIM, (bf16*)(F.ws + WS_WIN), dst, scr, 64 * kb, 32 * nb, F.lane); continue; } r -= I_IN;
        if (r < I_A) { p0_matrix(F, P.w_ba, 512, D_, (bf16*)(F.ws + WS_WA), scr, r); continue; } r -= I_A;
        if (r < I_SQ) { p0_matrix(F, P.w_bg, D_, D_, (bf16*)(F.ws + WS_WB), scr, r); continue; } r -= I_SQ;
        if (r < I_SQ) { p0_matrix(F, P.w_out, D_, D_, (bf16*)(F.ws + WS_WO), scr, r); continue; } r -= I_SQ;
        if (r < I_SQ) { p0_matrix(F, P.w_pg, D_, D_, (bf16*)(F.ws + WS_WPG), scr, r); continue; } r -= I_SQ;
        p0_matrix(F, P.w_ple, PLE, D_, (bf16*)(F.ws + WS_WPLE), scr, r);
    }
    for (int i = (F.vcu * NT + F.tid); i < 28672; i += F.G * NT) *((GAS u32x4*)(F.ws + WS_WIN + (size_t)5920 * 2048) + i) = (u32x4){0u, 0u, 0u, 0u};
    for (int m = gw; m < T_; m += NGW) {
        const GAS f32x4* xr = (const GAS f32x4*)(P.x + (size_t)m * D_) + F.lane;
        f32x4 v[4]; float s = 0.f;
#pragma unroll
        for (int j = 0; j < 4; ++j) { v[j] = xr[64 * j]; s += (v[j].x * v[j].x + v[j].y * v[j].y) + (v[j].z * v[j].z + v[j].w * v[j].w); }
        const float r = 1.0f / sqrtf(wave_sum(s) * (1.0f / D_) + EPS);
        GAS u32x2* o8 = (GAS u32x2*)(F.ws + WS_A0 + (size_t)m * D_ * 2) + F.lane;
#pragma unroll
        for (int j = 0; j < 4; ++j) { const f32x4 g = ((const GAS f32x4*)P.norm_mix)[F.lane + 64 * j]; const f32x4 y = v[j] * r * g; o8[64 * j] = (u32x2){pk2(y.x, y.y), pk2(y.z, y.w)}; }
    }
    for (int gid = F.vcu * NT + F.tid; gid < T_ * 8; gid += F.G * NT) {
        const int i = gid & 7, t = gid >> 3;
        const float invf = i == 0 ? 1.0f : i == 1 ? 0.1939227432012558f : i == 2 ? 0.03760603070259094f : i == 3 ? 0.007292664609849453f : i == 4 ? 0.0014142135623842478f : i == 5 ? 0.00027424818836152554f : i == 6 ? 5.3182957344688475e-05f : 1.0313385246263351e-05f;
        const float ang = (float)P.pos[t] * invf;
        float* RT = (float*)(F.ws + WS_ROPE);
        RT[t * 16 + i] = cosf(ang); RT[t * 16 + 8 + i] = sinf(ang);
    }
}

struct EpiInProj {
    static constexpr bool PERM = true;
    char* ws;
    __device__ __forceinline__ void operator()(const f32x4 (&acc)[2][2][4][2], const pg8::Unit& u, int wr, int wc, int fr, int fq) const {
        const int pn = u.pn; const int row0 = u.pm * 256 + wr * 64 + fr;
        if (pn == 23) {
            if (wc == 0) {
#pragma unroll
                for (int ai = 0; ai < 2; ++ai)
#pragma unroll
                    for (int m = 0; m < 4; ++m) { float* zp = (float*)(ws + WS_Z) + (size_t)(row0 + ai * 128 + m * 16) * 32 + 8 * fq; *(f32x4*)zp = acc[ai][0][m][0]; *(f32x4*)(zp + 4) = acc[ai][0][m][1]; }
            }
            return;
        }
        bf16* base; int ldc, ct; float sc = 1.f;
        if (pn < 3) { base = (bf16*)(ws + WS_QKV); ldc = 768; ct = pn * 256; if (pn < 2) sc = QSCALE; }
        else { const int g = (pn - 3) >> 2; ct = ((pn - 3) & 3) * 256; ldc = 1024; base = (bf16*)(ws + (g == 0 ? WS_GQK : g == 1 ? WS_GV : g == 2 ? WS_GR : g == 3 ? WS_GATT : WS_GGLA)); if (g == 0 && ct < 512) sc = GQSCALE; }
        const bool rope_wave = (pn < 3) && ((wc & 1) == 0);
        const float* RT = (const float*)(ws + WS_ROPE);
#pragma unroll
        for (int ai = 0; ai < 2; ++ai)
#pragma unroll
            for (int m = 0; m < 4; ++m) {
                const int r = row0 + ai * 128 + m * 16;
                f32x4 cs0, cs1, sn0, sn1;
                if (rope_wave) { const f32x4* rp = (const f32x4*)(RT + (size_t)r * 16); cs0 = rp[0]; cs1 = rp[1]; sn0 = rp[2]; sn1 = rp[3]; }
#pragma unroll
                for (int bj = 0; bj < 2; ++bj) {
                    f32x4 v0 = acc[ai][bj][m][0], v1 = acc[ai][bj][m][1];
                    if (rope_wave && !(pn == 2 && bj == 1)) {
                        f32x4 o0, o1;
#pragma unroll
                        for (int j = 0; j < 4; ++j) { o0[j] = __shfl_xor(v0[j], 16); o1[j] = __shfl_xor(v1[j], 16); }
                        if (fq == 0) { v0 = v0 * cs0 - o0 * sn0; v1 = v1 * cs1 - o1 * sn1; }
                        else if (fq == 1) { v0 = v0 * cs0 + o0 * sn0; v1 = v1 * cs1 + o1 * sn1; }
                    }
                    v0 = v0 * sc; v1 = v1 * sc;
                    u32x4 w; w.x = pg8::cvt_pk_bf16(v0[0], v0[1]); w.y = pg8::cvt_pk_bf16(v0[2], v0[3]); w.z = pg8::cvt_pk_bf16(v1[0], v1[1]); w.w = pg8::cvt_pk_bf16(v1[2], v1[3]);
                    *(u32x4*)(base + (size_t)r * ldc + ct + bj * 128 + wc * 32 + 8 * fq) = w;
                }
            }
    }
};
__device__ __forceinline__ void phase1(Frame& F, const Params& P) {
    pg8::DenseOrder S; S.init(F.ws + WS_A0, F.ws + WS_WIN, T_, 6144, D_, F.G, (int)blockIdx.x);
    EpiInProj E{F.ws};
    pg8::gemm_phase<EpiInProj, pg8::DenseOrder, false, true>(F.lds + RING_OFF, D_, S, E);
}


__device__ __forceinline__ f32x4 ldbf4(const bf16* p) { const u32x2 r = *(const u32x2*)p; return (f32x4){bf2f(r.x & 0xffffu), bf2f(r.x >> 16), bf2f(r.y & 0xffffu), bf2f(r.y >> 16)}; }
__device__ __forceinline__ void stbf4(bf16* p, f32x4 v) { *(u32x2*)p = (u32x2){pk2(v.x, v.y), pk2(v.z, v.w)}; }
__device__ __forceinline__ f32x4 sig4(f32x4 g) { return (f32x4){sigmoidf_(g.x), sigmoidf_(g.y), sigmoidf_(g.z), sigmoidf_(g.w)}; }

__device__ __forceinline__ void phase3_pre(Frame& F, const Params& P) {
    const bf16* OFp = (const bf16*)(F.ws + WS_OF); const bf16* OBp = (const bf16*)(F.ws + WS_OB); const bf16* GR = (const bf16*)(F.ws + WS_GR); bf16* GLAO = (bf16*)(F.ws + WS_GLAO);
    const int gw0 = F.vcu * NWAVES + F.wave, NGW = F.G * NWAVES;
    for (int gw = gw0; gw < T_ * 4; gw += NGW) {
        const int h = gw & 3; const long t = gw >> 2; const long off = t * 1024 + h * 256 + F.lane * 4;
        const f32x4 x = ldbf4(OFp + off) + ldbf4(OBp + off);
        const float s = wave_sum(x.x * x.x + x.y * x.y + x.z * x.z + x.w * x.w);
        const float r = 1.0f / sqrtf(s * (1.0f / 256.0f) + EPS);
        const f32x4 g = *(const f32x4*)(P.gla_norm + h * 256 + F.lane * 4); const f32x4 gr = ldbf4(GR + off);
        stbf4(GLAO + off, x * r * g * gr * sig4(gr));
    }
}
struct EpiGate1 {
    static constexpr bool PERM = false;
    const bf16* G; float* C;
    __device__ __forceinline__ void operator()(const f32x4 (&acc)[2][2][4][2], const pg8::Unit& u, int wr, int wc, int fr, int fq) const {
        const int row0 = u.pm * 256 + wr * 64 + fr, col0 = u.pn * 256 + wc * 32 + 4 * fq;
#pragma unroll
        for (int ai = 0; ai < 2; ++ai)
#pragma unroll
            for (int m = 0; m < 4; ++m) { const size_t ro = (size_t)(row0 + ai * 128 + m * 16) * D_ + col0;
#pragma unroll
                for (int bj = 0; bj < 2; ++bj)
#pragma unroll
                    for (int n = 0; n < 2; ++n) { const size_t o = ro + bj * 128 + n * 16; *(f32x4*)(C + o) = sig4(ldbf4(G + o)) * acc[ai][bj][m][n]; } }
    }
};
struct EpiGate2 {
    static constexpr bool PERM = true;
    const bf16* G; const float* Tm; bf16* C;
    __device__ __forceinline__ void operator()(const f32x4 (&acc)[2][2][4][2], const pg8::Unit& u, int wr, int wc, int fr, int fq) const {
        const int row0 = u.pm * 256 + wr * 64 + fr, col0 = u.pn * 256 + wc * 32 + 8 * fq;
#pragma unroll
        for (int ai = 0; ai < 2; ++ai)
#pragma unroll
            for (int m = 0; m < 4; ++m) { const size_t ro = (size_t)(row0 + ai * 128 + m * 16) * D_ + col0;
#pragma unroll
                for (int bj = 0; bj < 2; ++bj) { const size_t o = ro + bj * 128;
                    const f32x4 v0 = *(const f32x4*)(Tm + o) + sig4(ldbf4(G + o)) * acc[ai][bj][m][0], v1 = *(const f32x4*)(Tm + o + 4) + sig4(ldbf4(G + o + 4)) * acc[ai][bj][m][1];
                    u32x4 w; w.x = pg8::cvt_pk_bf16(v0[0], v0[1]); w.y = pg8::cvt_pk_bf16(v0[2], v0[3]); w.z = pg8::cvt_pk_bf16(v1[0], v1[1]); w.w = pg8::cvt_pk_bf16(v1[2], v1[3]);
                    *(u32x4*)(C + o) = w; } }
    }
};
__device__ __forceinline__ void phase3a(Frame& F, const Params& P) {
    pg8::DenseOrder S; S.init(F.ws + WS_ATT, F.ws + WS_WA, T_, D_, 512, F.G, (int)blockIdx.x);
    EpiGate1 E{(const bf16*)(F.ws + WS_GATT), P.out};
    pg8::gemm_phase<EpiGate1, pg8::DenseOrder, false, false>(F.lds + RING_OFF, 512, S, E);
}
__device__ __forceinline__ void phase3b(Frame& F, const Params& P) {
    pg8::DenseOrder S; S.init(F.ws + WS_GLAO, F.ws + WS_WB, T_, D_, D_, F.G, (int)blockIdx.x);
    EpiGate2 E{(const bf16*)(F.ws + WS_GGLA), P.out, (bf16*)(F.ws + WS_MERGED)};
    pg8::gemm_phase<EpiGate2, pg8::DenseOrder, false, false>(F.lds + RING_OFF, D_, S, E);
}
struct EpiResid {
    static constexpr bool PERM = false;
    const float* R; float* C;
    __device__ __forceinline__ void operator()(const f32x4 (&acc)[2][2][4][2], const pg8::Unit& u, int wr, int wc, int fr, int fq) const {
        const int row0 = u.pm * 256 + wr * 64 + fr, col0 = u.pn * 256 + wc * 32 + 4 * fq;
#pragma unroll
        for (int ai = 0; ai < 2; ++ai)
#pragma unroll
            for (int m = 0; m < 4; ++m) { const size_t ro = (size_t)(row0 + ai * 128 + m * 16) * D_ + col0;
#pragma unroll
                for (int bj = 0; bj < 2; ++bj)
#pragma unroll
                    for (int n = 0; n < 2; ++n) { const size_t o = ro + bj * 128 + n * 16; *(f32x4*)(C + o) = *(const f32x4*)(R + o) + acc[ai][bj][m][n]; } }
    }
};
__device__ __forceinline__ void phase4a(Frame& F, const Params& P) {
    pg8::DenseOrder S; S.init(F.ws + WS_MERGED, F.ws + WS_WO, T_, D_, D_, F.G, (int)blockIdx.x);
    EpiResid E{P.x, (float*)(F.ws + WS_H)};
    pg8::gemm_phase<EpiResid, pg8::DenseOrder, false, false>(F.lds + RING_OFF, D_, S, E);
}
__device__ __forceinline__ void phase4b(Frame& F, const Params& P) {
    const float* H = (const float*)(F.ws + WS_H); bf16* XN = (bf16*)(F.ws + WS_XN); float* aff = (float*)(F.ws + WS_AFF);
    const int gw0 = F.vcu * NWAVES + F.wave, NGW = F.G * NWAVES, lane = F.lane;
    for (int row = gw0; row < T_; row += NGW) {
        const f32x4* xr = (const f32x4*)(H + (long)row * D_) + lane;
        f32x4 v[4]; float s = 0.f;
#pragma unroll
        for (int j = 0; j < 4; ++j) { v[j] = xr[64 * j]; s += v[j].x * v[j].x + v[j].y * v[j].y + v[j].z * v[j].z + v[j].w * v[j].w; }
        const float r = 1.0f / sqrtf(wave_sum(s) * (1.0f / D_) + EPS);
        float lg[16];
#pragma unroll
        for (int e = 0; e < 16; ++e) lg[e] = 0.f;
#pragma unroll
        for (int j = 0; j < 4; ++j) { const f32x4 y = v[j] * r * ((const f32x4*)P.norm_ffn)[lane + 64 * j]; stbf4(XN + (long)row * D_ + 4 * (lane + 64 * j), y);
            const f32x4* wr = (const f32x4*)(P.w_router + (size_t)(4 * (lane + 64 * j)) * 16);
#pragma unroll
            for (int q = 0; q < 4; ++q) { const f32x4 w0 = wr[q], w1 = wr[4 + q], w2 = wr[8 + q], w3 = wr[12 + q];
#pragma unroll
                for (int c = 0; c < 4; ++c) lg[4 * q + c] += y.x * w0[c] + y.y * w1[c] + y.z * w2[c] + y.w * w3[c]; } }
        float m = -INFINITY;
#pragma unroll
        for (int e = 0; e < 16; ++e) { lg[e] = wave_sum(lg[e]); m = fmaxf(m, lg[e]); }
        float sum = 0.f;
#pragma unroll
        for (int e = 0; e < 16; ++e) { lg[e] = expf(lg[e] - m); sum += lg[e]; }
        float val = 0.f;
#pragma unroll
        for (int e = 0; e < 16; ++e) if (lane == e) val = lg[e];
        if (lane < 16) aff[row * 16 + lane] = val / sum;
    }
}
__device__ __forceinline__ void topk_item(Frame& F, int b, int e) {
    LAS unsigned* cnts = (LAS unsigned*)(F.lds + RING_OFF);
    const float* aff = (const float*)(F.ws + WS_AFF); int* gidx = (int*)(F.ws + WS_GIDX); int* inv = (int*)(F.ws + WS_INV);
    const int tid = F.tid, lane = F.lane, wave = F.wave;
    unsigned v[8];
#pragma unroll
    for (int j = 0; j < 8; ++j) v[j] = __builtin_bit_cast(unsigned, aff[(size_t)(b * S_ + tid * 8 + j) * 16 + e]);
    unsigned Tv = 0u;
    __syncthreads();
    for (int bit = 30; bit >= 0; --bit) {
        const unsigned cand = Tv | (1u << bit);
        unsigned c = 0;
#pragma unroll
        for (int j = 0; j < 8; ++j) c += (v[j] >= cand) ? 1u : 0u;
#pragma unroll
        for (int o = 1; o < 64; o <<= 1) c += __shfl_xor(c, o);
        LAS unsigned* slot = cnts + (bit & 1) * 8;
        if (lane == 0) slot[wave] = c;
        __syncthreads();
        unsigned tot = 0;
#pragma unroll
        for (int w = 0; w < 8; ++w) tot += slot[w];
        if (tot >= (unsigned)CAP) Tv = cand;
    }
    unsigned ngt = 0, neq = 0;
#pragma unroll
    for (int j = 0; j < 8; ++j) { ngt += (v[j] > Tv) ? 1u : 0u; neq += (v[j] == Tv) ? 1u : 0u; }
    unsigned pk = ngt | (neq << 16), incl = pk;
#pragma unroll
    for (int o = 1; o < 64; o <<= 1) { const unsigned t = __shfl_up(incl, o); if (lane >= o) incl += t; }
    __syncthreads();
    LAS unsigned* wtot = cnts + 16;
    if (lane == 63) wtot[wave] = incl;
    __syncthreads();
    unsigned base = 0, total = 0;
#pragma unroll
    for (int w = 0; w < 8; ++w) { const unsigned t = wtot[w]; if (w < wave) base += t; total += t; }
    const unsigned excl = base + incl - pk;
    const unsigned tot_gt = total & 0xffffu, need_eq = (unsigned)CAP - tot_gt;
    unsigned g_before = excl & 0xffffu, e_before = excl >> 16;
#pragma unroll
    for (int j = 0; j < 8; ++j) {
        const bool gt = v[j] > Tv, eq = v[j] == Tv;
        const bool sel = gt || (eq && e_before < need_eq);
        const unsigned slotc = g_before + (e_before < need_eq ? e_before : need_eq);
        const int tok = b * S_ + tid * 8 + j;
        if (sel) gidx[e * ME + b * CAP + (int)slotc] = tok;
        inv[tok * 16 + e] = sel ? (int)(b * CAP + slotc) : -1;
        g_before += gt ? 1u : 0u; e_before += eq ? 1u : 0u;
    }
    __syncthreads();
}
__device__ __forceinline__ void phase5(Frame& F, const Params& P) {
    if (blockIdx.x < 64) topk_item(F, (int)blockIdx.x >> 4, (int)blockIdx.x & 15);
    LAS float* scr = (LAS float*)(F.lds + RING_OFF + 1024 + F.wave * 16384);
    const int gw = F.vcu * NWAVES + F.wave, NGW = F.G * NWAVES;
    for (int it = gw; it < 3 * 16 * 512; it += NGW) {
        const int mat = it >> 9, r = it & 511, which = mat >> 4, e = mat & 15;
        const float* W = (which == 0 ? P.w_eg : which == 1 ? P.w_eu : P.w_ed) + (size_t)e * D_ * FF;
        bf16* WT = (bf16*)(F.ws + (which == 0 ? WS_WEG : which == 1 ? WS_WEU : WS_WED)) + (size_t)e * D_ * FF;
        p0_matrix(F, W, 1024, 1024, WT, scr, r);
    }
}
struct ExpertOrder1 {
    const char* XN; const char* WG; const char* WU; const int* gidx; int G, c;
    __device__ bool next(int i, pg8::Unit& u) const {
        const int L = i * G + c; if (L >= 1024) return false;
        const int e = L >> 6, r = L & 63; u.e = e; u.pm = r & 7; u.pn = r >> 3; u.pad = 0;
        u.a = XN; u.gi = gidx + e * ME + u.pm * 256;
        const size_t bo = ((size_t)e * FF + (size_t)u.pn * 128) * D_ * 2; u.b0 = WG + bo; u.b1 = WU + bo; return true;
    }
};
struct EpiSwiglu {
    static constexpr bool PERM = true;
    bf16* HID;
    __device__ __forceinline__ void operator()(const f32x4 (&acc)[2][2][4][2], const pg8::Unit& u, int wr, int wc, int fr, int fq) const {
        const int row0 = u.e * ME + u.pm * 256 + wr * 64 + fr, col0 = u.pn * 128 + wc * 32 + 8 * fq;
#pragma unroll
        for (int ai = 0; ai < 2; ++ai)
#pragma unroll
            for (int m = 0; m < 4; ++m) { const f32x4 g0 = acc[ai][0][m][0], g1 = acc[ai][0][m][1];
                const f32x4 v0 = g0 * sig4(g0) * acc[ai][1][m][0], v1 = g1 * sig4(g1) * acc[ai][1][m][1];
                u32x4 w; w.x = pg8::cvt_pk_bf16(v0[0], v0[1]); w.y = pg8::cvt_pk_bf16(v0[2], v0[3]); w.z = pg8::cvt_pk_bf16(v1[0], v1[1]); w.w = pg8::cvt_pk_bf16(v1[2], v1[3]);
                *(u32x4*)(HID + (size_t)(row0 + ai * 128 + m * 16) * FF + col0) = w; }
    }
};
__device__ __forceinline__ void phase6(Frame& F, const Params& P) {
    ExpertOrder1 S{F.ws + WS_XN, F.ws + WS_WEG, F.ws + WS_WEU, (const int*)(F.ws + WS_GIDX), F.G, F.vcu};
    EpiSwiglu E{(bf16*)(F.ws + WS_HID)};
    pg8::gemm_phase<EpiSwiglu, ExpertOrder1, true, true>(F.lds + RING_OFF, D_, S, E);
}
struct ExpertOrder2 {
    const char* HID; const char* WD; int G, c;
    __device__ bool next(int i, pg8::Unit& u) const {
        const int L = i * G + c; if (L >= 512) return false;
        const int e = L >> 5, r = L & 31; u.e = e; u.pm = r & 7; u.pn = r >> 3; u.pad = 0; u.gi = nullptr;
        u.a = HID + ((size_t)e * ME + (size_t)u.pm * 256) * FF * 2;
        u.b0 = WD + ((size_t)e * D_ + (size_t)u.pn * 256) * FF * 2; u.b1 = u.b0 + (size_t)128 * FF * 2; return true;
    }
};
struct EpiRowScale {
    static constexpr bool PERM = true;
    const float* aff; const int* gidx; bf16* Y;
    __device__ __forceinline__ void operator()(const f32x4 (&acc)[2][2][4][2], const pg8::Unit& u, int wr, int wc, int fr, int fq) const {
        const int row0 = u.e * ME + u.pm * 256 + wr * 64 + fr, col0 = u.pn * 256 + wc * 32 + 8 * fq;
#pragma unroll
        for (int ai = 0; ai < 2; ++ai)
#pragma unroll
            for (int m = 0; m < 4; ++m) { const int r = row0 + ai * 128 + m * 16; const float a = aff[gidx[r] * NE + u.e];
#pragma unroll
                for (int bj = 0; bj < 2; ++bj) { const f32x4 v0 = acc[ai][bj][m][0] * a, v1 = acc[ai][bj][m][1] * a;
                    u32x4 w; w.x = pg8::cvt_pk_bf16(v0[0], v0[1]); w.y = pg8::cvt_pk_bf16(v0[2], v0[3]); w.z = pg8::cvt_pk_bf16(v1[0], v1[1]); w.w = pg8::cvt_pk_bf16(v1[2], v1[3]);
                    *(u32x4*)(Y + (size_t)r * D_ + col0 + bj * 128) = w; } }
    }
};
__device__ __forceinline__ void phase7(Frame& F, const Params& P) {
    ExpertOrder2 S{F.ws + WS_HID, F.ws + WS_WED, F.G, F.vcu};
    EpiRowScale E{(const float*)(F.ws + WS_AFF), (const int*)(F.ws + WS_GIDX), (bf16*)P.out};
    pg8::gemm_phase<EpiRowScale, ExpertOrder2, false, true>(F.lds + RING_OFF, FF, S, E);
}
constexpr size_t WS_PB = WS_GGLA;
__device__ __forceinline__ void phase8(Frame& F, const Params& P) {
    float* H = (float*)(F.ws + WS_H); const bf16* Y = (const bf16*)P.out; const int* inv = (const int*)(F.ws + WS_INV); bf16* XN3 = (bf16*)(F.ws + WS_XN3); bf16* PB = (bf16*)(F.ws + WS_PB);
    const int gw0 = F.vcu * NWAVES + F.wave, NGW = F.G * NWAVES, lane = F.lane;
    for (int row = gw0; row < T_; row += NGW) {
        f32x4* xr = (f32x4*)(H + (long)row * D_) + lane;
        f32x4 v[4];
#pragma unroll
        for (int j = 0; j < 4; ++j) v[j] = xr[64 * j];
        const int myinv = lane < 16 ? inv[row * 16 + lane] : -1;
        for (int e = 0; e < 16; ++e) { const int sl = __shfl(myinv, e); if (sl >= 0) { const bf16* yp = Y + ((long)e * ME + sl) * D_;
#pragma unroll
                for (int j = 0; j < 4; ++j) v[j] += ldbf4(yp + 4 * (lane + 64 * j)); } }
        float s = 0.f;
#pragma unroll
        for (int j = 0; j < 4; ++j) { xr[64 * j] = v[j]; s += v[j].x * v[j].x + v[j].y * v[j].y + v[j].z * v[j].z + v[j].w * v[j].w; }
        const float r = 1.0f / sqrtf(wave_sum(s) * (1.0f / D_) + EPS);
#pragma unroll
        for (int j = 0; j < 4; ++j) stbf4(XN3 + (long)row * D_ + 4 * (lane + 64 * j), v[j] * r * ((const f32x4*)P.norm_ple)[lane + 64 * j]);
        stbf4(PB + (long)row * PLE + 4 * lane, *((const f32x4*)(P.p + (long)row * PLE) + lane));
    }
}
struct EpiStoreF32 {
    static constexpr bool PERM = false;
    float* C;
    __device__ __forceinline__ void operator()(const f32x4 (&acc)[2][2][4][2], const pg8::Unit& u, int wr, int wc, int fr, int fq) const {
        const int row0 = u.pm * 256 + wr * 64 + fr, col0 = u.pn * 256 + wc * 32 + 4 * fq;
#pragma unroll
        for (int ai = 0; ai < 2; ++ai)
#pragma unroll
            for (int m = 0; m < 4; ++m) { const size_t ro = (size_t)(row0 + ai * 128 + m * 16) * D_ + col0;
#pragma unroll
                for (int bj = 0; bj < 2; ++bj)
#pragma unroll
                    for (int n = 0; n < 2; ++n) *(f32x4*)(C + ro + bj * 128 + n * 16) = acc[ai][bj][m][n]; }
    }
};
struct EpiPle {
    static constexpr bool PERM = false;
    const float* Pt; float* H;
    __device__ __forceinline__ void operator()(const f32x4 (&acc)[2][2][4][2], const pg8::Unit& u, int wr, int wc, int fr, int fq) const {
        const int row0 = u.pm * 256 + wr * 64 + fr, col0 = u.pn * 256 + wc * 32 + 4 * fq;
#pragma unroll
        for (int ai = 0; ai < 2; ++ai)
#pragma unroll
            for (int m = 0; m < 4; ++m) { const size_t ro = (size_t)(row0 + ai * 128 + m * 16) * D_ + col0;
#pragma unroll
                for (int bj = 0; bj < 2; ++bj)
#pragma unroll
                    for (int n = 0; n < 2; ++n) { const size_t o = ro + bj * 128 + n * 16; *(f32x4*)(H + o) = *(const f32x4*)(H + o) + sig4(acc[ai][bj][m][n]) * *(const f32x4*)(Pt + o); } }
    }
};
__device__ __forceinline__ void phase9a(Frame& F, const Params& P) {
    pg8::DenseOrder S; S.init(F.ws + WS_PB, F.ws + WS_WPLE, T_, D_, PLE, F.G, (int)blockIdx.x);
    EpiStoreF32 E{(float*)(F.ws + WS_PLET)};
    pg8::gemm_phase<EpiStoreF32, pg8::DenseOrder, false, false>(F.lds + RING_OFF, PLE, S, E);
}
__device__ __forceinline__ void phase9b(Frame& F, const Params& P) {
    pg8::DenseOrder S; S.init(F.ws + WS_XN3, F.ws + WS_WPG, T_, D_, D_, F.G, (int)blockIdx.x);
    EpiPle E{(const float*)(F.ws + WS_PLET), (float*)(F.ws + WS_H)};
    pg8::gemm_phase<EpiPle, pg8::DenseOrder, false, false>(F.lds + RING_OFF, D_, S, E);
}
__device__ __forceinline__ void phase10(Frame& F, const Params& P) {
    const float* H = (const float*)(F.ws + WS_H);
    const int gw0 = F.vcu * NWAVES + F.wave, NGW = F.G * NWAVES, lane = F.lane;
    for (int row = gw0; row < T_; row += NGW) {
        const f32x4* xr = (const f32x4*)(H + (long)row * D_) + lane;
        f32x4 v[4]; float s = 0.f;
#pragma unroll
        for (int j = 0; j < 4; ++j) { v[j] = xr[64 * j]; s += v[j].x * v[j].x + v[j].y * v[j].y + v[j].z * v[j].z + v[j].w * v[j].w; }
        const float r = 1.0f / sqrtf(wave_sum(s) * (1.0f / D_) + EPS);
#pragma unroll
        for (int j = 0; j < 4; ++j) *((f32x4*)(P.out + (long)row * D_) + lane + 64 * j) = v[j] * r * ((const f32x4*)P.norm_final)[lane + 64 * j];
    }
}

}
namespace mk {
typedef float f32x16 __attribute__((ext_vector_type(16)));
typedef short s16x8 __attribute__((ext_vector_type(8)));
typedef short s16x4 __attribute__((ext_vector_type(4)));
__device__ __forceinline__ int crow(int r, int hi) { return (r & 3) + 8 * (r >> 2) + 4 * hi; }
__device__ __forceinline__ s16x4 tr16(LAS const void* p) { return __builtin_bit_cast(s16x4, __builtin_amdgcn_ds_read_tr16_b64_v4i16((LAS s16x4*)p)); }
__device__ __forceinline__ unsigned cvtpk(float lo, float hi) { f32x2 v = {lo, hi}; typedef __bf16 bf2 __attribute__((ext_vector_type(2))); bf2 b = __builtin_convertvector(v, bf2); return __builtin_bit_cast(unsigned, b); }

constexpr int ATT_K = 0, ATT_V = 49152;

__device__ __forceinline__ void attn_unit(Frame& F, const Params& P, int b, int kvh, int nb) {
    const bf16* QKV = (const bf16*)(F.ws + WS_QKV); bf16* ATT = (bf16*)(F.ws + WS_ATT);
    LAS unsigned char* lds = F.lds + RING_OFF;
    const int tid = F.tid, lane = F.lane, wave = F.wave;
#pragma unroll
    for (int i = 0; i < 6; ++i) {
        const int idx = tid + NT * i, row = idx >> 3, ch = idx & 7;
        const int pos = (nb - 1) * 128 + row;
        u32x4 kv = (u32x4){0u, 0u, 0u, 0u}, vv = (u32x4){0u, 0u, 0u, 0u};
        if (pos >= 0 && pos < S_) { const bf16* src = QKV + (size_t)(b * S_ + pos) * 768 + 512 + kvh * 64 + ch * 8; kv = *(const u32x4*)src; vv = *(const u32x4*)(src + 128); }
        *(LAS u32x4*)(lds + ATT_K + row * 128 + ((ch ^ (row & 7)) * 16)) = kv;
        *(LAS u32x4*)(lds + ATT_V + row * 128 + ch * 16) = vv;
    }
    __syncthreads();
    const int g = wave >> 1, qh = wave & 1, hq = kvh * 4 + g;
    const int ql = lane & 31, hi = lane >> 5;
    const float sink2 = P.sink[hq] * LOG2E;
    const bool edge = (nb == 0) || (nb == S_ / 128 - 1);
    for (int sb = 0; sb < 2; ++sb) {
        const int q0 = qh * 64 + sb * 32;
        const size_t tok = (size_t)b * S_ + nb * 128 + q0 + ql;
        s16x8 qr[4];
#pragma unroll
        for (int d0 = 0; d0 < 4; ++d0) qr[d0] = *(const s16x8*)(QKV + tok * 768 + hq * 64 + d0 * 16 + hi * 8);
        float m = sink2, l = 0.f;
        f32x16 o0 = {}, o1 = {};
        for (int kt = 0; kt < 9; ++kt) {
            const int kr0 = q0 + 32 * kt;
            f32x16 p = {};
            { const int krow = kr0 + ql; LAS const unsigned char* kb = lds + ATT_K + krow * 128; const int sw = krow & 7;
#pragma unroll
                for (int d0 = 0; d0 < 4; ++d0) { const s16x8 kf = *(LAS const s16x8*)(kb + (((2 * d0 + hi) ^ sw) * 16)); p = __builtin_amdgcn_mfma_f32_32x32x16_bf16(kf, qr[d0], p, 0, 0, 0); } }
            if (kt == 0 || kt == 8 || edge) {
#pragma unroll
                for (int r = 0; r < 16; ++r) { const int krow = kr0 + crow(r, hi); const int rel = krow - (q0 + ql); const int pos = (nb - 1) * 128 + krow;
                    if (rel < 0 || rel > 256 || pos < 0 || pos >= S_) p[r] = -INFINITY; }
            }
            float tm = p[0];
#pragma unroll
            for (int r = 1; r < 16; ++r) tm = fmaxf(tm, p[r]);
            tm = fmaxf(tm, __shfl_xor(tm, 32));
            const float mn = fmaxf(m, tm), alpha = exp2f(m - mn);
            float ps = 0.f;
#pragma unroll
            for (int r = 0; r < 16; ++r) { p[r] = exp2f(p[r] - mn); ps += p[r]; }
            l = l * alpha + ps; m = mn;
#pragma unroll
            for (int r = 0; r < 16; ++r) { o0[r] *= alpha; o1[r] *= alpha; }
            LAS const unsigned char* vb = lds + ATT_V + (kr0 + 4 * hi + ((lane & 15) >> 2)) * 128 + (16 * ((lane >> 4) & 1) + 4 * (lane & 3)) * 2;
#pragma unroll
            for (int s = 0; s < 2; ++s) {
                u32x4 pw; pw.x = cvtpk(p[8 * s + 0], p[8 * s + 1]); pw.y = cvtpk(p[8 * s + 2], p[8 * s + 3]); pw.z = cvtpk(p[8 * s + 4], p[8 * s + 5]); pw.w = cvtpk(p[8 * s + 6], p[8 * s + 7]);
                const s16x8 pf = __builtin_bit_cast(s16x8, pw);
#pragma unroll
                for (int dd = 0; dd < 2; ++dd) {
                    const s16x4 lo = tr16(vb + (16 * s) * 128 + dd * 64), hi4 = tr16(vb + (16 * s + 8) * 128 + dd * 64);
                    const s16x8 vf = (s16x8){lo[0], lo[1], lo[2], lo[3], hi4[0], hi4[1], hi4[2], hi4[3]};
                    if (dd == 0) o0 = __builtin_amdgcn_mfma_f32_32x32x16_bf16(vf, pf, o0, 0, 0, 0); else o1 = __builtin_amdgcn_mfma_f32_32x32x16_bf16(vf, pf, o1, 0, 0, 0);
                }
            }
        }
        l += __shfl_xor(l, 32);
        l += exp2f(sink2 - m);
        const float rl = 1.0f / l;
        bf16* op = ATT + tok * 512 + hq * 64;
#pragma unroll
        for (int dd = 0; dd < 2; ++dd)
#pragma unroll
            for (int rg = 0; rg < 4; ++rg) { const f32x16& o = dd ? o1 : o0; const int d = 32 * dd + 8 * rg + 4 * hi;
                *(u32x2*)(op + d) = (u32x2){cvtpk(o[4 * rg + 0] * rl, o[4 * rg + 1] * rl), cvtpk(o[4 * rg + 2] * rl, o[4 * rg + 3] * rl)}; }
    }
    __syncthreads();
}
__device__ __forceinline__ void phase2_attn(Frame& F, const Params& P, int first, int nwg) {
    for (int L = (int)blockIdx.x - first; L < 256; L += nwg) { if (L < 0) break; attn_unit(F, P, L >> 6, (L >> 5) & 1, L & 31); }
}
}
namespace mk {
constexpr int GL_QT = 0, GL_QS = 272;
constexpr int GL_KT = 17408;
constexpr int GL_KE = 34816, GL_KES = 320;
constexpr int GL_VV = 55296, GL_VS = 576;
constexpr int GL_AT = 92160, GL_AS = 144;
constexpr int GL_ZZ = 101376;
constexpr int GL_SEG = 105472;
constexpr int GL_DEC = 107520;
constexpr int GL_END = 108032;
constexpr int GLA_STATE_FLOATS = 128 * 256;

__device__ __forceinline__ float logsig(float x) { return fminf(x, 0.f) - log1pf(expf(-fabsf(x))); }

__device__ __forceinline__ void gla_unit(Frame& F, const Params& P, int b, int h, int dir, int c0, int nc, const float* Sin, float* Sout, float* Gout, bool write_o) {
    const bf16* GQK = (const bf16*)(F.ws + WS_GQK); const bf16* GV = (const bf16*)(F.ws + WS_GV); const float* Z = (const float*)(F.ws + WS_Z);
    bf16* OUT = (bf16*)(F.ws + (dir ? WS_OB : WS_OF));
    const float* up = dir ? P.up_b : P.up_f; const float* bias = dir ? P.bias_b : P.bias_f;
    LAS unsigned char* lds = F.lds + RING_OFF;
    const int tid = F.tid, lane = F.lane, w = F.wave, lr = lane & 31, hi = lane >> 5;
    const int d = tid & 127, ls = tid >> 7;
    float upr[16];
#pragma unroll
    for (int r = 0; r < 16; ++r) upr[r] = up[r * 512 + h * 128 + d];
    const float bias_d = bias[h * 128 + d];
    float gacc = 0.f;
    f32x16 S[4];
#pragma unroll
    for (int k = 0; k < 4; ++k) {
        if (Sin) {
#pragma unroll
            for (int r = 0; r < 16; ++r) S[k][r] = Sin[((w * 4 + k) * 16 + r) * 64 + lane];
        } else S[k] = (f32x16){};
    }
    const int trq = (lane & 15) >> 2, trp = lane & 3, trg = (lane >> 4) & 1;
    for (int ci = 0; ci < nc; ++ci) {
        const int c = c0 + ci;
        if (tid < 256) { const int l = tid >> 2, r4 = tid & 3; const int il = 64 * c + l, t = dir ? (S_ - 1 - il) : il;
            *(LAS f32x4*)(lds + GL_ZZ + l * 64 + r4 * 16) = *(const f32x4*)(Z + (size_t)(b * S_ + t) * 32 + dir * 16 + 4 * r4); }
#pragma unroll
        for (int i = 0; i < 4; ++i) { const int idx = tid + NT * i, l = idx >> 5, ch = idx & 31; const int il = 64 * c + l, t = dir ? (S_ - 1 - il) : il;
            *(LAS u32x4*)(lds + GL_VV + l * GL_VS + ch * 16) = *(const u32x4*)(GV + (size_t)(b * S_ + t) * 1024 + h * 256 + ch * 8); }
        float qv[16], kv[16];
#pragma unroll
        for (int li = 0; li < 16; ++li) { const int il = 64 * c + 16 * ls + li, t = dir ? (S_ - 1 - il) : il; const bf16* row = GQK + (size_t)(b * S_ + t) * 1024 + h * 128 + d;
            qv[li] = bf2f(row[0]); kv[li] = bf2f(row[512]); }
        __syncthreads();
        float bl[16];
        { float run = 0.f;
#pragma unroll
            for (int li = 0; li < 16; ++li) { const LAS f32x4* zr = (const LAS f32x4*)(lds + GL_ZZ + (16 * ls + li) * 64);
                float x = bias_d;
#pragma unroll
                for (int q = 0; q < 4; ++q) { const f32x4 zz = zr[q]; x += zz.x * upr[4 * q] + zz.y * upr[4 * q + 1] + zz.z * upr[4 * q + 2] + zz.w * upr[4 * q + 3]; }
                run += logsig(x) * (1.0f / 16.0f); bl[li] = run; } }
        ((LAS float*)(lds + GL_SEG))[ls * 128 + d] = bl[15];
        __syncthreads();
        float off = 0.f, gtot = 0.f;
#pragma unroll
        for (int q = 0; q < 4; ++q) { const float sgv = ((LAS const float*)(lds + GL_SEG))[q * 128 + d]; gtot += sgv; if (q < ls) off += sgv; }
        gacc += gtot;
        if (ls == 0) ((LAS float*)(lds + GL_DEC))[d] = expf(gtot);
#pragma unroll
        for (int li = 0; li < 16; ++li) { const int l = 16 * ls + li; const float bb = off + bl[li]; const float eb = expf(bb), ieb = expf(-bb), ee = expf(gtot - bb);
            *(LAS bf16*)(lds + GL_QT + l * GL_QS + d * 2) = (bf16)f2bf(qv[li] * eb);
            *(LAS bf16*)(lds + GL_KT + l * GL_QS + d * 2) = (bf16)f2bf(kv[li] * ieb);
            *(LAS bf16*)(lds + GL_KE + l * GL_KES + d * 2) = (bf16)f2bf(kv[li] * ee); }
        __syncthreads();
        if (write_o && w < 3) {
            const int li_ = (w + 1) >> 1, mi = w >> 1;
            f32x16 a = {};
#pragma unroll
            for (int s = 0; s < 8; ++s) { const s16x8 kf = *(LAS const s16x8*)(lds + GL_KT + (32 * mi + lr) * GL_QS + (16 * s + 8 * hi) * 2);
                const s16x8 qf = *(LAS const s16x8*)(lds + GL_QT + (32 * li_ + lr) * GL_QS + (16 * s + 8 * hi) * 2);
                a = __builtin_amdgcn_mfma_f32_32x32x16_bf16(kf, qf, a, 0, 0, 0); }
            const int l = 32 * li_ + lr;
#pragma unroll
            for (int rg = 0; rg < 4; ++rg) { const int m0 = 32 * mi + 8 * rg + 4 * hi; float v4[4];
#pragma unroll
                for (int j = 0; j < 4; ++j) { const int m = m0 + j; const bool keep = dir ? (m < l) : (m <= l); v4[j] = keep ? a[4 * rg + j] : 0.f; }
                *(LAS u32x2*)(lds + GL_AT + l * GL_AS + m0 * 2) = (u32x2){cvtpk(v4[0], v4[1]), cvtpk(v4[2], v4[3])}; }
        }
        __syncthreads();
        s16x8 vf[4];
        { LAS const unsigned char* vb = lds + GL_VV + (8 * hi + trq) * GL_VS + (32 * w + 16 * trg + 4 * trp) * 2;
#pragma unroll
            for (int s = 0; s < 4; ++s) { const s16x4 lo = tr16(vb + (16 * s) * GL_VS), hh = tr16(vb + (16 * s + 4) * GL_VS);
                vf[s] = (s16x8){lo[0], lo[1], lo[2], lo[3], hh[0], hh[1], hh[2], hh[3]}; } }
        if (write_o) {
            s16x8 sp[4][2];
#pragma unroll
            for (int k = 0; k < 4; ++k)
#pragma unroll
                for (int s2 = 0; s2 < 2; ++s2) { u32x4 pw; pw.x = cvtpk(S[k][8 * s2 + 0], S[k][8 * s2 + 1]); pw.y = cvtpk(S[k][8 * s2 + 2], S[k][8 * s2 + 3]); pw.z = cvtpk(S[k][8 * s2 + 4], S[k][8 * s2 + 5]); pw.w = cvtpk(S[k][8 * s2 + 6], S[k][8 * s2 + 7]);
                    sp[k][s2] = __builtin_bit_cast(s16x8, pw); }
#pragma unroll
            for (int lb = 0; lb < 2; ++lb) {
                f32x16 O = {};
                LAS const unsigned char* qrow = lds + GL_QT + (32 * lb + lr) * GL_QS;
#pragma unroll
                for (int k = 0; k < 4; ++k)
#pragma unroll
                    for (int s2 = 0; s2 < 2; ++s2) { const int dc = 32 * k + 16 * s2 + 4 * hi;
                        const s16x4 a0 = *(LAS const s16x4*)(qrow + dc * 2), a1 = *(LAS const s16x4*)(qrow + (dc + 8) * 2);
                        const s16x8 af = (s16x8){a0[0], a0[1], a0[2], a0[3], a1[0], a1[1], a1[2], a1[3]};
                        O = __builtin_amdgcn_mfma_f32_32x32x16_bf16(af, sp[k][s2], O, 0, 0, 0); }
                LAS const unsigned char* arow = lds + GL_AT + (32 * lb + lr) * GL_AS;
#pragma unroll
                for (int s = 0; s < 4; ++s) { if (lb == 0 && s >= 2) continue;
                    const s16x8 af = *(LAS const s16x8*)(arow + (16 * s + 8 * hi) * 2);
                    O = __builtin_amdgcn_mfma_f32_32x32x16_bf16(af, vf[s], O, 0, 0, 0); }
#pragma unroll
                for (int r = 0; r < 16; ++r) { const int l = 32 * lb + crow(r, hi); const int il = 64 * c + l, t = dir ? (S_ - 1 - il) : il;
                    OUT[(size_t)(b * S_ + t) * 1024 + h * 256 + 32 * w + lr] = (bf16)f2bf(O[r]); }
            }
        }
#pragma unroll
        for (int k = 0; k < 4; ++k) {
#pragma unroll
            for (int rg = 0; rg < 4; ++rg) { const f32x4 dc = *(LAS const f32x4*)(lds + GL_DEC + (32 * k + 8 * rg + 4 * hi) * 4);
                S[k][4 * rg + 0] *= dc.x; S[k][4 * rg + 1] *= dc.y; S[k][4 * rg + 2] *= dc.z; S[k][4 * rg + 3] *= dc.w; }
            LAS const unsigned char* kb = lds + GL_KE + (8 * hi + trq) * GL_KES + (32 * k + 16 * trg + 4 * trp) * 2;
#pragma unroll
            for (int s = 0; s < 4; ++s) { const s16x4 lo = tr16(kb + (16 * s) * GL_KES), hh = tr16(kb + (16 * s + 4) * GL_KES);
                const s16x8 kf = (s16x8){lo[0], lo[1], lo[2], lo[3], hh[0], hh[1], hh[2], hh[3]};
                S[k] = __builtin_amdgcn_mfma_f32_32x32x16_bf16(kf, vf[s], S[k], 0, 0, 0); }
        }
        __syncthreads();
    }
    if (Sout) {
#pragma unroll
        for (int k = 0; k < 4; ++k)
#pragma unroll
            for (int r = 0; r < 16; ++r) Sout[((w * 4 + k) * 16 + r) * 64 + lane] = S[k][r];
    }
    if (Gout && ls == 0) Gout[d] = gacc;
}
__device__ __forceinline__ void phase2_gla_simple(Frame& F, const Params& P) {
    const int u = (int)blockIdx.x; if (u >= 32) return;
    gla_unit(F, P, u >> 3, (u >> 1) & 3, u & 1, 0, 64, nullptr, nullptr, nullptr, true);
}
}
namespace mk {
constexpr int CW_BAR = 4096;
__global__ void __launch_bounds__(NT, 2) mega_fwd(Params P) {
    extern __shared__ __attribute__((aligned(16))) unsigned char lds[];
    Frame F; F.lds = (LAS unsigned char*)lds; F.ws = P.ws;
    F.tid = threadIdx.x; F.lane = F.tid & 63; F.wave = __builtin_amdgcn_readfirstlane(F.tid >> 6);
    F.G = gridDim.x; { const int bx = blockIdx.x; F.vcu = (F.G % 8 == 0) ? (bx % 8) * (F.G / 8) + bx / 8 : bx; }
    volatile LAS unsigned* MISC = (volatile LAS unsigned*)(F.lds + MISC_OFF);
    for (int u = F.tid; u < (LDS_BYTES - LDSCTL_OFF) / 4; u += NT) ((LAS unsigned*)(F.lds + LDSCTL_OFF))[u] = 0u;
    __syncthreads();
    XcdBarrier bar = xcd_barrier_post((unsigned*)(P.ws + WS_CTL) + CW_BAR, MISC + 8);
#define GRID_BAR() do { xcd_barrier(bar); asm volatile("" : "+v"(F.tid), "+v"(F.lane)); } while (0)
    phase0(F, P);                 GRID_BAR();
    phase1(F, P);                 GRID_BAR();
    if (blockIdx.x < 32) phase2_gla_simple(F, P); else phase2_attn(F, P, 32, (int)gridDim.x - 32);
    GRID_BAR();
    phase3_pre(F, P); phase3a(F, P); GRID_BAR();
    phase3b(F, P);                GRID_BAR();
    phase4a(F, P);                GRID_BAR();
    phase4b(F, P);                GRID_BAR();
    phase5(F, P);                 GRID_BAR();
    phase6(F, P);                 GRID_BAR();
    phase7(F, P);                 GRID_BAR();
    phase8(F, P);                 GRID_BAR();
    phase9a(F, P); phase9b(F, P); GRID_BAR();
    phase10(F, P);
#undef GRID_BAR
}
}
extern "C" void kernel_launch(void* const* d_in, const int* in_sizes, int n_in, void* d_out, int out_size, void* d_ws, size_t ws_size, hipStream_t stream) {
    static int ready = 0;
    if (!ready) {
        if (n_in != 23 || ws_size < WS_END) { fprintf(stderr, "kernel_launch: unexpected inputs (n_in %d, ws %zu < %zu)\n", n_in, ws_size, (size_t)WS_END); ready = -1; return; }
        if (hipFuncSetAttribute((const void*)mk::mega_fwd, hipFuncAttributeMaxDynamicSharedMemorySize, mk::LDS_BYTES) != hipSuccess) { fprintf(stderr, "kernel_launch: hipFuncSetAttribute failed\n"); ready = -1; return; }
        ready = 1;
    }
    if (ready < 0) return;
    Params P{};
    P.x = (const float*)d_in[0]; P.p = (const float*)d_in[1]; P.pos = (const int*)d_in[2]; P.norm_mix = (const float*)d_in[3]; P.w_in = (const float*)d_in[4];
    P.up_f = (const float*)d_in[5]; P.bias_f = (const float*)d_in[6]; P.up_b = (const float*)d_in[7]; P.bias_b = (const float*)d_in[8]; P.sink = (const float*)d_in[9];
    P.gla_norm = (const float*)d_in[10]; P.w_ba = (const float*)d_in[11]; P.w_bg = (const float*)d_in[12]; P.w_out = (const float*)d_in[13]; P.norm_ffn = (const float*)d_in[14];
    P.w_router = (const float*)d_in[15]; P.w_eg = (const float*)d_in[16]; P.w_eu = (const float*)d_in[17]; P.w_ed = (const float*)d_in[18]; P.norm_ple = (const float*)d_in[19];
    P.w_pg = (const float*)d_in[20]; P.w_ple = (const float*)d_in[21]; P.norm_final = (const float*)d_in[22];
    P.out = (float*)d_out; P.ws = (char*)d_ws;
    (void)hipMemsetAsync((char*)d_ws + WS_CTL, 0, 1 * MiB, stream);
    hipLaunchKernelGGL(mk::mega_fwd, dim3(256), dim3(mk::NT), mk::LDS_BYTES, stream, P);
}
```

```cpp
#include <hip/hip_runtime.h>
#include <cstdio>
#include <cstdint>

constexpr int B_ = 4, S_ = 4096, D_ = 1024, T_ = B_ * S_;
constexpr int IN_DIM = 5920;
constexpr int C_Q = 0, C_K = 512, C_V = 640, C_GQ = 768, C_GK = 1280, C_GV = 1792, C_GR = 2816, C_ZF = 3840, C_ZB = 3856, C_GATT = 3872, C_GGLA = 4896;
constexpr int NE = 16, CAP = 512, FF = 1024, PLE = 256, ME = B_ * CAP;
constexpr float EPS = 1e-6f;
constexpr float LOG2E = 1.4426950408889634f;
constexpr float QSCALE = 0.125f * LOG2E;
constexpr float GQSCALE = 0.08838834764831845f;

typedef float f32x4 __attribute__((ext_vector_type(4)));
typedef float f32x2 __attribute__((ext_vector_type(2)));
typedef unsigned short bf16;
typedef unsigned u32x4 __attribute__((ext_vector_type(4)));
typedef unsigned u32x2 __attribute__((ext_vector_type(2)));

constexpr size_t MiB = 1u << 20;
constexpr size_t WS_CTL = 0, WS_ROPE = 1 * MiB, WS_AFF = 2 * MiB, WS_INV = 3 * MiB, WS_GIDX = 4 * MiB, WS_Z = 5 * MiB;
constexpr size_t WS_WIN = 8 * MiB, WS_WA = 20 * MiB, WS_WB = 21 * MiB, WS_WO = 23 * MiB, WS_WPG = 25 * MiB, WS_WPLE = 27 * MiB;
constexpr size_t WS_A0 = 28 * MiB;
constexpr size_t WS_QKV = 60 * MiB;
constexpr size_t WS_GQK = 84 * MiB;
constexpr size_t WS_GV = 116 * MiB;
constexpr size_t WS_GR = 148 * MiB;
constexpr size_t WS_GATT = 180 * MiB;
constexpr size_t WS_GGLA = 212 * MiB;
constexpr size_t WS_OB = 244 * MiB;
constexpr size_t WS_ATT = 276 * MiB;
constexpr size_t WS_OF = WS_A0, WS_XN = WS_A0, WS_XN3 = WS_A0, WS_GLAO = WS_GQK, WS_MERGED = WS_GV, WS_H = WS_GR, WS_HID = WS_QKV, WS_PLET = WS_QKV;
constexpr size_t WS_WEG = 212 * MiB, WS_WEU = 244 * MiB, WS_WED = 276 * MiB, WS_END = 308 * MiB;

__device__ __forceinline__ unsigned f2bf(float f) { unsigned u = __builtin_bit_cast(unsigned, f); return (u + 0x7fffu + ((u >> 16) & 1u)) >> 16; }
__device__ __forceinline__ float bf2f(unsigned h) { return __builtin_bit_cast(float, h << 16); }
__device__ __forceinline__ unsigned pk2(float lo, float hi) { return f2bf(lo) | (f2bf(hi) << 16); }
__device__ __forceinline__ float sigmoidf_(float x) { return 1.0f / (1.0f + __expf(-x)); }
__device__ __forceinline__ float wave_sum(float v) {
#pragma unroll
    for (int o = 1; o < 64; o <<= 1) v += __shfl_xor(v, o);
    return v;
}

struct Params {
    const float *x, *p; const int* pos; const float *norm_mix, *w_in, *up_f, *bias_f, *up_b, *bias_b, *sink, *gla_norm, *w_ba, *w_bg, *w_out,
        *norm_ffn, *w_router, *w_eg, *w_eu, *w_ed, *norm_ple, *w_pg, *w_ple, *norm_final;
    float* out; char* ws;
};
namespace pg8 {
#define PG8_LAS __attribute__((address_space(3)))
typedef short bf16x8 __attribute__((ext_vector_type(8)));
constexpr int BM = 256, BK = 64, HALF = 128, HTB = HALF * BK * 2  , STAGE_BYTES = 8 * HTB;

__host__ __device__ __forceinline__ int lds_byte(int r, int c) { const int st = (r >> 4) * 2 + (c >> 5), rr = r & 15, cc = c & 31, ob = rr * 64 + cc * 2; return st * 1024 + (ob ^ (((ob >> 9) & 1) << 5)); }
__host__ __device__ __forceinline__ void stage_rc(int b, int& R, int& C) { const int st = b / 1024, sb = b % 1024, swz = sb ^ (((sb >> 9) & 1) << 5); R = (st >> 1) * 16 + swz / 64; C = (st & 1) * 32 + (swz % 64) / 2; }
__host__ __device__ __forceinline__ int perm32(int rho) { const int n = rho >> 4, i = rho & 15; return 8 * (i >> 2) + 4 * n + (i & 3); }

struct Unit { const char* a; const char* b0; const char* b1; const int* gi; int pm, pn, e, pad; };

__device__ __forceinline__ unsigned cvt_pk_bf16(float lo, float hi) { unsigned r; asm volatile("v_cvt_pk_bf16_f32 %0, %1, %2" : "=v"(r) : "v"(lo), "v"(hi)); return r; }

template <class Epi, class Sched, bool GATHER, bool ALIGN_EPI>
__device__ __forceinline__ void gemm_phase(PG8_LAS unsigned char* lds, const int K, const Sched& S, const Epi& E) {
    int tid_ = threadIdx.x; asm volatile("" : "+v"(tid_));
    const int tid = tid_, wid = __builtin_amdgcn_readfirstlane(tid >> 6), lane = tid & 63, wr = wid >> 2, wc = wid & 3, fr = lane & 15, fq = lane >> 4;
    const int nt = K / BK;
    int sR[2], sC[2];
    unsigned voffB[2], voffA[2][2];
#pragma unroll
    for (int i = 0; i < 2; ++i) { stage_rc(tid * 16 + i * 8192, sR[i], sC[i]); const int Rb = Epi::PERM ? ((sR[i] & ~31) + perm32(sR[i] & 31)) : sR[i];
        voffB[i] = (unsigned)(Rb * K + sC[i]) * 2u;
        voffA[0][i] = (unsigned)(sR[i] * K + sC[i]) * 2u; voffA[1][i] = (unsigned)((sR[i] + HALF) * K + sC[i]) * 2u; }
    const size_t kstep = (size_t)(BK * 2);
    const unsigned ldsw = (unsigned)wid * 1024u;
    const int aoff = lds_byte(wr * 64 + fr, fq * 8), boff = lds_byte(wc * 32 + fr, fq * 8);
#define PG8_SA(b, h) (((b) * 2 + (h)) * HTB)
#define PG8_SB(b, h) ((4 + (b) * 2 + (h)) * HTB)
#define PG8_STAGE(bufoff, gbase, voff) do { _Pragma("unroll") for (int _i = 0; _i < 2; ++_i) \
        __builtin_amdgcn_global_load_lds((const unsigned*)((const char*)(gbase) + (voff)[_i]), (PG8_LAS unsigned*)(lds + (bufoff) + ldsw + _i * 8192), 16, 0, 0); } while (0)
#define PG8_LDA(dst, b, h) do { _Pragma("unroll") for (int m = 0; m < 4; ++m) _Pragma("unroll") for (int k = 0; k < 2; ++k) dst[m][k] = *(const PG8_LAS bf16x8*)(lds + PG8_SA(b, h) + aoff + m * 2048 + k * 1024); } while (0)
#define PG8_LDB(dst, b, h) do { _Pragma("unroll") for (int n = 0; n < 2; ++n) _Pragma("unroll") for (int k = 0; k < 2; ++k) dst[n][k] = *(const PG8_LAS bf16x8*)(lds + PG8_SB(b, h) + boff + n * 2048 + k * 1024); } while (0)
#define PG8_MMA(ai, bj, At, Bt) do { __builtin_amdgcn_s_setprio(1); _Pragma("unroll") for (int m = 0; m < 4; ++m) _Pragma("unroll") for (int n = 0; n < 2; ++n) _Pragma("unroll") for (int k = 0; k < 2; ++k) \
        acc[ai][bj][m][n] = __builtin_amdgcn_mfma_f32_16x16x32_bf16(Bt[n][k], At[m][k], acc[ai][bj][m][n], 0, 0, 0); __builtin_amdgcn_s_setprio(0); } while (0)
#define PG8_WAIT_V(n) asm volatile("s_waitcnt vmcnt(" #n ")" ::: "memory")
#define PG8_WAIT_L(n) asm volatile("s_waitcnt lgkmcnt(" #n ")" ::: "memory")
#define PG8_BAR __builtin_amdgcn_s_barrier()
#define PG8_SCHED __builtin_amdgcn_sched_barrier(0)
    Unit cur, nxt; int ui = 0;
    if (!S.next(0, cur)) return;
    if constexpr (GATHER) {
#pragma unroll
        for (int h = 0; h < 2; ++h)
#pragma unroll
            for (int i = 0; i < 2; ++i) voffA[h][i] = (unsigned)(cur.gi[h * HALF + sR[i]] * K + sC[i]) * 2u;
    }
    f32x4 acc[2][2][4][2];
#pragma unroll
    for (int a = 0; a < 2; ++a)
#pragma unroll
        for (int b = 0; b < 2; ++b)
#pragma unroll
            for (int m = 0; m < 4; ++m)
#pragma unroll
                for (int n = 0; n < 2; ++n) acc[a][b][m][n] = (f32x4){0.f, 0.f, 0.f, 0.f};
    bf16x8 At[4][2], B0[2][2], B1[2][2];
    const char* cA = cur.a; const char* cB0 = cur.b0; const char* cB1 = cur.b1;
    PG8_STAGE(PG8_SB(0, 0), cB0, voffB); PG8_STAGE(PG8_SB(0, 1), cB1, voffB); PG8_STAGE(PG8_SA(0, 0), cA, voffA[0]); PG8_STAGE(PG8_SA(0, 1), cA, voffA[1]);
    if (wr == 1) PG8_BAR;
    PG8_WAIT_V(2); PG8_BAR;
    PG8_STAGE(PG8_SB(1, 0), cB0 + kstep, voffB); PG8_STAGE(PG8_SA(1, 0), cA + kstep, voffA[0]); PG8_STAGE(PG8_SB(1, 1), cB1 + kstep, voffB);
    PG8_WAIT_V(6); PG8_BAR;
    for (;;) {
        const bool has_next = S.next(ui + 1, nxt);
        unsigned voffN[2][2];
#pragma unroll
        for (int h = 0; h < 2; ++h)
#pragma unroll
            for (int i = 0; i < 2; ++i) voffN[h][i] = voffA[h][i];
        if constexpr (GATHER) { if (has_next) {
#pragma unroll
            for (int h = 0; h < 2; ++h)
#pragma unroll
                for (int i = 0; i < 2; ++i) voffN[h][i] = (unsigned)(nxt.gi[h * HALF + sR[i]] * K + sC[i]) * 2u; } }
        const char* nA = has_next ? nxt.a : cA; const char* nB0 = has_next ? nxt.b0 : cB0; const char* nB1 = has_next ? nxt.b1 : cB1;
        for (int t = 0; t < nt; t += 2) {
            const bool last = (t == nt - 2);
            const char* a1 = cA + (size_t)(t + 1) * kstep;
            const char* a2 = last ? nA : cA + (size_t)(t + 2) * kstep;
            const char* b20 = last ? nB0 : cB0 + (size_t)(t + 2) * kstep; const char* b21 = last ? nB1 : cB1 + (size_t)(t + 2) * kstep;
            const char* a3 = a2 + kstep; const char* b30 = b20 + kstep; const char* b31 = b21 + kstep;
            unsigned va0[2], va1[2];
#pragma unroll
            for (int i = 0; i < 2; ++i) { va0[i] = last ? voffN[0][i] : voffA[0][i]; va1[i] = last ? voffN[1][i] : voffA[1][i]; }
            PG8_LDB(B0, 0, 0); PG8_LDB(B1, 0, 1); PG8_SCHED; PG8_LDA(At, 0, 0); PG8_STAGE(PG8_SA(1, 1), a1, voffA[1]);
            PG8_WAIT_V(8); PG8_WAIT_L(0); PG8_BAR; PG8_MMA(0, 0, At, B0); PG8_MMA(0, 1, At, B1); PG8_BAR; PG8_SCHED;
            PG8_LDA(At, 0, 1); PG8_STAGE(PG8_SB(0, 0), b20, voffB); PG8_STAGE(PG8_SB(0, 1), b21, voffB); PG8_STAGE(PG8_SA(0, 0), a2, va0);
            PG8_WAIT_V(8); PG8_WAIT_L(0); PG8_BAR; PG8_MMA(1, 0, At, B0); PG8_MMA(1, 1, At, B1); PG8_BAR; PG8_SCHED;
            PG8_LDB(B0, 1, 0); PG8_LDB(B1, 1, 1); PG8_SCHED; PG8_LDA(At, 1, 0); PG8_STAGE(PG8_SA(0, 1), a2, va1);
            PG8_WAIT_V(8); PG8_WAIT_L(0); PG8_BAR; PG8_MMA(0, 0, At, B0); PG8_MMA(0, 1, At, B1); PG8_BAR; PG8_SCHED;
            PG8_LDA(At, 1, 1); PG8_STAGE(PG8_SB(1, 0), b30, voffB); PG8_STAGE(PG8_SB(1, 1), b31, voffB); PG8_STAGE(PG8_SA(1, 0), a3, va0);
            PG8_WAIT_V(8); PG8_WAIT_L(0); PG8_BAR; PG8_MMA(1, 0, At, B0); PG8_MMA(1, 1, At, B1); PG8_BAR; PG8_SCHED;
        }
        if constexpr (ALIGN_EPI) { if (wr == 0) PG8_BAR; }
        E(acc, cur, wr, wc, fr, fq);
        if (!has_next) break;
#pragma unroll
        for (int a = 0; a < 2; ++a)
#pragma unroll
            for (int b = 0; b < 2; ++b)
#pragma unroll
                for (int m = 0; m < 4; ++m)
#pragma unroll
                    for (int n = 0; n < 2; ++n) acc[a][b][m][n] = (f32x4){0.f, 0.f, 0.f, 0.f};
        cur = nxt; cA = nA; cB0 = nB0; cB1 = nB1; ++ui;
#pragma unroll
        for (int h = 0; h < 2; ++h)
#pragma unroll
            for (int i = 0; i < 2; ++i) voffA[h][i] = voffN[h][i];
        if constexpr (ALIGN_EPI) { if (wr == 1) PG8_BAR; }
    }
    PG8_WAIT_V(0);
    if constexpr (!ALIGN_EPI) { if (wr == 0) PG8_BAR; }
    PG8_BAR;
#undef PG8_SA
#undef PG8_SB
#undef PG8_STAGE
#undef PG8_LDA
#undef PG8_LDB
#undef PG8_MMA
#undef PG8_WAIT_V
#undef PG8_WAIT_L
#undef PG8_BAR
#undef PG8_SCHED
}

struct DenseOrder {
    const char* A; const char* Bt; int K, nM, nN, nwg, G, c;
    __device__ void init(const void* A_, const void* Bt_, int M, int N, int K_, int G_, int c_) { A = (const char*)A_; Bt = (const char*)Bt_; K = K_; nM = M / BM; nN = N / BM; nwg = nM * nN; G = G_; c = c_; }
    __device__ bool next(int i, Unit& u) const {
        const long L = (long)i * G + c; if (L >= nwg) return false;
        int wgid = (int)L; { const int q = nwg / 8, r = nwg % 8, xcd = wgid % 8, off = wgid / 8; wgid = (xcd < r ? xcd * (q + 1) : r * (q + 1) + (xcd - r) * q) + off; }
        const int nig = 8 * nN, gid = wgid / nig, fm = gid * 8, gsz = (nM - fm) < 8 ? (nM - fm) : 8;
        u.pm = fm + ((wgid % nig) % gsz); u.pn = (wgid % nig) / gsz; u.e = 0; u.pad = 0; u.gi = nullptr;
        u.a = A + (size_t)u.pm * BM * K * 2; u.b0 = Bt + (size_t)u.pn * BM * K * 2; u.b1 = u.b0 + (size_t)HALF * K * 2; return true;
    }
};
}
namespace mk {
constexpr int NWAVES = 8, NT = NWAVES * 64;
constexpr int RING_OFF = 0, RING_BYTES = 131072;
constexpr int LDS_BYTES = 147456;
constexpr int LDSCTL_OFF = LDS_BYTES - 1024, MISC_OFF = LDSCTL_OFF + 320;
#define GAS __attribute__((address_space(1)))
#define LAS __attribute__((address_space(3)))
typedef GAS unsigned gu32;
#define RLX_AGENT __ATOMIC_RELAXED, __HIP_MEMORY_SCOPE_AGENT
#define LDS_WAIT() asm volatile("s_waitcnt lgkmcnt(0)" ::: "memory")
#define VM_WAIT() asm volatile("s_waitcnt vmcnt(0)" ::: "memory")

#define XB_TMO      128
#define XB_XCNT(j)  (256  + 64 * (j))
#define XB_XSUB(j)  (1280 + 64 * (j))
#define XB_XGEN(j)  (2304 + 64 * (j))
#define XB_TOP      3328
#define XB_TOPGEN   3392
#define XCD_BAR_WORDS 3456
#define XB_SPIN_CAP (1u << 18)
__device__ __forceinline__ unsigned xb_ld(unsigned* p)              { return __hip_atomic_load(p, __ATOMIC_RELAXED, __HIP_MEMORY_SCOPE_AGENT); }
__device__ __forceinline__ unsigned xb_add(unsigned* p, unsigned v) { return __hip_atomic_fetch_add(p, v, __ATOMIC_RELAXED, __HIP_MEMORY_SCOPE_AGENT); }
__device__ __forceinline__ unsigned xb_xcc_id() { return (unsigned)__builtin_amdgcn_s_getreg((3 << 11) | 20) & 0xFu; }
#define XB_SPIN(cond, bar) do { unsigned _sp = 0; while (cond) { __builtin_amdgcn_s_sleep(1); \
    if ((++_sp & 255u) == 0u) { if (xb_ld(&(bar)[XB_TMO])) break; if (_sp > XB_SPIN_CAP) { atomicAdd(&(bar)[XB_TMO], 1u); break; } } } } while (0)
struct XcdBarrier { unsigned* bar; unsigned x; volatile LAS unsigned* st; };
__device__ __forceinline__ XcdBarrier xcd_barrier_post(unsigned* bar, volatile LAS unsigned* st) {
    XcdBarrier b; b.bar = bar; b.x = xb_xcc_id(); b.st = st;
    if (threadIdx.x == 0) (void)xb_add(&bar[XB_XCNT(b.x)], 1u);
    return b;
}
__device__ __forceinline__ void xcd_barrier_complete(unsigned* bar, unsigned x, unsigned& nloc, unsigned& nx) {
    const unsigned G = gridDim.x * gridDim.y * gridDim.z;
    unsigned sum, cnt, mine, sp = 0u;
    for (;;) {
        sum = 0u; cnt = 0u; mine = 0u;
#pragma unroll
        for (unsigned j = 0; j < 16; ++j) { const unsigned c = xb_ld(&bar[XB_XCNT(j)]); sum += c; cnt += (c > 0u) ? 1u : 0u; mine = (j == x) ? c : mine; }
        if (sum == G) break;
        __builtin_amdgcn_s_sleep(1);
        if ((++sp & 255u) == 0u) { if (xb_ld(&bar[XB_TMO])) break; if (sp > XB_SPIN_CAP) { atomicAdd(&bar[XB_TMO], 1u); break; } }
    }
    nloc = mine > 0u ? mine : 1u; nx = cnt > 0u ? cnt : 1u;
}
__device__ __forceinline__ void xcd_barrier(const XcdBarrier& b) {
    asm volatile("s_waitcnt vmcnt(0)" ::: "memory");
    __syncthreads();
    if (threadIdx.x == 0) {
        unsigned* bar = b.bar;
        __builtin_amdgcn_s_waitcnt(0);
        unsigned nloc = b.st[0], nx = b.st[1];
        if (nloc == 0u) { xcd_barrier_complete(bar, b.x, nloc, nx); b.st[0] = nloc; b.st[1] = nx; }
        const unsigned old = xb_add(&bar[XB_XSUB(b.x)], 1u);
        const unsigned gen = old / nloc;
        if (old + 1u == (gen + 1u) * nloc) {
            __builtin_amdgcn_fence(__ATOMIC_RELEASE, "agent");
            asm volatile("s_waitcnt vmcnt(0)" ::: "memory");
            const unsigned og = xb_add(&bar[XB_TOP], 1u);
            const unsigned tg = og / nx;
            if (og + 1u == (tg + 1u) * nx) xb_add(&bar[XB_TOPGEN], 1u);
            else XB_SPIN(xb_ld(&bar[XB_TOPGEN]) == tg, bar);
            __builtin_amdgcn_fence(__ATOMIC_ACQUIRE, "agent");
            xb_add(&bar[XB_XGEN(b.x)], 1u);
            asm volatile("s_waitcnt vmcnt(0)" ::: "memory");
        } else {
            XB_SPIN(xb_ld(&bar[XB_XGEN(b.x)]) == gen, bar);
            __builtin_amdgcn_fence(__ATOMIC_ACQUIRE, "agent");
            asm volatile("s_waitcnt vmcnt(0)" ::: "memory");
        }
    }
    __syncthreads();
}

struct Frame {
    LAS unsigned char* lds; char* ws;
    int tid, lane, wave, vcu, G;
};

__device__ __forceinline__ void p0_transpose_item(const float* W, int K, int N, bf16* WT, int dst_row0, LAS float* scr, int k0, int n0, int lane) {
#pragma unroll 8
    for (int i = 0; i < 32; ++i) { const int kk = 2 * i + (lane >> 5); scr[kk * 33 + (lane & 31)] = W[(size_t)(k0 + kk) * N + n0 + (lane & 31)]; }
    LDS_WAIT(); asm volatile("" ::: "memory");
    const int c = lane & 7;
#pragma unroll
    for (int j = 0; j < 4; ++j) { const int n = (lane >> 3) + 8 * j; const LAS float* s = scr + (8 * c) * 33 + n;
        u32x4 o; o.x = pk2(s[0 * 33], s[1 * 33]); o.y = pk2(s[2 * 33], s[3 * 33]); o.z = pk2(s[4 * 33], s[5 * 33]); o.w = pk2(s[6 * 33], s[7 * 33]);
        *(GAS u32x4*)(WT + (size_t)(dst_row0 + n) * K + k0 + 8 * c) = o; }
    LDS_WAIT(); asm volatile("" ::: "memory");
}
__device__ __forceinline__ void p0_matrix(Frame& F, const float* W, int K, int N, bf16* WT, LAS float* scr, int it) {
    const int nblk = N / 32, kb = it / nblk, nb = it % nblk;
    p0_transpose_item(W, K, N, WT, 32 * nb, scr, 64 * kb, 32 * nb, F.lane);
}
__device__ __forceinline__ void phase0(Frame& F, const Params& P) {
    LAS float* scr = (LAS float*)(F.lds + RING_OFF + F.wave * 16384);
    const int gw = F.vcu * NWAVES + F.wave, NGW = F.G * NWAVES;
    constexpr int I_IN = 16 * 185, I_A = 8 * 32, I_SQ = 16 * 32, I_PLE = 4 * 32;
    constexpr int NITEMS = I_IN + I_A + 3 * I_SQ + I_PLE;
    for (int it = gw; it < NITEMS; it += NGW) {
        int r = it;
        if (r < I_IN) { const int kb = r / 185, nb = r % 185; const int dst = nb < 120 ? 32 * nb : (nb == 120 ? 5888 : 32 * nb - 32);
            p0_transpose_item(P.w_in, D_, IN_DIM, (bf16*)(F.ws + WS_WIN), dst, scr, 64 * kb, 32 * nb, F.lane); continue; } r -= I_IN;
        if (r < I_A) { p0_matrix(F, P.w_ba, 512, D_, (bf16*)(F.ws + WS_WA), scr, r); continue; } r -= I_A;
        if (r < I_SQ) { p0_matrix(F, P.w_bg, D_, D_, (bf16*)(F.ws + WS_WB), scr, r); continue; } r -= I_SQ;
        if (r < I_SQ) { p0_matrix(F, P.w_out, D_, D_, (bf16*)(F.ws + WS_WO), scr, r); continue; } r -= I_SQ;
        if (r < I_SQ) { p0_matrix(F, P.w_pg, D_, D_, (bf16*)(F.ws + WS_WPG), scr, r); continue; } r -= I_SQ;
        p0_matrix(F, P.w_ple, PLE, D_, (bf16*)(F.ws + WS_WPLE), scr, r);
    }
    for (int i = (F.vcu * NT + F.tid); i < 28672; i += F.G * NT) *((GAS u32x4*)(F.ws + WS_WIN + (size_t)5920 * 2048) + i) = (u32x4){0u, 0u, 0u, 0u};
    for (int m = gw; m < T_; m += NGW) {
        const GAS f32x4* xr = (const GAS f32x4*)(P.x + (size_t)m * D_) + F.lane;
        f32x4 v[4]; float s = 0.f;
#pragma unroll
        for (int j = 0; j < 4; ++j) { v[j] = xr[64 * j]; s += (v[j].x * v[j].x + v[j].y * v[j].y) + (v[j].z * v[j].z + v[j].w * v[j].w); }
        const float r = 1.0f / sqrtf(wave_sum(s) * (1.0f / D_) + EPS);
        GAS u32x2* o8 = (GAS u32x2*)(F.ws + WS_A0 + (size_t)m * D_ * 2) + F.lane;
#pragma unroll
        for (int j = 0; j < 4; ++j) { const f32x4 g = ((const GAS f32x4*)P.norm_mix)[F.lane + 64 * j]; const f32x4 y = v[j] * r * g; o8[64 * j] = (u32x2){pk2(y.x, y.y), pk2(y.z, y.w)}; }
    }
    for (int gid = F.vcu * NT + F.tid; gid < T_ * 8; gid += F.G * NT) {
        const int i = gid & 7, t = gid >> 3;
        const float invf = i == 0 ? 1.0f : i == 1 ? 0.1939227432012558f : i == 2 ? 0.03760603070259094f : i == 3 ? 0.007292664609849453f : i == 4 ? 0.0014142135623842478f : i == 5 ? 0.00027424818836152554f : i == 6 ? 5.3182957344688475e-05f : 1.0313385246263351e-05f;
        const float ang = (float)P.pos[t] * invf;
        float* RT = (float*)(F.ws + WS_ROPE);
        RT[t * 16 + i] = cosf(ang); RT[t * 16 + 8 + i] = sinf(ang);
    }
}

struct EpiInProj {
    static constexpr bool PERM = true;
    char* ws;
    __device__ __forceinline__ void operator()(const f32x4 (&acc)[2][2][4][2], const pg8::Unit& u, int wr, int wc, int fr, int fq) const {
        const int pn = u.pn; const int row0 = u.pm * 256 + wr * 64 + fr;
        if (pn == 23) {
            if (wc == 0) {
#pragma unroll
                for (int ai = 0; ai < 2; ++ai)
#pragma unroll
                    for (int m = 0; m < 4; ++m) { float* zp = (float*)(ws + WS_Z) + (size_t)(row0 + ai * 128 + m * 16) * 32 + 8 * fq; *(f32x4*)zp = acc[ai][0][m][0]; *(f32x4*)(zp + 4) = acc[ai][0][m][1]; }
            }
            return;
        }
        bf16* base; int ldc, ct; float sc = 1.f;
        if (pn < 3) { base = (bf16*)(ws + WS_QKV); ldc = 768; ct = pn * 256; if (pn < 2) sc = QSCALE; }
        else { const int g = (pn - 3) >> 2; ct = ((pn - 3) & 3) * 256; ldc = 1024; base = (bf16*)(ws + (g == 0 ? WS_GQK : g == 1 ? WS_GV : g == 2 ? WS_GR : g == 3 ? WS_GATT : WS_GGLA)); if (g == 0 && ct < 512) sc = GQSCALE; }
        const bool rope_wave = (pn < 3) && ((wc & 1) == 0);
        const float* RT = (const float*)(ws + WS_ROPE);
#pragma unroll
        for (int ai = 0; ai < 2; ++ai)
#pragma unroll
            for (int m = 0; m < 4; ++m) {
                const int r = row0 + ai * 128 + m * 16;
                f32x4 cs0, cs1, sn0, sn1;
                if (rope_wave) { const f32x4* rp = (const f32x4*)(RT + (size_t)r * 16); cs0 = rp[0]; cs1 = rp[1]; sn0 = rp[2]; sn1 = rp[3]; }
#pragma unroll
                for (int bj = 0; bj < 2; ++bj) {
                    f32x4 v0 = acc[ai][bj][m][0], v1 = acc[ai][bj][m][1];
                    if (rope_wave && !(pn == 2 && bj == 1)) {
                        f32x4 o0, o1;
#pragma unroll
                        for (int j = 0; j < 4; ++j) { o0[j] = __shfl_xor(v0[j], 16); o1[j] = __shfl_xor(v1[j], 16); }
                        if (fq == 0) { v0 = v0 * cs0 - o0 * sn0; v1 = v1 * cs1 - o1 * sn1; }
                        else if (fq == 1) { v0 = v0 * cs0 + o0 * sn0; v1 = v1 * cs1 + o1 * sn1; }
                    }
                    v0 = v0 * sc; v1 = v1 * sc;
                    u32x4 w; w.x = pg8::cvt_pk_bf16(v0[0], v0[1]); w.y = pg8::cvt_pk_bf16(v0[2], v0[3]); w.z = pg8::cvt_pk_bf16(v1[0], v1[1]); w.w = pg8::cvt_pk_bf16(v1[2], v1[3]);
                    *(u32x4*)(base + (size_t)r * ldc + ct + bj * 128 + wc * 32 + 8 * fq) = w;
                }
            }
    }
};
__device__ __forceinline__ void phase1(Frame& F, const Params& P) {
    pg8::DenseOrder S; S.init(F.ws + WS_A0, F.ws + WS_WIN, T_, 6144, D_, F.G, (int)blockIdx.x);
    EpiInProj E{F.ws};
    pg8::gemm_phase<EpiInProj, pg8::DenseOrder, false, true>(F.lds + RING_OFF, D_, S, E);
}


__device__ __forceinline__ f32x4 ldbf4(const bf16* p) { const u32x2 r = *(const u32x2*)p; return (f32x4){bf2f(r.x & 0xffffu), bf2f(r.x >> 16), bf2f(r.y & 0xffffu), bf2f(r.y >> 16)}; }
__device__ __forceinline__ void stbf4(bf16* p, f32x4 v) { *(u32x2*)p = (u32x2){pk2(v.x, v.y), pk2(v.z, v.w)}; }
__device__ __forceinline__ f32x4 sig4(f32x4 g) { return (f32x4){sigmoidf_(g.x), sigmoidf_(g.y), sigmoidf_(g.z), sigmoidf_(g.w)}; }

__device__ __forceinline__ void phase3_pre(Frame& F, const Params& P) {
    const bf16* OFp = (const bf16*)(F.ws + WS_OF); const bf16* OBp = (const bf16*)(F.ws + WS_OB); const bf16* GR = (const bf16*)(F.ws + WS_GR); bf16* GLAO = (bf16*)(F.ws + WS_GLAO);
    const int gw0 = F.vcu * NWAVES + F.wave, NGW = F.G * NWAVES;
    for (int gw = gw0; gw < T_ * 4; gw += NGW) {
        const int h = gw & 3; const long t = gw >> 2; const long off = t * 1024 + h * 256 + F.lane * 4;
        const f32x4 x = ldbf4(OFp + off) + ldbf4(OBp + off);
        const float s = wave_sum(x.x * x.x + x.y * x.y + x.z * x.z + x.w * x.w);
        const float r = 1.0f / sqrtf(s * (1.0f / 256.0f) + EPS);
        const f32x4 g = *(const f32x4*)(P.gla_norm + h * 256 + F.lane * 4); const f32x4 gr = ldbf4(GR + off);
        stbf4(GLAO + off, x * r * g * gr * sig4(gr));
    }
}
struct EpiGate1 {
    static constexpr bool PERM = false;
    const bf16* G; float* C;
    __device__ __forceinline__ void operator()(const f32x4 (&acc)[2][2][4][2], const pg8::Unit& u, int wr, int wc, int fr, int fq) const {
        const int row0 = u.pm * 256 + wr * 64 + fr, col0 = u.pn * 256 + wc * 32 + 4 * fq;
#pragma unroll
        for (int ai = 0; ai < 2; ++ai)
#pragma unroll
            for (int m = 0; m < 4; ++m) { const size_t ro = (size_t)(row0 + ai * 128 + m * 16) * D_ + col0;
#pragma unroll
                for (int bj = 0; bj < 2; ++bj)
#pragma unroll
                    for (int n = 0; n < 2; ++n) { const size_t o = ro + bj * 128 + n * 16; *(f32x4*)(C + o) = sig4(ldbf4(G + o)) * acc[ai][bj][m][n]; } }
    }
};
struct EpiGate2 {
    static constexpr bool PERM = true;
    const bf16* G; const float* Tm; bf16* C;
    __device__ __forceinline__ void operator()(const f32x4 (&acc)[2][2][4][2], const pg8::Unit& u, int wr, int wc, int fr, int fq) const {
        const int row0 = u.pm * 256 + wr * 64 + fr, col0 = u.pn * 256 + wc * 32 + 8 * fq;
#pragma unroll
        for (int ai = 0; ai < 2; ++ai)
#pragma unroll
            for (int m = 0; m < 4; ++m) { const size_t ro = (size_t)(row0 + ai * 128 + m * 16) * D_ + col0;
#pragma unroll
                for (int bj = 0; bj < 2; ++bj) { const size_t o = ro + bj * 128;
                    const f32x4 v0 = *(const f32x4*)(Tm + o) + sig4(ldbf4(G + o)) * acc[ai][bj][m][0], v1 = *(const f32x4*)(Tm + o + 4) + sig4(ldbf4(G + o + 4)) * acc[ai][bj][m][1];
                    u32x4 w; w.x = pg8::cvt_pk_bf16(v0[0], v0[1]); w.y = pg8::cvt_pk_bf16(v0[2], v0[3]); w.z = pg8::cvt_pk_bf16(v1[0], v1[1]); w.w = pg8::cvt_pk_bf16(v1[2], v1[3]);
                    *(u32x4*)(C + o) = w; } }
    }
};
__device__ __forceinline__ void phase3a(Frame& F, const Params& P) {
    pg8::DenseOrder S; S.init(F.ws + WS_ATT, F.ws + WS_WA, T_, D_, 512, F.G, (int)blockIdx.x);
    EpiGate1 E{(const bf16*)(F.ws + WS_GATT), P.out};
    pg8::gemm_phase<EpiGate1, pg8::DenseOrder, false, false>(F.lds + RING_OFF, 512, S, E);
}
__device__ __forceinline__ void phase3b(Frame& F, const Params& P) {
    pg8::DenseOrder S; S.init(F.ws + WS_GLAO, F.ws + WS_WB, T_, D_, D_, F.G, (int)blockIdx.x);
    EpiGate2 E{(const bf16*)(F.ws + WS_GGLA), P.out, (bf16*)(F.ws + WS_MERGED)};
    pg8::gemm_phase<EpiGate2, pg8::DenseOrder, false, false>(F.lds + RING_OFF, D_, S, E);
}
struct EpiResid {
    static constexpr bool PERM = false;
    const float* R; float* C;
    __device__ __forceinline__ void operator()(const f32x4 (&acc)[2][2][4][2], const pg8::Unit& u, int wr, int wc, int fr, int fq) const {
        const int row0 = u.pm * 256 + wr * 64 + fr, col0 = u.pn * 256 + wc * 32 + 4 * fq;
#pragma unroll
        for (int ai = 0; ai < 2; ++ai)
#pragma unroll
            for (int m = 0; m < 4; ++m) { const size_t ro = (size_t)(row0 + ai * 128 + m * 16) * D_ + col0;
#pragma unroll
                for (int bj = 0; bj < 2; ++bj)
#pragma unroll
                    for (int n = 0; n < 2; ++n) { const size_t o = ro + bj * 128 + n * 16; *(f32x4*)(C + o) = *(const f32x4*)(R + o) + acc[ai][bj][m][n]; } }
    }
};
__device__ __forceinline__ void phase4a(Frame& F, const Params& P) {
    pg8::DenseOrder S; S.init(F.ws + WS_MERGED, F.ws + WS_WO, T_, D_, D_, F.G, (int)blockIdx.x);
    EpiResid E{P.x, (float*)(F.ws + WS_H)};
    pg8::gemm_phase<EpiResid, pg8::DenseOrder, false, false>(F.lds + RING_OFF, D_, S, E);
}
__device__ __forceinline__ void phase4b(Frame& F, const Params& P) {
    const float* H = (const float*)(F.ws + WS_H); bf16* XN = (bf16*)(F.ws + WS_XN); float* aff = (float*)(F.ws + WS_AFF);
    const int gw0 = F.vcu * NWAVES + F.wave, NGW = F.G * NWAVES, lane = F.lane;
    for (int row = gw0; row < T_; row += NGW) {
        const f32x4* xr = (const f32x4*)(H + (long)row * D_) + lane;
        f32x4 v[4]; float s = 0.f;
#pragma unroll
        for (int j = 0; j < 4; ++j) { v[j] = xr[64 * j]; s += v[j].x * v[j].x + v[j].y * v[j].y + v[j].z * v[j].z + v[j].w * v[j].w; }
        const float r = 1.0f / sqrtf(wave_sum(s) * (1.0f / D_) + EPS);
        float lg[16];
#pragma unroll
        for (int e = 0; e < 16; ++e) lg[e] = 0.f;
#pragma unroll
        for (int j = 0; j < 4; ++j) { const f32x4 y = v[j] * r * ((const f32x4*)P.norm_ffn)[lane + 64 * j]; stbf4(XN + (long)row * D_ + 4 * (lane + 64 * j), y);
            const f32x4* wr = (const f32x4*)(P.w_router + (size_t)(4 * (lane + 64 * j)) * 16);
#pragma unroll
            for (int q = 0; q < 4; ++q) { const f32x4 w0 = wr[q], w1 = wr[4 + q], w2 = wr[8 + q], w3 = wr[12 + q];
#pragma unroll
                for (int c = 0; c < 4; ++c) lg[4 * q + c] += y.x * w0[c] + y.y * w1[c] + y.z * w2[c] + y.w * w3[c]; } }
        float m = -INFINITY;
#pragma unroll
        for (int e = 0; e < 16; ++e) { lg[e] = wave_sum(lg[e]); m = fmaxf(m, lg[e]); }
        float sum = 0.f;
#pragma unroll
        for (int e = 0; e < 16; ++e) { lg[e] = expf(lg[e] - m); sum += lg[e]; }
        float val = 0.f;
#pragma unroll
        for (int e = 0; e < 16; ++e) if (lane == e) val = lg[e];
        if (lane < 16) aff[row * 16 + lane] = val / sum;
    }
}
__device__ __forceinline__ void topk_item(Frame& F, int b, int e) {
    LAS unsigned* cnts = (LAS unsigned*)(F.lds + RING_OFF);
    const float* aff = (const float*)(F.ws + WS_AFF); int* gidx = (int*)(F.ws + WS_GIDX); int* inv = (int*)(F.ws + WS_INV);
    const int tid = F.tid, lane = F.lane, wave = F.wave;
    unsigned v[8];
#pragma unroll
    for (int j = 0; j < 8; ++j) v[j] = __builtin_bit_cast(unsigned, aff[(size_t)(b * S_ + tid * 8 + j) * 16 + e]);
    unsigned Tv = 0u;
    __syncthreads();
    for (int bit = 30; bit >= 0; --bit) {
        const unsigned cand = Tv | (1u << bit);
        unsigned c = 0;
#pragma unroll
        for (int j = 0; j < 8; ++j) c += (v[j] >= cand) ? 1u : 0u;
#pragma unroll
        for (int o = 1; o < 64; o <<= 1) c += __shfl_xor(c, o);
        LAS unsigned* slot = cnts + (bit & 1) * 8;
        if (lane == 0) slot[wave] = c;
        __syncthreads();
        unsigned tot = 0;
#pragma unroll
        for (int w = 0; w < 8; ++w) tot += slot[w];
        if (tot >= (unsigned)CAP) Tv = cand;
    }
    unsigned ngt = 0, neq = 0;
#pragma unroll
    for (int j = 0; j < 8; ++j) { ngt += (v[j] > Tv) ? 1u : 0u; neq += (v[j] == Tv) ? 1u : 0u; }
    unsigned pk = ngt | (neq << 16), incl = pk;
#pragma unroll
    for (int o = 1; o < 64; o <<= 1) { const unsigned t = __shfl_up(incl, o); if (lane >= o) incl += t; }
    __syncthreads();
    LAS unsigned* wtot = cnts + 16;
    if (lane == 63) wtot[wave] = incl;
    __syncthreads();
    unsigned base = 0, total = 0;
#pragma unroll
    for (int w = 0; w < 8; ++w) { const unsigned t = wtot[w]; if (w < wave) base += t; total += t; }
    const unsigned excl = base + incl - pk;
    const unsigned tot_gt = total & 0xffffu, need_eq = (unsigned)CAP - tot_gt;
    unsigned g_before = excl & 0xffffu, e_before = excl >> 16;
#pragma unroll
    for (int j = 0; j < 8; ++j) {
        const bool gt = v[j] > Tv, eq = v[j] == Tv;
        const bool sel = gt || (eq && e_before < need_eq);
        const unsigned slotc = g_before + (e_before < need_eq ? e_before : need_eq);
        const int tok = b * S_ + tid * 8 + j;
        if (sel) gidx[e * ME + b * CAP + (int)slotc] = tok;
        inv[tok * 16 + e] = sel ? (int)(b * CAP + slotc) : -1;
        g_before += gt ? 1u : 0u; e_before += eq ? 1u : 0u;
    }
    __syncthreads();
}
__device__ __forceinline__ void phase5(Frame& F, const Params& P) {
    if (blockIdx.x < 64) topk_item(F, (int)blockIdx.x >> 4, (int)blockIdx.x & 15);
    LAS float* scr = (LAS float*)(F.lds + RING_OFF + 1024 + F.wave * 16384);
    const int gw = F.vcu * NWAVES + F.wave, NGW = F.G * NWAVES;
    for (int it = gw; it < 3 * 16 * 512; it += NGW) {
        const int mat = it >> 9, r = it & 511, which = mat >> 4, e = mat & 15;
        const float* W = (which == 0 ? P.w_eg : which == 1 ? P.w_eu : P.w_ed) + (size_t)e * D_ * FF;
        bf16* WT = (bf16*)(F.ws + (which == 0 ? WS_WEG : which == 1 ? WS_WEU : WS_WED)) + (size_t)e * D_ * FF;
        p0_matrix(F, W, 1024, 1024, WT, scr, r);
    }
}
struct ExpertOrder1 {
    const char* XN; const char* WG; const char* WU; const int* gidx; int G, c;
    __device__ bool next(int i, pg8::Unit& u) const {
        const int L = i * G + c; if (L >= 1024) return false;
        const int e = L >> 6, r = L & 63; u.e = e; u.pm = r & 7; u.pn = r >> 3; u.pad = 0;
        u.a = XN; u.gi = gidx + e * ME + u.pm * 256;
        const size_t bo = ((size_t)e * FF + (size_t)u.pn * 128) * D_ * 2; u.b0 = WG + bo; u.b1 = WU + bo; return true;
    }
};
struct EpiSwiglu {
    static constexpr bool PERM = true;
    bf16* HID;
    __device__ __forceinline__ void operator()(const f32x4 (&acc)[2][2][4][2], const pg8::Unit& u, int wr, int wc, int fr, int fq) const {
        const int row0 = u.e * ME + u.pm * 256 + wr * 64 + fr, col0 = u.pn * 128 + wc * 32 + 8 * fq;
#pragma unroll
        for (int ai = 0; ai < 2; ++ai)
#pragma unroll
            for (int m = 0; m < 4; ++m) { const f32x4 g0 = acc[ai][0][m][0], g1 = acc[ai][0][m][1];
                const f32x4 v0 = g0 * sig4(g0) * acc[ai][1][m][0], v1 = g1 * sig4(g1) * acc[ai][1][m][1];
                u32x4 w; w.x = pg8::cvt_pk_bf16(v0[0], v0[1]); w.y = pg8::cvt_pk_bf16(v0[2], v0[3]); w.z = pg8::cvt_pk_bf16(v1[0], v1[1]); w.w = pg8::cvt_pk_bf16(v1[2], v1[3]);
                *(u32x4*)(HID + (size_t)(row0 + ai * 128 + m * 16) * FF + col0) = w; }
    }
};
__device__ __forceinline__ void phase6(Frame& F, const Params& P) {
    ExpertOrder1 S{F.ws + WS_XN, F.ws + WS_WEG, F.ws + WS_WEU, (const int*)(F.ws + WS_GIDX), F.G, F.vcu};
    EpiSwiglu E{(bf16*)(F.ws + WS_HID)};
    pg8::gemm_phase<EpiSwiglu, ExpertOrder1, true, true>(F.lds + RING_OFF, D_, S, E);
}
struct ExpertOrder2 {
    const char* HID; const char* WD; int G, c;
    __device__ bool next(int i, pg8::Unit& u) const {
        const int L = i * G + c; if (L >= 512) return false;
        const int e = L >> 5, r = L & 31; u.e = e; u.pm = r & 7; u.pn = r >> 3; u.pad = 0; u.gi = nullptr;
        u.a = HID + ((size_t)e * ME + (size_t)u.pm * 256) * FF * 2;
        u.b0 = WD + ((size_t)e * D_ + (size_t)u.pn * 256) * FF * 2; u.b1 = u.b0 + (size_t)128 * FF * 2; return true;
    }
};
struct EpiRowScale {
    static constexpr bool PERM = true;
    const float* aff; const int* gidx; bf16* Y;
    __device__ __forceinline__ void operator()(const f32x4 (&acc)[2][2][4][2], const pg8::Unit& u, int wr, int wc, int fr, int fq) const {
        const int row0 = u.e * ME + u.pm * 256 + wr * 64 + fr, col0 = u.pn * 256 + wc * 32 + 8 * fq;
#pragma unroll
        for (int ai = 0; ai < 2; ++ai)
#pragma unroll
            for (int m = 0; m < 4; ++m) { const int r = row0 + ai * 128 + m * 16; const float a = aff[gidx[r] * NE + u.e];
#pragma unroll
                for (int bj = 0; bj < 2; ++bj) { const f32x4 v0 = acc[ai][bj][m][0] * a, v1 = acc[ai][bj][m][1] * a;
                    u32x4 w; w.x = pg8::cvt_pk_bf16(v0[0], v0[1]); w.y = pg8::cvt_pk_bf16(v0[2], v0[3]); w.z = pg8::cvt_pk_bf16(v1[0], v1[1]); w.w = pg8::cvt_pk_bf16(v1[2], v1[3]);
                    *(u32x4*)(Y + (size_t)r * D_ + col0 + bj * 128) = w; } }
    }
};
__device__ __forceinline__ void phase7(Frame& F, const Params& P) {
    ExpertOrder2 S{F.ws + WS_HID, F.ws + WS_WED, F.G, F.vcu};
    EpiRowScale E{(const float*)(F.ws + WS_AFF), (const int*)(F.ws + WS_GIDX), (bf16*)P.out};
    pg8::gemm_phase<EpiRowScale, ExpertOrder2, false, true>(F.lds + RING_OFF, FF, S, E);
}
constexpr size_t WS_PB = WS_GGLA;
__device__ __forceinline__ void phase8(Frame& F, const Params& P) {
    float* H = (float*)(F.ws + WS_H); const bf16* Y = (const bf16*)P.out; const int* inv = (const int*)(F.ws + WS_INV); bf16* XN3 = (bf16*)(F.ws + WS_XN3); bf16* PB = (bf16*)(F.ws + WS_PB);
    const int gw0 = F.vcu * NWAVES + F.wave, NGW = F.G * NWAVES, lane = F.lane;
    for (int row = gw0; row < T_; row += NGW) {
        f32x4* xr = (f32x4*)(H + (long)row * D_) + lane;
        f32x4 v[4];
#pragma unroll
        for (int j = 0; j < 4; ++j) v[j] = xr[64 * j];
        const int myinv = lane < 16 ? inv[row * 16 + lane] : -1;
        for (int e = 0; e < 16; ++e) { const int sl = __shfl(myinv, e); if (sl >= 0) { const bf16* yp = Y + ((long)e * ME + sl) * D_;
#pragma unroll
                for (int j = 0; j < 4; ++j) v[j] += ldbf4(yp + 4 * (lane + 64 * j)); } }
        float s = 0.f;
#pragma unroll
        for (int j = 0; j < 4; ++j) { xr[64 * j] = v[j]; s += v[j].x * v[j].x + v[j].y * v[j].y + v[j].z * v[j].z + v[j].w * v[j].w; }
        const float r = 1.0f / sqrtf(wave_sum(s) * (1.0f / D_) + EPS);
#pragma unroll
        for (int j = 0; j < 4; ++j) stbf4(XN3 + (long)row * D_ + 4 * (lane + 64 * j), v[j] * r * ((const f32x4*)P.norm_ple)[lane + 64 * j]);
        stbf4(PB + (long)row * PLE + 4 * lane, *((const f32x4*)(P.p + (long)row * PLE) + lane));
    }
}
struct EpiStoreF32 {
    static constexpr bool PERM = false;
    float* C;
    __device__ __forceinline__ void operator()(const f32x4 (&acc)[2][2][4][2], const pg8::Unit& u, int wr, int wc, int fr, int fq) const {
        const int row0 = u.pm * 256 + wr * 64 + fr, col0 = u.pn * 256 + wc * 32 + 4 * fq;
#pragma unroll
        for (int ai = 0; ai < 2; ++ai)
#pragma unroll
            for (int m = 0; m < 4; ++m) { const size_t ro = (size_t)(row0 + ai * 128 + m * 16) * D_ + col0;
#pragma unroll
                for (int bj = 0; bj < 2; ++bj)
#pragma unroll
                    for (int n = 0; n < 2; ++n) *(f32x4*)(C + ro + bj * 128 + n * 16) = acc[ai][bj][m][n]; }
    }
};
struct EpiPle {
    static constexpr bool PERM = false;
    const float* Pt; float* H;
    __device__ __forceinline__ void operator()(const f32x4 (&acc)[2][2][4][2], const pg8::Unit& u, int wr, int wc, int fr, int fq) const {
        const int row0 = u.pm * 256 + wr * 64 + fr, col0 = u.pn * 256 + wc * 32 + 4 * fq;
#pragma unroll
        for (int ai = 0; ai < 2; ++ai)
#pragma unroll
            for (int m = 0; m < 4; ++m) { const size_t ro = (size_t)(row0 + ai * 128 + m * 16) * D_ + col0;
#pragma unroll
                for (int bj = 0; bj < 2; ++bj)
#pragma unroll
                    for (int n = 0; n < 2; ++n) { const size_t o = ro + bj * 128 + n * 16; *(f32x4*)(H + o) = *(const f32x4*)(H + o) + sig4(acc[ai][bj][m][n]) * *(const f32x4*)(Pt + o); } }
    }
};
__device__ __forceinline__ void phase9a(Frame& F, const Params& P) {
    pg8::DenseOrder S; S.init(F.ws + WS_PB, F.ws + WS_WPLE, T_, D_, PLE, F.G, (int)blockIdx.x);
    EpiStoreF32 E{(float*)(F.ws + WS_PLET)};
    pg8::gemm_phase<EpiStoreF32, pg8::DenseOrder, false, false>(F.lds + RING_OFF, PLE, S, E);
}
__device__ __forceinline__ void phase9b(Frame& F, const Params& P) {
    pg8::DenseOrder S; S.init(F.ws + WS_XN3, F.ws + WS_WPG, T_, D_, D_, F.G, (int)blockIdx.x);
    EpiPle E{(const float*)(F.ws + WS_PLET), (float*)(F.ws + WS_H)};
    pg8::gemm_phase<EpiPle, pg8::DenseOrder, false, false>(F.lds + RING_OFF, D_, S, E);
}
__device__ __forceinline__ void phase10(Frame& F, const Params& P) {
    const float* H = (const float*)(F.ws + WS_H);
    const int gw0 = F.vcu * NWAVES + F.wave, NGW = F.G * NWAVES, lane = F.lane;
    for (int row = gw0; row < T_; row += NGW) {
        const f32x4* xr = (const f32x4*)(H + (long)row * D_) + lane;
        f32x4 v[4]; float s = 0.f;
#pragma unroll
        for (int j = 0; j < 4; ++j) { v[j] = xr[64 * j]; s += v[j].x * v[j].x + v[j].y * v[j].y + v[j].z * v[j].z + v[j].w * v[j].w; }
        const float r = 1.0f / sqrtf(wave_sum(s) * (1.0f / D_) + EPS);
#pragma unroll
        for (int j = 0; j < 4; ++j) *((f32x4*)(P.out + (long)row * D_) + lane + 64 * j) = v[j] * r * ((const f32x4*)P.norm_final)[lane + 64 * j];
    }
}

}
namespace mk {
typedef float f32x16 __attribute__((ext_vector_type(16)));
typedef short s16x8 __attribute__((ext_vector_type(8)));
typedef short s16x4 __attribute__((ext_vector_type(4)));
__device__ __forceinline__ int crow(int r, int hi) { return (r & 3) + 8 * (r >> 2) + 4 * hi; }
__device__ __forceinline__ s16x4 tr16(LAS const void* p) { return __builtin_bit_cast(s16x4, __builtin_amdgcn_ds_read_tr16_b64_v4i16((LAS s16x4*)p)); }
__device__ __forceinline__ unsigned cvtpk(float lo, float hi) { f32x2 v = {lo, hi}; typedef __bf16 bf2 __attribute__((ext_vector_type(2))); bf2 b = __builtin_convertvector(v, bf2); return __builtin_bit_cast(unsigned, b); }

constexpr int ATT_K = 0, ATT_V = 49152;

__device__ __forceinline__ void attn_unit(Frame& F, const Params& P, int b, int kvh, int nb) {
    const bf16* QKV = (const bf16*)(F.ws + WS_QKV); bf16* ATT = (bf16*)(F.ws + WS_ATT);
    LAS unsigned char* lds = F.lds + RING_OFF;
    const int tid = F.tid, lane = F.lane, wave = F.wave;
#pragma unroll
    for (int i = 0; i < 6; ++i) {
        const int idx = tid + NT * i, row = idx >> 3, ch = idx & 7;
        const int pos = (nb - 1) * 128 + row;
        u32x4 kv = (u32x4){0u, 0u, 0u, 0u}, vv = (u32x4){0u, 0u, 0u, 0u};
        if (pos >= 0 && pos < S_) { const bf16* src = QKV + (size_t)(b * S_ + pos) * 768 + 512 + kvh * 64 + ch * 8; kv = *(const u32x4*)src; vv = *(const u32x4*)(src + 128); }
        *(LAS u32x4*)(lds + ATT_K + row * 128 + ((ch ^ (row & 7)) * 16)) = kv;
        *(LAS u32x4*)(lds + ATT_V + row * 128 + ch * 16) = vv;
    }
    __syncthreads();
    const int g = wave >> 1, qh = wave & 1, hq = kvh * 4 + g;
    const int ql = lane & 31, hi = lane >> 5;
    const float sink2 = P.sink[hq] * LOG2E;
    const bool edge = (nb == 0) || (nb == S_ / 128 - 1);
    for (int sb = 0; sb < 2; ++sb) {
        const int q0 = qh * 64 + sb * 32;
        const size_t tok = (size_t)b * S_ + nb * 128 + q0 + ql;
        s16x8 qr[4];
#pragma unroll
        for (int d0 = 0; d0 < 4; ++d0) qr[d0] = *(const s16x8*)(QKV + tok * 768 + hq * 64 + d0 * 16 + hi * 8);
        float m = sink2, l = 0.f;
        f32x16 o0 = {}, o1 = {};
        for (int kt = 0; kt < 9; ++kt) {
            const int kr0 = q0 + 32 * kt;
            f32x16 p = {};
            { const int krow = kr0 + ql; LAS const unsigned char* kb = lds + ATT_K + krow * 128; const int sw = krow & 7;
#pragma unroll
                for (int d0 = 0; d0 < 4; ++d0) { const s16x8 kf = *(LAS const s16x8*)(kb + (((2 * d0 + hi) ^ sw) * 16)); p = __builtin_amdgcn_mfma_f32_32x32x16_bf16(kf, qr[d0], p, 0, 0, 0); } }
            if (kt == 0 || kt == 8 || edge) {
#pragma unroll
                for (int r = 0; r < 16; ++r) { const int krow = kr0 + crow(r, hi); const int rel = krow - (q0 + ql); const int pos = (nb - 1) * 128 + krow;
                    if (rel < 0 || rel > 256 || pos < 0 || pos >= S_) p[r] = -INFINITY; }
            }
            float tm = p[0];
#pragma unroll
            for (int r = 1; r < 16; ++r) tm = fmaxf(tm, p[r]);
            tm = fmaxf(tm, __shfl_xor(tm, 32));
            const float mn = fmaxf(m, tm), alpha = exp2f(m - mn);
            float ps = 0.f;
#pragma unroll
            for (int r = 0; r < 16; ++r) { p[r] = exp2f(p[r] - mn); ps += p[r]; }
            l = l * alpha + ps; m = mn;
#pragma unroll
            for (int r = 0; r < 16; ++r) { o0[r] *= alpha; o1[r] *= alpha; }
            LAS const unsigned char* vb = lds + ATT_V + (kr0 + 4 * hi + ((lane & 15) >> 2)) * 128 + (16 * ((lane >> 4) & 1) + 4 * (lane & 3)) * 2;
#pragma unroll
            for (int s = 0; s < 2; ++s) {
                u32x4 pw; pw.x = cvtpk(p[8 * s + 0], p[8 * s + 1]); pw.y = cvtpk(p[8 * s + 2], p[8 * s + 3]); pw.z = cvtpk(p[8 * s + 4], p[8 * s + 5]); pw.w = cvtpk(p[8 * s + 6], p[8 * s + 7]);
                const s16x8 pf = __builtin_bit_cast(s16x8, pw);
#pragma unroll
                for (int dd = 0; dd < 2; ++dd) {
                    const s16x4 lo = tr16(vb + (16 * s) * 128 + dd * 64), hi4 = tr16(vb + (16 * s + 8) * 128 + dd * 64);
                    const s16x8 vf = (s16x8){lo[0], lo[1], lo[2], lo[3], hi4[0], hi4[1], hi4[2], hi4[3]};
                    if (dd == 0) o0 = __builtin_amdgcn_mfma_f32_32x32x16_bf16(vf, pf, o0, 0, 0, 0); else o1 = __builtin_amdgcn_mfma_f32_32x32x16_bf16(vf, pf, o1, 0, 0, 0);
                }
            }
        }
        l += __shfl_xor(l, 32);
        l += exp2f(sink2 - m);
        const float rl = 1.0f / l;
        bf16* op = ATT + tok * 512 + hq * 64;
#pragma unroll
        for (int dd = 0; dd < 2; ++dd)
#pragma unroll
            for (int rg = 0; rg < 4; ++rg) { const f32x16& o = dd ? o1 : o0; const int d = 32 * dd + 8 * rg + 4 * hi;
                *(u32x2*)(op + d) = (u32x2){cvtpk(o[4 * rg + 0] * rl, o[4 * rg + 1] * rl), cvtpk(o[4 * rg + 2] * rl, o[4 * rg + 3] * rl)}; }
    }
    __syncthreads();
}
__device__ __forceinline__ void phase2_attn(Frame& F, const Params& P, int first, int nwg) {
    for (int L = (int)blockIdx.x - first; L < 256; L += nwg) { if (L < 0) break; attn_unit(F, P, L >> 6, (L >> 5) & 1, L & 31); }
}
}
namespace mk {
constexpr int GL_QT = 0, GL_QS = 272;
constexpr int GL_KT = 17408;
constexpr int GL_KE = 34816, GL_KES = 320;
constexpr int GL_VV = 55296, GL_VS = 576;
constexpr int GL_AT = 92160, GL_AS = 144;
constexpr int GL_ZZ = 101376;
constexpr int GL_SEG = 105472;
constexpr int GL_DEC = 109568;
constexpr int GL_UP = 110080;
constexpr int GL_OB = 0, GL_OS = 528;
constexpr int GL_END = 118272;
constexpr int GLA_NSEG = 8, GLA_SEGC = 8;
constexpr int GLA_STATE_FLOATS = 128 * 256;

struct GlaPre { u32x4 v[4]; f32x4 z; unsigned q[8], k[8]; };

template <bool FULL>
__device__ __forceinline__ void gla_load(GlaPre& R, const bf16* GQK, const bf16* GV, const float* Z, int b, int h, int dir, int c, int tid) {
    const int d2 = tid & 63, ls = tid >> 6;
    { const int l = tid >> 3; if (tid < 256) { const int l4 = tid >> 2, r4 = tid & 3; const int il = 64 * c + l4, t = dir ? (S_ - 1 - il) : il;
            R.z = *(const f32x4*)(Z + (size_t)(b * S_ + t) * 32 + dir * 16 + 4 * r4); } (void)l; }
#pragma unroll
    for (int i = 0; i < 4; ++i) { const int idx = tid + NT * i, l = idx >> 5, ch = idx & 31; const int il = 64 * c + l, t = dir ? (S_ - 1 - il) : il;
        R.v[i] = *(const u32x4*)(GV + (size_t)(b * S_ + t) * 1024 + h * 256 + ch * 8); }
}
template <bool FULL>
__device__ __forceinline__ void gla_load_qk(GlaPre& R, const bf16* GQK, int b, int h, int dir, int c, int tid) {
    const int d2 = tid & 63, ls = tid >> 6;
#pragma unroll
    for (int li = 0; li < 8; ++li) { const int il = 64 * c + 8 * ls + li, t = dir ? (S_ - 1 - il) : il; const bf16* row = GQK + (size_t)(b * S_ + t) * 1024 + h * 128 + 2 * d2;
        R.k[li] = *(const unsigned*)(row + 512); if (FULL) R.q[li] = *(const unsigned*)row; }
}

template <bool FULL>
__device__ __forceinline__ void gla_run(Frame& F, const Params& P, int b, int h, int dir, int c0, int nc, f32x16 (&S)[4], float& gacc0, float& gacc1) {
    const bf16* GQK = (const bf16*)(F.ws + WS_GQK); const bf16* GV = (const bf16*)(F.ws + WS_GV); const float* Z = (const float*)(F.ws + WS_Z);
    bf16* OUT = (bf16*)(F.ws + (dir ? WS_OB : WS_OF));
    const float* up = dir ? P.up_b : P.up_f; const float* bias = dir ? P.bias_b : P.bias_f;
    LAS unsigned char* lds = F.lds + RING_OFF;
    const int tid = F.tid, lane = F.lane, w = F.wave, lr = lane & 31, hi = lane >> 5;
    const int d2 = tid & 63, ls = tid >> 6, d0 = 2 * d2;
#pragma unroll
    for (int i = 0; i < 4; ++i) { const int idx = tid + NT * i; ((LAS float*)(lds + GL_UP))[idx] = up[(idx >> 7) * 512 + h * 128 + (idx & 127)]; }
    const f32x2 bias2 = *(const f32x2*)(bias + h * 128 + d0);
    const int trq = (lane & 15) >> 2, trp = lane & 3, trg = (lane >> 4) & 1;
    GlaPre R;
    gla_load<FULL>(R, GQK, GV, Z, b, h, dir, c0, tid);
    for (int ci = 0; ci < nc; ++ci) {
        const int c = c0 + ci;
        gla_load_qk<FULL>(R, GQK, b, h, dir, c, tid);
        if (tid < 256) *(LAS f32x4*)(lds + GL_ZZ + (tid >> 2) * 64 + (tid & 3) * 16) = R.z;
#pragma unroll
        for (int i = 0; i < 4; ++i) { const int idx = tid + NT * i, l = idx >> 5, ch = idx & 31; *(LAS u32x4*)(lds + GL_VV + l * GL_VS + ch * 16) = R.v[i]; }
        if (FULL && ci > 0) {
#pragma unroll
            for (int i = 0; i < 4; ++i) { const int idx = tid + NT * i, l = idx >> 5, ch = idx & 31; const int il = 64 * (c - 1) + l, t = dir ? (S_ - 1 - il) : il;
                *(u32x4*)(OUT + (size_t)(b * S_ + t) * 1024 + h * 256 + ch * 8) = *(LAS const u32x4*)(lds + GL_OB + l * GL_OS + ch * 16); }
        }
        __syncthreads();
        float bl0[8], bl1[8];
        { float run0 = 0.f, run1 = 0.f;
            float up0[16], up1[16];
#pragma unroll
            for (int r = 0; r < 16; ++r) { const f32x2 u2 = *(LAS const f32x2*)(lds + GL_UP + (r * 128 + d0) * 4); up0[r] = u2.x; up1[r] = u2.y; }
#pragma unroll
            for (int li = 0; li < 8; ++li) { const LAS f32x4* zr = (const LAS f32x4*)(lds + GL_ZZ + (8 * ls + li) * 64);
                float x0 = bias2.x, x1 = bias2.y;
#pragma unroll
                for (int q = 0; q < 4; ++q) { const f32x4 zz = zr[q];
                    x0 += zz.x * up0[4 * q] + zz.y * up0[4 * q + 1] + zz.z * up0[4 * q + 2] + zz.w * up0[4 * q + 3];
                    x1 += zz.x * up1[4 * q] + zz.y * up1[4 * q + 1] + zz.z * up1[4 * q + 2] + zz.w * up1[4 * q + 3]; }
                const float l0 = (fminf(x0, 0.f) * LOG2E - __builtin_amdgcn_logf(1.0f + __builtin_amdgcn_exp2f(-fabsf(x0) * LOG2E))) * (1.0f / 16.0f);
                const float l1 = (fminf(x1, 0.f) * LOG2E - __builtin_amdgcn_logf(1.0f + __builtin_amdgcn_exp2f(-fabsf(x1) * LOG2E))) * (1.0f / 16.0f);
                run0 += l0; run1 += l1; bl0[li] = run0; bl1[li] = run1; } }
        *(LAS f32x2*)(lds + GL_SEG + (ls * 128 + d0) * 4) = (f32x2){bl0[7], bl1[7]};
        __syncthreads();
        float off0 = 0.f, off1 = 0.f, g0 = 0.f, g1 = 0.f;
#pragma unroll
        for (int q = 0; q < 8; ++q) { const f32x2 sg = *(LAS const f32x2*)(lds + GL_SEG + (q * 128 + d0) * 4); g0 += sg.x; g1 += sg.y; if (q < ls) { off0 += sg.x; off1 += sg.y; } }
        gacc0 += g0; gacc1 += g1;
        if (ls == 0) *(LAS f32x2*)(lds + GL_DEC + d0 * 4) = (f32x2){__builtin_amdgcn_exp2f(g0), __builtin_amdgcn_exp2f(g1)};
#pragma unroll
        for (int li = 0; li < 8; ++li) { const int l = 8 * ls + li; const float b0 = off0 + bl0[li], b1 = off1 + bl1[li];
            const float k0 = bf2f(R.k[li] & 0xffffu), k1 = bf2f(R.k[li] >> 16);
            *(LAS unsigned*)(lds + GL_KE + l * GL_KES + d0 * 2) = cvtpk(k0 * __builtin_amdgcn_exp2f(g0 - b0), k1 * __builtin_amdgcn_exp2f(g1 - b1));
            if (FULL) { const float q0 = bf2f(R.q[li] & 0xffffu), q1 = bf2f(R.q[li] >> 16);
                *(LAS unsigned*)(lds + GL_QT + l * GL_QS + d0 * 2) = cvtpk(q0 * __builtin_amdgcn_exp2f(b0), q1 * __builtin_amdgcn_exp2f(b1));
                *(LAS unsigned*)(lds + GL_KT + l * GL_QS + d0 * 2) = cvtpk(k0 * __builtin_amdgcn_exp2f(-b0), k1 * __builtin_amdgcn_exp2f(-b1)); }
            if (li & 1) __builtin_amdgcn_sched_barrier(0); }
        if (ci + 1 < nc) gla_load<FULL>(R, GQK, GV, Z, b, h, dir, c + 1, tid);
        __syncthreads();
        s16x8 vf[4];
        { LAS const unsigned char* vb = lds + GL_VV + (8 * hi + trq) * GL_VS + (32 * w + 16 * trg + 4 * trp) * 2;
#pragma unroll
            for (int s = 0; s < 4; ++s) { const s16x4 lo = tr16(vb + (16 * s) * GL_VS), hh = tr16(vb + (16 * s + 4) * GL_VS);
                vf[s] = (s16x8){lo[0], lo[1], lo[2], lo[3], hh[0], hh[1], hh[2], hh[3]}; } }
        f32x16 O0 = {}, O1 = {};
        if (FULL) {
            if (w < 3) {
                const int li_ = (w + 1) >> 1, mi = w >> 1;
                f32x16 a = {};
#pragma unroll
                for (int s = 0; s < 8; ++s) { const s16x8 kf = *(LAS const s16x8*)(lds + GL_KT + (32 * mi + lr) * GL_QS + (16 * s + 8 * hi) * 2);
                    const s16x8 qf = *(LAS const s16x8*)(lds + GL_QT + (32 * li_ + lr) * GL_QS + (16 * s + 8 * hi) * 2);
                    a = __builtin_amdgcn_mfma_f32_32x32x16_bf16(kf, qf, a, 0, 0, 0); }
                const int l = 32 * li_ + lr;
#pragma unroll
                for (int rg = 0; rg < 4; ++rg) { const int m0 = 32 * mi + 8 * rg + 4 * hi; float v4[4];
#pragma unroll
                    for (int j = 0; j < 4; ++j) { const int m = m0 + j; const bool keep = dir ? (m < l) : (m <= l); v4[j] = keep ? a[4 * rg + j] : 0.f; }
                    *(LAS u32x2*)(lds + GL_AT + l * GL_AS + m0 * 2) = (u32x2){cvtpk(v4[0], v4[1]), cvtpk(v4[2], v4[3])}; }
            }
#pragma unroll
            for (int k = 0; k < 4; ++k)
#pragma unroll
                for (int s2 = 0; s2 < 2; ++s2) { u32x4 pw; pw.x = cvtpk(S[k][8 * s2 + 0], S[k][8 * s2 + 1]); pw.y = cvtpk(S[k][8 * s2 + 2], S[k][8 * s2 + 3]); pw.z = cvtpk(S[k][8 * s2 + 4], S[k][8 * s2 + 5]); pw.w = cvtpk(S[k][8 * s2 + 6], S[k][8 * s2 + 7]);
                    const s16x8 sp = __builtin_bit_cast(s16x8, pw); const int dc = 32 * k + 16 * s2 + 4 * hi;
                    LAS const unsigned char* qrow = lds + GL_QT + lr * GL_QS + dc * 2;
                    { const s16x4 a0 = *(LAS const s16x4*)(qrow), a1 = *(LAS const s16x4*)(qrow + 16);
                      O0 = __builtin_amdgcn_mfma_f32_32x32x16_bf16((s16x8){a0[0], a0[1], a0[2], a0[3], a1[0], a1[1], a1[2], a1[3]}, sp, O0, 0, 0, 0); }
                    { const s16x4 a0 = *(LAS const s16x4*)(qrow + 32 * GL_QS), a1 = *(LAS const s16x4*)(qrow + 32 * GL_QS + 16);
                      O1 = __builtin_amdgcn_mfma_f32_32x32x16_bf16((s16x8){a0[0], a0[1], a0[2], a0[3], a1[0], a1[1], a1[2], a1[3]}, sp, O1, 0, 0, 0); }
                    if (s2 == 1) __builtin_amdgcn_sched_barrier(0); }
        }
#pragma unroll
        for (int k = 0; k < 4; ++k) {
#pragma unroll
            for (int rg = 0; rg < 4; ++rg) { const f32x4 dc = *(LAS const f32x4*)(lds + GL_DEC + (32 * k + 8 * rg + 4 * hi) * 4);
                S[k][4 * rg + 0] *= dc.x; S[k][4 * rg + 1] *= dc.y; S[k][4 * rg + 2] *= dc.z; S[k][4 * rg + 3] *= dc.w; }
            LAS const unsigned char* kb = lds + GL_KE + (8 * hi + trq) * GL_KES + (32 * k + 16 * trg + 4 * trp) * 2;
#pragma unroll
            for (int s = 0; s < 4; ++s) { const s16x4 lo = tr16(kb + (16 * s) * GL_KES), hh = tr16(kb + (16 * s + 4) * GL_KES);
                const s16x8 kf = (s16x8){lo[0], lo[1], lo[2], lo[3], hh[0], hh[1], hh[2], hh[3]};
                S[k] = __builtin_amdgcn_mfma_f32_32x32x16_bf16(kf, vf[s], S[k], 0, 0, 0); }
            __builtin_amdgcn_sched_barrier(0);
        }
        if (FULL) {
            __syncthreads();
#pragma unroll
            for (int lb = 0; lb < 2; ++lb) {
                LAS const unsigned char* arow = lds + GL_AT + (32 * lb + lr) * GL_AS;
#pragma unroll
                for (int s = 0; s < 4; ++s) { if (lb == 0 && s >= 2) continue;
                    const s16x8 af = *(LAS const s16x8*)(arow + (16 * s + 8 * hi) * 2);
                    if (lb == 0) O0 = __builtin_amdgcn_mfma_f32_32x32x16_bf16(af, vf[s], O0, 0, 0, 0); else O1 = __builtin_amdgcn_mfma_f32_32x32x16_bf16(af, vf[s], O1, 0, 0, 0); }
            }
#pragma unroll
            for (int r = 0; r < 16; ++r) { const int l0 = crow(r, hi);
                *(LAS bf16*)(lds + GL_OB + l0 * GL_OS + (32 * w + lr) * 2) = (bf16)(cvtpk(O0[r], 0.f) & 0xffffu);
                *(LAS bf16*)(lds + GL_OB + (32 + l0) * GL_OS + (32 * w + lr) * 2) = (bf16)(cvtpk(O1[r], 0.f) & 0xffffu); }
        }
        __syncthreads();
    }
    if (FULL) {
        const int c = c0 + nc - 1;
#pragma unroll
        for (int i = 0; i < 4; ++i) { const int idx = tid + NT * i, l = idx >> 5, ch = idx & 31; const int il = 64 * c + l, t = dir ? (S_ - 1 - il) : il;
            *(u32x4*)(OUT + (size_t)(b * S_ + t) * 1024 + h * 256 + ch * 8) = *(LAS const u32x4*)(lds + GL_OB + l * GL_OS + ch * 16); }
        __syncthreads();
    }
}
__device__ __forceinline__ float* gla_SL(const Params& P, int u) { return P.out + (size_t)u * GLA_STATE_FLOATS; }
__device__ __forceinline__ float* gla_G(const Params& P, int u) { return P.out + (size_t)256 * GLA_STATE_FLOATS + (size_t)u * 128; }

__device__ __forceinline__ void gla_passA(Frame& F, const Params& P, int u) {
    const int seq = u >> 3, seg = u & 7;
    f32x16 S[4];
#pragma unroll
    for (int k = 0; k < 4; ++k) S[k] = (f32x16){};
    float ga0 = 0.f, ga1 = 0.f;
    gla_run<false>(F, P, seq >> 3, (seq >> 1) & 3, seq & 1, seg * GLA_SEGC, GLA_SEGC, S, ga0, ga1);
    float* SL = gla_SL(P, u);
#pragma unroll
    for (int k = 0; k < 4; ++k)
#pragma unroll
        for (int r = 0; r < 16; ++r) SL[((F.wave * 4 + k) * 16 + r) * 64 + F.lane] = S[k][r];
    if ((F.tid >> 6) == 0) *(f32x2*)(gla_G(P, u) + 2 * (F.tid & 63)) = (f32x2){ga0, ga1};
}
__device__ __forceinline__ void gla_passB(Frame& F, const Params& P, int u) {
    const int seq = u >> 3, seg = u & 7;
    LAS unsigned char* lds = F.lds + RING_OFF;
    const int hi = F.lane >> 5;
    f32x16 S[4];
#pragma unroll
    for (int k = 0; k < 4; ++k) S[k] = (f32x16){};
    for (int i = 0; i < seg; ++i) {
        const int ui = seq * 8 + i;
        if (F.tid < 128) ((LAS float*)(lds + GL_DEC))[F.tid] = __builtin_amdgcn_exp2f(gla_G(P, ui)[F.tid]);
        const float* SL = gla_SL(P, ui);
        f32x16 Lv[4];
#pragma unroll
        for (int k = 0; k < 4; ++k)
#pragma unroll
            for (int r = 0; r < 16; ++r) Lv[k][r] = SL[((F.wave * 4 + k) * 16 + r) * 64 + F.lane];
        __syncthreads();
#pragma unroll
        for (int k = 0; k < 4; ++k)
#pragma unroll
            for (int rg = 0; rg < 4; ++rg) { const f32x4 dc = *(LAS const f32x4*)(lds + GL_DEC + (32 * k + 8 * rg + 4 * hi) * 4);
                S[k][4 * rg + 0] = S[k][4 * rg + 0] * dc.x + Lv[k][4 * rg + 0]; S[k][4 * rg + 1] = S[k][4 * rg + 1] * dc.y + Lv[k][4 * rg + 1];
                S[k][4 * rg + 2] = S[k][4 * rg + 2] * dc.z + Lv[k][4 * rg + 2]; S[k][4 * rg + 3] = S[k][4 * rg + 3] * dc.w + Lv[k][4 * rg + 3]; }
        __syncthreads();
    }
    float ga0 = 0.f, ga1 = 0.f;
    gla_run<true>(F, P, seq >> 3, (seq >> 1) & 3, seq & 1, seg * GLA_SEGC, GLA_SEGC, S, ga0, ga1);
}
}
namespace mk {
constexpr int CW_BAR = 4096;
__global__ void __launch_bounds__(NT, 2) mega_fwd(Params P) {
    extern __shared__ __attribute__((aligned(16))) unsigned char lds[];
    Frame F; F.lds = (LAS unsigned char*)lds; F.ws = P.ws;
    F.tid = threadIdx.x; F.lane = F.tid & 63; F.wave = __builtin_amdgcn_readfirstlane(F.tid >> 6);
    F.G = gridDim.x; { const int bx = blockIdx.x; F.vcu = (F.G % 8 == 0) ? (bx % 8) * (F.G / 8) + bx / 8 : bx; }
    volatile LAS unsigned* MISC = (volatile LAS unsigned*)(F.lds + MISC_OFF);
    for (int u = F.tid; u < (LDS_BYTES - LDSCTL_OFF) / 4; u += NT) ((LAS unsigned*)(F.lds + LDSCTL_OFF))[u] = 0u;
    __syncthreads();
    XcdBarrier bar = xcd_barrier_post((unsigned*)(P.ws + WS_CTL) + CW_BAR, MISC + 8);
#define GRID_BAR() do { xcd_barrier(bar); asm volatile("" : "+v"(F.tid), "+v"(F.lane)); } while (0)
    phase0(F, P);                 GRID_BAR();
    phase1(F, P);                 GRID_BAR();
    { const int u = (int)blockIdx.x, seg = u & 7;
      if (seg < 7) gla_passA(F, P, u); else { for (int L = u >> 3; L < 64; L += 32) attn_unit(F, P, L >> 6, (L >> 5) & 1, L & 31); } }
    GRID_BAR();
    { const int u = (int)blockIdx.x, seg = u & 7;
      gla_passB(F, P, u);
      if (seg < 6) { const int L = 64 + seg * 32 + (u >> 3); attn_unit(F, P, L >> 6, (L >> 5) & 1, L & 31); } }
    GRID_BAR();
    phase3_pre(F, P); phase3a(F, P); GRID_BAR();
    phase3b(F, P);                GRID_BAR();
    phase4a(F, P);                GRID_BAR();
    phase4b(F, P);                GRID_BAR();
    phase5(F, P);                 GRID_BAR();
    phase6(F, P);                 GRID_BAR();
    phase7(F, P);                 GRID_BAR();
    phase8(F, P);                 GRID_BAR();
    phase9a(F, P); phase9b(F, P); GRID_BAR();
    phase10(F, P);
#undef GRID_BAR
}
}
extern "C" void kernel_launch(void* const* d_in, const int* in_sizes, int n_in, void* d_out, int out_size, void* d_ws, size_t ws_size, hipStream_t stream) {
    static int ready = 0;
    if (!ready) {
        if (n_in != 23 || ws_size < WS_END) { fprintf(stderr, "kernel_launch: unexpected inputs (n_in %d, ws %zu < %zu)\n", n_in, ws_size, (size_t)WS_END); ready = -1; return; }
        if (hipFuncSetAttribute((const void*)mk::mega_fwd, hipFuncAttributeMaxDynamicSharedMemorySize, mk::LDS_BYTES) != hipSuccess) { fprintf(stderr, "kernel_launch: hipFuncSetAttribute failed\n"); ready = -1; return; }
        ready = 1;
    }
    if (ready < 0) return;
    Params P{};
    P.x = (const float*)d_in[0]; P.p = (const float*)d_in[1]; P.pos = (const int*)d_in[2]; P.norm_mix = (const float*)d_in[3]; P.w_in = (const float*)d_in[4];
    P.up_f = (const float*)d_in[5]; P.bias_f = (const float*)d_in[6]; P.up_b = (const float*)d_in[7]; P.bias_b = (const float*)d_in[8]; P.sink = (const float*)d_in[9];
    P.gla_norm = (const float*)d_in[10]; P.w_ba = (const float*)d_in[11]; P.w_bg = (const float*)d_in[12]; P.w_out = (const float*)d_in[13]; P.norm_ffn = (const float*)d_in[14];
    P.w_router = (const float*)d_in[15]; P.w_eg = (const float*)d_in[16]; P.w_eu = (const float*)d_in[17]; P.w_ed = (const float*)d_in[18]; P.norm_ple = (const float*)d_in[19];
    P.w_pg = (const float*)d_in[20]; P.w_ple = (const float*)d_in[21]; P.norm_final = (const float*)d_in[22];
    P.out = (float*)d_out; P.ws = (char*)d_ws;
    (void)hipMemsetAsync((char*)d_ws + WS_CTL, 0, 1 * MiB, stream);
    hipLaunchKernelGGL(mk::mega_fwd, dim3(256), dim3(mk::NT), mk::LDS_BYTES, stream, P);
}
```

```cpp
#include <hip/hip_runtime.h>
#include <cstdio>
#include <cstdint>

constexpr int B_ = 4, S_ = 4096, D_ = 1024, T_ = B_ * S_;
constexpr int IN_DIM = 5920;
constexpr int C_Q = 0, C_K = 512, C_V = 640, C_GQ = 768, C_GK = 1280, C_GV = 1792, C_GR = 2816, C_ZF = 3840, C_ZB = 3856, C_GATT = 3872, C_GGLA = 4896;
constexpr int NE = 16, CAP = 512, FF = 1024, PLE = 256, ME = B_ * CAP;
constexpr float EPS = 1e-6f;
constexpr float LOG2E = 1.4426950408889634f;
constexpr float QSCALE = 0.125f * LOG2E;
constexpr float GQSCALE = 0.08838834764831845f;

typedef float f32x4 __attribute__((ext_vector_type(4)));
typedef float f32x2 __attribute__((ext_vector_type(2)));
typedef unsigned short bf16;
typedef unsigned u32x4 __attribute__((ext_vector_type(4)));
typedef unsigned u32x2 __attribute__((ext_vector_type(2)));

constexpr size_t MiB = 1u << 20;
constexpr size_t WS_CTL = 0, WS_ROPE = 1 * MiB, WS_AFF = 2 * MiB, WS_INV = 3 * MiB, WS_GIDX = 4 * MiB, WS_Z = 5 * MiB;
constexpr size_t WS_WIN = 8 * MiB, WS_WA = 20 * MiB, WS_WB = 21 * MiB, WS_WO = 23 * MiB, WS_WPG = 25 * MiB, WS_WPLE = 27 * MiB;
constexpr size_t WS_A0 = 28 * MiB;
constexpr size_t WS_QKV = 60 * MiB;
constexpr size_t WS_GQK = 84 * MiB;
constexpr size_t WS_GV = 116 * MiB;
constexpr size_t WS_GR = 148 * MiB;
constexpr size_t WS_GATT = 180 * MiB;
constexpr size_t WS_GGLA = 212 * MiB;
constexpr size_t WS_OB = 244 * MiB;
constexpr size_t WS_ATT = 276 * MiB;
constexpr size_t WS_OF = WS_A0, WS_XN = WS_A0, WS_XN3 = WS_A0, WS_GLAO = WS_GQK, WS_MERGED = WS_GV, WS_H = WS_GR, WS_HID = WS_QKV, WS_PLET = WS_QKV;
constexpr size_t WS_WEG = 212 * MiB, WS_WEU = 244 * MiB, WS_WED = 276 * MiB, WS_END = 308 * MiB;

__device__ __forceinline__ unsigned f2bf(float f) { unsigned u = __builtin_bit_cast(unsigned, f); return (u + 0x7fffu + ((u >> 16) & 1u)) >> 16; }
__device__ __forceinline__ float bf2f(unsigned h) { return __builtin_bit_cast(float, h << 16); }
__device__ __forceinline__ unsigned pk2(float lo, float hi) { return f2bf(lo) | (f2bf(hi) << 16); }
__device__ __forceinline__ float sigmoidf_(float x) { return 1.0f / (1.0f + __expf(-x)); }
__device__ __forceinline__ float wave_sum(float v) {
#pragma unroll
    for (int o = 1; o < 64; o <<= 1) v += __shfl_xor(v, o);
    return v;
}

struct Params {
    const float *x, *p; const int* pos; const float *norm_mix, *w_in, *up_f, *bias_f, *up_b, *bias_b, *sink, *gla_norm, *w_ba, *w_bg, *w_out,
        *norm_ffn, *w_router, *w_eg, *w_eu, *w_ed, *norm_ple, *w_pg, *w_ple, *norm_final;
    float* out; char* ws;
};
namespace pg8 {
#define PG8_LAS __attribute__((address_space(3)))
typedef short bf16x8 __attribute__((ext_vector_type(8)));
constexpr int BM = 256, BK = 64, HALF = 128, HTB = HALF * BK * 2  , STAGE_BYTES = 8 * HTB;

__host__ __device__ __forceinline__ int lds_byte(int r, int c) { const int st = (r >> 4) * 2 + (c >> 5), rr = r & 15, cc = c & 31, ob = rr * 64 + cc * 2; return st * 1024 + (ob ^ (((ob >> 9) & 1) << 5)); }
__host__ __device__ __forceinline__ void stage_rc(int b, int& R, int& C) { const int st = b / 1024, sb = b % 1024, swz = sb ^ (((sb >> 9) & 1) << 5); R = (st >> 1) * 16 + swz / 64; C = (st & 1) * 32 + (swz % 64) / 2; }
__host__ __device__ __forceinline__ int perm32(int rho) { const int n = rho >> 4, i = rho & 15; return 8 * (i >> 2) + 4 * n + (i & 3); }

struct Unit { const char* a; const char* b0; const char* b1; const int* gi; int pm, pn, e, pad; };

__device__ __forceinline__ unsigned cvt_pk_bf16(float lo, float hi) { unsigned r; asm volatile("v_cvt_pk_bf16_f32 %0, %1, %2" : "=v"(r) : "v"(lo), "v"(hi)); return r; }

template <class Epi, class Sched, bool GATHER, bool ALIGN_EPI>
__device__ __forceinline__ void gemm_phase(PG8_LAS unsigned char* lds, const int K, const Sched& S, const Epi& E) {
    int tid_ = threadIdx.x; asm volatile("" : "+v"(tid_));
    const int tid = tid_, wid = __builtin_amdgcn_readfirstlane(tid >> 6), lane = tid & 63, wr = wid >> 2, wc = wid & 3, fr = lane & 15, fq = lane >> 4;
    const int nt = K / BK;
    int sR[2], sC[2];
    unsigned voffB[2], voffA[2][2];
#pragma unroll
    for (int i = 0; i < 2; ++i) { stage_rc(tid * 16 + i * 8192, sR[i], sC[i]); const int Rb = Epi::PERM ? ((sR[i] & ~31) + perm32(sR[i] & 31)) : sR[i];
        voffB[i] = (unsigned)(Rb * K + sC[i]) * 2u;
        voffA[0][i] = (unsigned)(sR[i] * K + sC[i]) * 2u; voffA[1][i] = (unsigned)((sR[i] + HALF) * K + sC[i]) * 2u; }
    const size_t kstep = (size_t)(BK * 2);
    const unsigned ldsw = (unsigned)wid * 1024u;
    const int aoff = lds_byte(wr * 64 + fr, fq * 8), boff = lds_byte(wc * 32 + fr, fq * 8);
#define PG8_SA(b, h) (((b) * 2 + (h)) * HTB)
#define PG8_SB(b, h) ((4 + (b) * 2 + (h)) * HTB)
#define PG8_STAGE(bufoff, gbase, voff) do { _Pragma("unroll") for (int _i = 0; _i < 2; ++_i) \
        __builtin_amdgcn_global_load_lds((const unsigned*)((const char*)(gbase) + (voff)[_i]), (PG8_LAS unsigned*)(lds + (bufoff) + ldsw + _i * 8192), 16, 0, 0); } while (0)
#define PG8_LDA(dst, b, h) do { _Pragma("unroll") for (int m = 0; m < 4; ++m) _Pragma("unroll") for (int k = 0; k < 2; ++k) dst[m][k] = *(const PG8_LAS bf16x8*)(lds + PG8_SA(b, h) + aoff + m * 2048 + k * 1024); } while (0)
#define PG8_LDB(dst, b, h) do { _Pragma("unroll") for (int n = 0; n < 2; ++n) _Pragma("unroll") for (int k = 0; k < 2; ++k) dst[n][k] = *(const PG8_LAS bf16x8*)(lds + PG8_SB(b, h) + boff + n * 2048 + k * 1024); } while (0)
#define PG8_MMA(ai, bj, At, Bt) do { __builtin_amdgcn_s_setprio(1); _Pragma("unroll") for (int m = 0; m < 4; ++m) _Pragma("unroll") for (int n = 0; n < 2; ++n) _Pragma("unroll") for (int k = 0; k < 2; ++k) \
        acc[ai][bj][m][n] = __builtin_amdgcn_mfma_f32_16x16x32_bf16(Bt[n][k], At[m][k], acc[ai][bj][m][n], 0, 0, 0); __builtin_amdgcn_s_setprio(0); } while (0)
#define PG8_WAIT_V(n) asm volatile("s_waitcnt vmcnt(" #n ")" ::: "memory")
#define PG8_WAIT_L(n) asm volatile("s_waitcnt lgkmcnt(" #n ")" ::: "memory")
#define PG8_BAR __builtin_amdgcn_s_barrier()
#define PG8_SCHED __builtin_amdgcn_sched_barrier(0)
    Unit cur, nxt; int ui = 0;
    if (!S.next(0, cur)) return;
    if constexpr (GATHER) {
#pragma unroll
        for (int h = 0; h < 2; ++h)
#pragma unroll
            for (int i = 0; i < 2; ++i) voffA[h][i] = (unsigned)(cur.gi[h * HALF + sR[i]] * K + sC[i]) * 2u;
    }
    f32x4 acc[2][2][4][2];
#pragma unroll
    for (int a = 0; a < 2; ++a)
#pragma unroll
        for (int b = 0; b < 2; ++b)
#pragma unroll
            for (int m = 0; m < 4; ++m)
#pragma unroll
                for (int n = 0; n < 2; ++n) acc[a][b][m][n] = (f32x4){0.f, 0.f, 0.f, 0.f};
    bf16x8 At[4][2], B0[2][2], B1[2][2];
    const char* cA = cur.a; const char* cB0 = cur.b0; const char* cB1 = cur.b1;
    PG8_STAGE(PG8_SB(0, 0), cB0, voffB); PG8_STAGE(PG8_SB(0, 1), cB1, voffB); PG8_STAGE(PG8_SA(0, 0), cA, voffA[0]); PG8_STAGE(PG8_SA(0, 1), cA, voffA[1]);
    if (wr == 1) PG8_BAR;
    PG8_WAIT_V(2); PG8_BAR;
    PG8_STAGE(PG8_SB(1, 0), cB0 + kstep, voffB); PG8_STAGE(PG8_SA(1, 0), cA + kstep, voffA[0]); PG8_STAGE(PG8_SB(1, 1), cB1 + kstep, voffB);
    PG8_WAIT_V(6); PG8_BAR;
    for (;;) {
        const bool has_next = S.next(ui + 1, nxt);
        unsigned voffN[2][2];
#pragma unroll
        for (int h = 0; h < 2; ++h)
#pragma unroll
            for (int i = 0; i < 2; ++i) voffN[h][i] = voffA[h][i];
        if constexpr (GATHER) { if (has_next) {
#pragma unroll
            for (int h = 0; h < 2; ++h)
#pragma unroll
                for (int i = 0; i < 2; ++i) voffN[h][i] = (unsigned)(nxt.gi[h * HALF + sR[i]] * K + sC[i]) * 2u; } }
        const char* nA = has_next ? nxt.a : cA; const char* nB0 = has_next ? nxt.b0 : cB0; const char* nB1 = has_next ? nxt.b1 : cB1;
        for (int t = 0; t < nt; t += 2) {
            const bool last = (t == nt - 2);
            const char* a1 = cA + (size_t)(t + 1) * kstep;
            const char* a2 = last ? nA : cA + (size_t)(t + 2) * kstep;
            const char* b20 = last ? nB0 : cB0 + (size_t)(t + 2) * kstep; const char* b21 = last ? nB1 : cB1 + (size_t)(t + 2) * kstep;
            const char* a3 = a2 + kstep; const char* b30 = b20 + kstep; const char* b31 = b21 + kstep;
            unsigned va0[2], va1[2];
#pragma unroll
            for (int i = 0; i < 2; ++i) { va0[i] = last ? voffN[0][i] : voffA[0][i]; va1[i] = last ? voffN[1][i] : voffA[1][i]; }
            PG8_LDB(B0, 0, 0); PG8_LDB(B1, 0, 1); PG8_SCHED; PG8_LDA(At, 0, 0); PG8_STAGE(PG8_SA(1, 1), a1, voffA[1]);
            PG8_WAIT_V(8); PG8_WAIT_L(0); PG8_BAR; PG8_MMA(0, 0, At, B0); PG8_MMA(0, 1, At, B1); PG8_BAR; PG8_SCHED;
            PG8_LDA(At, 0, 1); PG8_STAGE(PG8_SB(0, 0), b20, voffB); PG8_STAGE(PG8_SB(0, 1), b21, voffB); PG8_STAGE(PG8_SA(0, 0), a2, va0);
            PG8_WAIT_V(8); PG8_WAIT_L(0); PG8_BAR; PG8_MMA(1, 0, At, B0); PG8_MMA(1, 1, At, B1); PG8_BAR; PG8_SCHED;
            PG8_LDB(B0, 1, 0); PG8_LDB(B1, 1, 1); PG8_SCHED; PG8_LDA(At, 1, 0); PG8_STAGE(PG8_SA(0, 1), a2, va1);
            PG8_WAIT_V(8); PG8_WAIT_L(0); PG8_BAR; PG8_MMA(0, 0, At, B0); PG8_MMA(0, 1, At, B1); PG8_BAR; PG8_SCHED;
            PG8_LDA(At, 1, 1); PG8_STAGE(PG8_SB(1, 0), b30, voffB); PG8_STAGE(PG8_SB(1, 1), b31, voffB); PG8_STAGE(PG8_SA(1, 0), a3, va0);
            PG8_WAIT_V(8); PG8_WAIT_L(0); PG8_BAR; PG8_MMA(1, 0, At, B0); PG8_MMA(1, 1, At, B1); PG8_BAR; PG8_SCHED;
        }
        if constexpr (ALIGN_EPI) { if (wr == 0) PG8_BAR; }
        E(acc, cur, wr, wc, fr, fq);
        if (!has_next) break;
#pragma unroll
        for (int a = 0; a < 2; ++a)
#pragma unroll
            for (int b = 0; b < 2; ++b)
#pragma unroll
                for (int m = 0; m < 4; ++m)
#pragma unroll
                    for (int n = 0; n < 2; ++n) acc[a][b][m][n] = (f32x4){0.f, 0.f, 0.f, 0.f};
        cur = nxt; cA = nA; cB0 = nB0; cB1 = nB1; ++ui;
#pragma unroll
        for (int h = 0; h < 2; ++h)
#pragma unroll
            for (int i = 0; i < 2; ++i) voffA[h][i] = voffN[h][i];
        if constexpr (ALIGN_EPI) { if (wr == 1) PG8_BAR; }
    }
    PG8_WAIT_V(0);
    if constexpr (!ALIGN_EPI) { if (wr == 0) PG8_BAR; }
    PG8_BAR;
#undef PG8_SA
#undef PG8_SB
#undef PG8_STAGE
#undef PG8_LDA
#undef PG8_LDB
#undef PG8_MMA
#undef PG8_WAIT_V
#undef PG8_WAIT_L
#undef PG8_BAR
#undef PG8_SCHED
}

struct DenseOrder {
    const char* A; const char* Bt; int K, nM, nN, nwg, G, c;
    __device__ void init(const void* A_, const void* Bt_, int M, int N, int K_, int G_, int c_) { A = (const char*)A_; Bt = (const char*)Bt_; K = K_; nM = M / BM; nN = N / BM; nwg = nM * nN; G = G_; c = c_; }
    __device__ bool next(int i, Unit& u) const {
        const long L = (long)i * G + c; if (L >= nwg) return false;
        int wgid = (int)L; { const int q = nwg / 8, r = nwg % 8, xcd = wgid % 8, off = wgid / 8; wgid = (xcd < r ? xcd * (q + 1) : r * (q + 1) + (xcd - r) * q) + off; }
        const int nig = 8 * nN, gid = wgid / nig, fm = gid * 8, gsz = (nM - fm) < 8 ? (nM - fm) : 8;
        u.pm = fm + ((wgid % nig) % gsz); u.pn = (wgid % nig) / gsz; u.e = 0; u.pad = 0; u.gi = nullptr;
        u.a = A + (size_t)u.pm * BM * K * 2; u.b0 = Bt + (size_t)u.pn * BM * K * 2; u.b1 = u.b0 + (size_t)HALF * K * 2; return true;
    }
};
}
namespace mk {
constexpr int NWAVES = 8, NT = NWAVES * 64;
constexpr int RING_OFF = 0, RING_BYTES = 131072;
constexpr int LDS_BYTES = 147456;
constexpr int LDSCTL_OFF = LDS_BYTES - 1024, MISC_OFF = LDSCTL_OFF + 320;
#define GAS __attribute__((address_space(1)))
#define LAS __attribute__((address_space(3)))
typedef GAS unsigned gu32;
#define RLX_AGENT __ATOMIC_RELAXED, __HIP_MEMORY_SCOPE_AGENT
#define LDS_WAIT() asm volatile("s_waitcnt lgkmcnt(0)" ::: "memory")
#define VM_WAIT() asm volatile("s_waitcnt vmcnt(0)" ::: "memory")

#define XB_TMO      128
#define XB_XCNT(j)  (256  + 64 * (j))
#define XB_XSUB(j)  (1280 + 64 * (j))
#define XB_XGEN(j)  (2304 + 64 * (j))
#define XB_TOP      3328
#define XB_TOPGEN   3392
#define XCD_BAR_WORDS 3456
#define XB_SPIN_CAP (1u << 18)
__device__ __forceinline__ unsigned xb_ld(unsigned* p)              { return __hip_atomic_load(p, __ATOMIC_RELAXED, __HIP_MEMORY_SCOPE_AGENT); }
__device__ __forceinline__ unsigned xb_add(unsigned* p, unsigned v) { return __hip_atomic_fetch_add(p, v, __ATOMIC_RELAXED, __HIP_MEMORY_SCOPE_AGENT); }
__device__ __forceinline__ unsigned xb_xcc_id() { return (unsigned)__builtin_amdgcn_s_getreg((3 << 11) | 20) & 0xFu; }
#define XB_SPIN(cond, bar) do { unsigned _sp = 0; while (cond) { __builtin_amdgcn_s_sleep(1); \
    if ((++_sp & 255u) == 0u) { if (xb_ld(&(bar)[XB_TMO])) break; if (_sp > XB_SPIN_CAP) { atomicAdd(&(bar)[XB_TMO], 1u); break; } } } } while (0)
struct XcdBarrier { unsigned* bar; unsigned x; volatile LAS unsigned* st; };
__device__ __forceinline__ XcdBarrier xcd_barrier_post(unsigned* bar, volatile LAS unsigned* st) {
    XcdBarrier b; b.bar = bar; b.x = xb_xcc_id(); b.st = st;
    if (threadIdx.x == 0) (void)xb_add(&bar[XB_XCNT(b.x)], 1u);
    return b;
}
__device__ __forceinline__ void xcd_barrier_complete(unsigned* bar, unsigned x, unsigned& nloc, unsigned& nx) {
    const unsigned G = gridDim.x * gridDim.y * gridDim.z;
    unsigned sum, cnt, mine, sp = 0u;
    for (;;) {
        sum = 0u; cnt = 0u; mine = 0u;
#pragma unroll
        for (unsigned j = 0; j < 16; ++j) { const unsigned c = xb_ld(&bar[XB_XCNT(j)]); sum += c; cnt += (c > 0u) ? 1u : 0u; mine = (j == x) ? c : mine; }
        if (sum == G) break;
        __builtin_amdgcn_s_sleep(1);
        if ((++sp & 255u) == 0u) { if (xb_ld(&bar[XB_TMO])) break; if (sp > XB_SPIN_CAP) { atomicAdd(&bar[XB_TMO], 1u); break; } }
    }
    nloc = mine > 0u ? mine : 1u; nx = cnt > 0u ? cnt : 1u;
}
__device__ __forceinline__ void xcd_barrier(const XcdBarrier& b) {
    asm volatile("s_waitcnt vmcnt(0)" ::: "memory");
    __syncthreads();
    if (threadIdx.x == 0) {
        unsigned* bar = b.bar;
        __builtin_amdgcn_s_waitcnt(0);
        unsigned nloc = b.st[0], nx = b.st[1];
        if (nloc == 0u) { xcd_barrier_complete(bar, b.x, nloc, nx); b.st[0] = nloc; b.st[1] = nx; }
        const unsigned old = xb_add(&bar[XB_XSUB(b.x)], 1u);
        const unsigned gen = old / nloc;
        if (old + 1u == (gen + 1u) * nloc) {
            __builtin_amdgcn_fence(__ATOMIC_RELEASE, "agent");
            asm volatile("s_waitcnt vmcnt(0)" ::: "memory");
            const unsigned og = xb_add(&bar[XB_TOP], 1u);
            const unsigned tg = og / nx;
            if (og + 1u == (tg + 1u) * nx) xb_add(&bar[XB_TOPGEN], 1u);
            else XB_SPIN(xb_ld(&bar[XB_TOPGEN]) == tg, bar);
            __builtin_amdgcn_fence(__ATOMIC_ACQUIRE, "agent");
            xb_add(&bar[XB_XGEN(b.x)], 1u);
            asm volatile("s_waitcnt vmcnt(0)" ::: "memory");
        } else {
            XB_SPIN(xb_ld(&bar[XB_XGEN(b.x)]) == gen, bar);
            __builtin_amdgcn_fence(__ATOMIC_ACQUIRE, "agent");
            asm volatile("s_waitcnt vmcnt(0)" ::: "memory");
        }
    }
    __syncthreads();
}

struct Frame {
    LAS unsigned char* lds; char* ws;
    int tid, lane, wave, vcu, G;
};

__device__ __forceinline__ void p0_transpose_item(const float* W, int K, int N, bf16* WT, int dst_row0, LAS float* scr, int k0, int n0, int lane) {
#pragma unroll 8
    for (int i = 0; i < 32; ++i) { const int kk = 2 * i + (lane >> 5); scr[kk * 33 + (lane & 31)] = W[(size_t)(k0 + kk) * N + n0 + (lane & 31)]; }
    LDS_WAIT(); asm volatile("" ::: "memory");
    const int c = lane & 7;
#pragma unroll
    for (int j = 0; j < 4; ++j) { const int n = (lane >> 3) + 8 * j; const LAS float* s = scr + (8 * c) * 33 + n;
        u32x4 o; o.x = pk2(s[0 * 33], s[1 * 33]); o.y = pk2(s[2 * 33], s[3 * 33]); o.z = pk2(s[4 * 33], s[5 * 33]); o.w = pk2(s[6 * 33], s[7 * 33]);
        *(GAS u32x4*)(WT + (size_t)(dst_row0 + n) * K + k0 + 8 * c) = o; }
    LDS_WAIT(); asm volatile("" ::: "memory");
}
__device__ __forceinline__ void p0_matrix(Frame& F, const float* W, int K, int N, bf16* WT, LAS float* scr, int it) {
    const int nblk = N / 32, kb = it / nblk, nb = it % nblk;
    p0_transpose_item(W, K, N, WT, 32 * nb, scr, 64 * kb, 32 * nb, F.lane);
}
__device__ __forceinline__ void phase0(Frame& F, const Params& P) {
    LAS float* scr = (LAS float*)(F.lds + RING_OFF + F.wave * 16384);
    const int gw = F.vcu * NWAVES + F.wave, NGW = F.G * NWAVES;
    constexpr int I_IN = 16 * 185, I_A = 8 * 32, I_SQ = 16 * 32, I_PLE = 4 * 32;
    constexpr int NITEMS = I_IN + I_A + 3 * I_SQ + I_PLE;
    for (int it = gw; it < NITEMS; it += NGW) {
        int r = it;
        if (r < I_IN) { const int kb = r / 185, nb = r % 185; const int dst = nb < 120 ? 32 * nb : (nb == 120 ? 5888 : 32 * nb - 32);
            p0_transpose_item(P.w_in, D_, IN_DIM, (bf16*)(F.ws + WS_WIN), dst, scr, 64 * kb, 32 * nb, F.lane); continue; } r -= I_IN;
        if (r < I_A) { p0_matrix(F, P.w_ba, 512, D_, (bf16*)(F.ws + WS_WA), scr, r); continue; } r -= I_A;
        if (r < I_SQ) { p0_matrix(F, P.w_bg, D_, D_, (bf16*)(F.ws + WS_WB), scr, r); continue; } r -= I_SQ;
        if (r < I_SQ) { p0_matrix(F, P.w_out, D_, D_, (bf16*)(F.ws + WS_WO), scr, r); continue; } r -= I_SQ;
        if (r < I_SQ) { p0_matrix(F, P.w_pg, D_, D_, (bf16*)(F.ws + WS_WPG), scr, r); continue; } r -= I_SQ;
        p0_matrix(F, P.w_ple, PLE, D_, (bf16*)(F.ws + WS_WPLE), scr, r);
    }
    for (int i = (F.vcu * NT + F.tid); i < 28672; i += F.G * NT) *((GAS u32x4*)(F.ws + WS_WIN + (size_t)5920 * 2048) + i) = (u32x4){0u, 0u, 0u, 0u};
    for (int m = gw; m < T_; m += NGW) {
        const GAS f32x4* xr = (const GAS f32x4*)(P.x + (size_t)m * D_) + F.lane;
        f32x4 v[4]; float s = 0.f;
#pragma unroll
        for (int j = 0; j < 4; ++j) { v[j] = xr[64 * j]; s += (v[j].x * v[j].x + v[j].y * v[j].y) + (v[j].z * v[j].z + v[j].w * v[j].w); }
        const float r = 1.0f / sqrtf(wave_sum(s) * (1.0f / D_) + EPS);
        GAS u32x2* o8 = (GAS u32x2*)(F.ws + WS_A0 + (size_t)m * D_ * 2) + F.lane;
#pragma unroll
        for (int j = 0; j < 4; ++j) { const f32x4 g = ((const GAS f32x4*)P.norm_mix)[F.lane + 64 * j]; const f32x4 y = v[j] * r * g; o8[64 * j] = (u32x2){pk2(y.x, y.y), pk2(y.z, y.w)}; }
    }
    for (int gid = F.vcu * NT + F.tid; gid < T_ * 8; gid += F.G * NT) {
        const int i = gid & 7, t = gid >> 3;
        const float invf = i == 0 ? 1.0f : i == 1 ? 0.1939227432012558f : i == 2 ? 0.03760603070259094f : i == 3 ? 0.007292664609849453f : i == 4 ? 0.0014142135623842478f : i == 5 ? 0.00027424818836152554f : i == 6 ? 5.3182957344688475e-05f : 1.0313385246263351e-05f;
        const float ang = (float)P.pos[t] * invf;
        float* RT = (float*)(F.ws + WS_ROPE);
        RT[t * 16 + i] = cosf(ang); RT[t * 16 + 8 + i] = sinf(ang);
    }
}

struct EpiInProj {
    static constexpr bool PERM = true;
    char* ws;
    __device__ __forceinline__ void operator()(const f32x4 (&acc)[2][2][4][2], const pg8::Unit& u, int wr, int wc, int fr, int fq) const {
        const int pn = u.pn; const int row0 = u.pm * 256 + wr * 64 + fr;
        if (pn == 23) {
            if (wc == 0) {
#pragma unroll
                for (int ai = 0; ai < 2; ++ai)
#pragma unroll
                    for (int m = 0; m < 4; ++m) { float* zp = (float*)(ws + WS_Z) + (size_t)(row0 + ai * 128 + m * 16) * 32 + 8 * fq; *(f32x4*)zp = acc[ai][0][m][0]; *(f32x4*)(zp + 4) = acc[ai][0][m][1]; }
            }
            return;
        }
        bf16* base; int ldc, ct; float sc = 1.f;
        if (pn < 3) { base = (bf16*)(ws + WS_QKV); ldc = 768; ct = pn * 256; if (pn < 2) sc = QSCALE; }
        else { const int g = (pn - 3) >> 2; ct = ((pn - 3) & 3) * 256; ldc = 1024; base = (bf16*)(ws + (g == 0 ? WS_GQK : g == 1 ? WS_GV : g == 2 ? WS_GR : g == 3 ? WS_GATT : WS_GGLA)); if (g == 0 && ct < 512) sc = GQSCALE; }
        const bool rope_wave = (pn < 3) && ((wc & 1) == 0);
        const float* RT = (const float*)(ws + WS_ROPE);
#pragma unroll
        for (int ai = 0; ai < 2; ++ai)
#pragma unroll
            for (int m = 0; m < 4; ++m) {
                const int r = row0 + ai * 128 + m * 16;
                f32x4 cs0, cs1, sn0, sn1;
                if (rope_wave) { const f32x4* rp = (const f32x4*)(RT + (size_t)r * 16); cs0 = rp[0]; cs1 = rp[1]; sn0 = rp[2]; sn1 = rp[3]; }
#pragma unroll
                for (int bj = 0; bj < 2; ++bj) {
                    f32x4 v0 = acc[ai][bj][m][0], v1 = acc[ai][bj][m][1];
                    if (rope_wave && !(pn == 2 && bj == 1)) {
                        f32x4 o0, o1;
#pragma unroll
                        for (int j = 0; j < 4; ++j) { o0[j] = __shfl_xor(v0[j], 16); o1[j] = __shfl_xor(v1[j], 16); }
                        if (fq == 0) { v0 = v0 * cs0 - o0 * sn0; v1 = v1 * cs1 - o1 * sn1; }
                        else if (fq == 1) { v0 = v0 * cs0 + o0 * sn0; v1 = v1 * cs1 + o1 * sn1; }
                    }
                    v0 = v0 * sc; v1 = v1 * sc;
                    u32x4 w; w.x = pg8::cvt_pk_bf16(v0[0], v0[1]); w.y = pg8::cvt_pk_bf16(v0[2], v0[3]); w.z = pg8::cvt_pk_bf16(v1[0], v1[1]); w.w = pg8::cvt_pk_bf16(v1[2], v1[3]);
                    *(u32x4*)(base + (size_t)r * ldc + ct + bj * 128 + wc * 32 + 8 * fq) = w;
                }
            }
    }
};
__device__ __forceinline__ void phase1(Frame& F, const Params& P) {
    pg8::DenseOrder S; S.init(F.ws + WS_A0, F.ws + WS_WIN, T_, 6144, D_, F.G, (int)blockIdx.x);
    EpiInProj E{F.ws};
    pg8::gemm_phase<EpiInProj, pg8::DenseOrder, false, true>(F.lds + RING_OFF, D_, S, E);
}


__device__ __forceinline__ f32x4 ldbf4(const bf16* p) { const u32x2 r = *(const u32x2*)p; return (f32x4){bf2f(r.x & 0xffffu), bf2f(r.x >> 16), bf2f(r.y & 0xffffu), bf2f(r.y >> 16)}; }
__device__ __forceinline__ void stbf4(bf16* p, f32x4 v) { *(u32x2*)p = (u32x2){pk2(v.x, v.y), pk2(v.z, v.w)}; }
__device__ __forceinline__ f32x4 sig4(f32x4 g) { return (f32x4){sigmoidf_(g.x), sigmoidf_(g.y), sigmoidf_(g.z), sigmoidf_(g.w)}; }

__device__ __forceinline__ void phase3_pre(Frame& F, const Params& P) {
    const bf16* OFp = (const bf16*)(F.ws + WS_OF); const bf16* OBp = (const bf16*)(F.ws + WS_OB); const bf16* GR = (const bf16*)(F.ws + WS_GR); bf16* GLAO = (bf16*)(F.ws + WS_GLAO);
    const int gw0 = F.vcu * NWAVES + F.wave, NGW = F.G * NWAVES;
    for (int gw = gw0; gw < T_ * 4; gw += NGW) {
        const int h = gw & 3; const long t = gw >> 2; const long off = t * 1024 + h * 256 + F.lane * 4;
        const f32x4 x = ldbf4(OFp + off) + ldbf4(OBp + off);
        const float s = wave_sum(x.x * x.x + x.y * x.y + x.z * x.z + x.w * x.w);
        const float r = 1.0f / sqrtf(s * (1.0f / 256.0f) + EPS);
        const f32x4 g = *(const f32x4*)(P.gla_norm + h * 256 + F.lane * 4); const f32x4 gr = ldbf4(GR + off);
        stbf4(GLAO + off, x * r * g * gr * sig4(gr));
    }
}
struct EpiGate1 {
    static constexpr bool PERM = true;
    const bf16* G; bf16* C;
    __device__ __forceinline__ void operator()(const f32x4 (&acc)[2][2][4][2], const pg8::Unit& u, int wr, int wc, int fr, int fq) const {
        const int row0 = u.pm * 256 + wr * 64 + fr, col0 = u.pn * 256 + wc * 32 + 8 * fq;
#pragma unroll
        for (int ai = 0; ai < 2; ++ai)
#pragma unroll
            for (int m = 0; m < 4; ++m) { const size_t ro = (size_t)(row0 + ai * 128 + m * 16) * D_ + col0;
#pragma unroll
                for (int bj = 0; bj < 2; ++bj) { const size_t o = ro + bj * 128; const u32x4 gw = *(const u32x4*)(G + o);
                    const f32x4 g0 = (f32x4){bf2f(gw.x & 0xffffu), bf2f(gw.x >> 16), bf2f(gw.y & 0xffffu), bf2f(gw.y >> 16)}, g1 = (f32x4){bf2f(gw.z & 0xffffu), bf2f(gw.z >> 16), bf2f(gw.w & 0xffffu), bf2f(gw.w >> 16)};
                    const f32x4 v0 = sig4(g0) * acc[ai][bj][m][0], v1 = sig4(g1) * acc[ai][bj][m][1];
                    u32x4 w; w.x = pg8::cvt_pk_bf16(v0[0], v0[1]); w.y = pg8::cvt_pk_bf16(v0[2], v0[3]); w.z = pg8::cvt_pk_bf16(v1[0], v1[1]); w.w = pg8::cvt_pk_bf16(v1[2], v1[3]);
                    *(u32x4*)(C + o) = w; } }
    }
};
struct EpiGate2 {
    static constexpr bool PERM = true;
    const bf16* G; const bf16* Tm; bf16* C;
    __device__ __forceinline__ void operator()(const f32x4 (&acc)[2][2][4][2], const pg8::Unit& u, int wr, int wc, int fr, int fq) const {
        const int row0 = u.pm * 256 + wr * 64 + fr, col0 = u.pn * 256 + wc * 32 + 8 * fq;
#pragma unroll
        for (int ai = 0; ai < 2; ++ai)
#pragma unroll
            for (int m = 0; m < 4; ++m) { const size_t ro = (size_t)(row0 + ai * 128 + m * 16) * D_ + col0;
#pragma unroll
                for (int bj = 0; bj < 2; ++bj) { const size_t o = ro + bj * 128; const u32x4 gw = *(const u32x4*)(G + o), tw = *(const u32x4*)(Tm + o);
                    const f32x4 g0 = (f32x4){bf2f(gw.x & 0xffffu), bf2f(gw.x >> 16), bf2f(gw.y & 0xffffu), bf2f(gw.y >> 16)}, g1 = (f32x4){bf2f(gw.z & 0xffffu), bf2f(gw.z >> 16), bf2f(gw.w & 0xffffu), bf2f(gw.w >> 16)};
                    const f32x4 t0 = (f32x4){bf2f(tw.x & 0xffffu), bf2f(tw.x >> 16), bf2f(tw.y & 0xffffu), bf2f(tw.y >> 16)}, t1 = (f32x4){bf2f(tw.z & 0xffffu), bf2f(tw.z >> 16), bf2f(tw.w & 0xffffu), bf2f(tw.w >> 16)};
                    const f32x4 v0 = t0 + sig4(g0) * acc[ai][bj][m][0], v1 = t1 + sig4(g1) * acc[ai][bj][m][1];
                    u32x4 w; w.x = pg8::cvt_pk_bf16(v0[0], v0[1]); w.y = pg8::cvt_pk_bf16(v0[2], v0[3]); w.z = pg8::cvt_pk_bf16(v1[0], v1[1]); w.w = pg8::cvt_pk_bf16(v1[2], v1[3]);
                    *(u32x4*)(C + o) = w; } }
    }
};
__device__ __forceinline__ void phase3a(Frame& F, const Params& P) {
    pg8::DenseOrder S; S.init(F.ws + WS_ATT, F.ws + WS_WA, T_, D_, 512, F.G, (int)blockIdx.x);
    EpiGate1 E{(const bf16*)(F.ws + WS_GATT), (bf16*)P.out};
    pg8::gemm_phase<EpiGate1, pg8::DenseOrder, false, false>(F.lds + RING_OFF, 512, S, E);
}
__device__ __forceinline__ void phase3b(Frame& F, const Params& P) {
    pg8::DenseOrder S; S.init(F.ws + WS_GLAO, F.ws + WS_WB, T_, D_, D_, F.G, (int)blockIdx.x);
    EpiGate2 E{(const bf16*)(F.ws + WS_GGLA), (const bf16*)P.out, (bf16*)(F.ws + WS_MERGED)};
    pg8::gemm_phase<EpiGate2, pg8::DenseOrder, false, false>(F.lds + RING_OFF, D_, S, E);
}
struct EpiResid {
    static constexpr bool PERM = false;
    const float* R; float* C;
    __device__ __forceinline__ void operator()(const f32x4 (&acc)[2][2][4][2], const pg8::Unit& u, int wr, int wc, int fr, int fq) const {
        const int row0 = u.pm * 256 + wr * 64 + fr, col0 = u.pn * 256 + wc * 32 + 4 * fq;
#pragma unroll
        for (int ai = 0; ai < 2; ++ai)
#pragma unroll
            for (int m = 0; m < 4; ++m) { const size_t ro = (size_t)(row0 + ai * 128 + m * 16) * D_ + col0;
#pragma unroll
                for (int bj = 0; bj < 2; ++bj)
#pragma unroll
                    for (int n = 0; n < 2; ++n) { const size_t o = ro + bj * 128 + n * 16; *(f32x4*)(C + o) = *(const f32x4*)(R + o) + acc[ai][bj][m][n]; } }
    }
};
__device__ __forceinline__ void phase4a(Frame& F, const Params& P) {
    pg8::DenseOrder S; S.init(F.ws + WS_MERGED, F.ws + WS_WO, T_, D_, D_, F.G, (int)blockIdx.x);
    EpiResid E{P.x, (float*)(F.ws + WS_H)};
    pg8::gemm_phase<EpiResid, pg8::DenseOrder, false, false>(F.lds + RING_OFF, D_, S, E);
}
__device__ __forceinline__ void phase4b(Frame& F, const Params& P) {
    const float* H = (const float*)(F.ws + WS_H); bf16* XN = (bf16*)(F.ws + WS_XN); float* aff = (float*)(F.ws + WS_AFF);
    LAS unsigned char* lds = F.lds + RING_OFF;
    for (int i = F.tid; i < 1024 * 4; i += NT) { const int k = i >> 2, q = i & 3; *(LAS f32x4*)(lds + k * 80 + q * 16) = *(const f32x4*)(P.w_router + k * 16 + q * 4); }
    __syncthreads();
    const int gw0 = F.vcu * NWAVES + F.wave, NGW = F.G * NWAVES, lane = F.lane;
    float gn[16];
#pragma unroll
    for (int m = 0; m < 16; ++m) gn[m] = P.norm_ffn[lane + 64 * m];
    for (int row = gw0; row < T_; row += NGW) {
        const float* xr = H + (long)row * D_ + lane;
        float v[16]; float s = 0.f;
#pragma unroll
        for (int m = 0; m < 16; ++m) { v[m] = xr[64 * m]; s += v[m] * v[m]; }
        const float r = 1.0f / sqrtf(wave_sum(s) * (1.0f / D_) + EPS);
        float lg[16];
#pragma unroll
        for (int e = 0; e < 16; ++e) lg[e] = 0.f;
        bf16* xo = XN + (long)row * D_ + lane;
#pragma unroll
        for (int m = 0; m < 16; ++m) { const float y = v[m] * r * gn[m]; xo[64 * m] = (bf16)f2bf(y);
            LAS const f32x4* wr = (LAS const f32x4*)(lds + (lane + 64 * m) * 80);
#pragma unroll
            for (int q = 0; q < 4; ++q) { const f32x4 w4 = wr[q]; lg[4 * q + 0] += y * w4.x; lg[4 * q + 1] += y * w4.y; lg[4 * q + 2] += y * w4.z; lg[4 * q + 3] += y * w4.w; }
            if (m & 1) __builtin_amdgcn_sched_barrier(0); }
        float mx = -INFINITY;
#pragma unroll
        for (int e = 0; e < 16; ++e) { lg[e] = wave_sum(lg[e]); mx = fmaxf(mx, lg[e]); }
        float sum = 0.f;
#pragma unroll
        for (int e = 0; e < 16; ++e) { lg[e] = expf(lg[e] - mx); sum += lg[e]; }
        float val = 0.f;
#pragma unroll
        for (int e = 0; e < 16; ++e) if (lane == e) val = lg[e];
        if (lane < 16) aff[row * 16 + lane] = val / sum;
    }
    __syncthreads();
}
__device__ __forceinline__ void topk_item(Frame& F, int b, int e) {
    LAS unsigned* cnts = (LAS unsigned*)(F.lds + RING_OFF);
    const float* aff = (const float*)(F.ws + WS_AFF); int* gidx = (int*)(F.ws + WS_GIDX); int* inv = (int*)(F.ws + WS_INV);
    const int tid = F.tid, lane = F.lane, wave = F.wave;
    unsigned v[8];
#pragma unroll
    for (int j = 0; j < 8; ++j) v[j] = __builtin_bit_cast(unsigned, aff[(size_t)(b * S_ + tid * 8 + j) * 16 + e]);
    unsigned Tv = 0u;
    __syncthreads();
    for (int bit = 30; bit >= 0; --bit) {
        const unsigned cand = Tv | (1u << bit);
        unsigned c = 0;
#pragma unroll
        for (int j = 0; j < 8; ++j) c += (v[j] >= cand) ? 1u : 0u;
#pragma unroll
        for (int o = 1; o < 64; o <<= 1) c += __shfl_xor(c, o);
        LAS unsigned* slot = cnts + (bit & 1) * 8;
        if (lane == 0) slot[wave] = c;
        __syncthreads();
        unsigned tot = 0;
#pragma unroll
        for (int w = 0; w < 8; ++w) tot += slot[w];
        if (tot >= (unsigned)CAP) Tv = cand;
    }
    unsigned ngt = 0, neq = 0;
#pragma unroll
    for (int j = 0; j < 8; ++j) { ngt += (v[j] > Tv) ? 1u : 0u; neq += (v[j] == Tv) ? 1u : 0u; }
    unsigned pk = ngt | (neq << 16), incl = pk;
#pragma unroll
    for (int o = 1; o < 64; o <<= 1) { const unsigned t = __shfl_up(incl, o); if (lane >= o) incl += t; }
    __syncthreads();
    LAS unsigned* wtot = cnts + 16;
    if (lane == 63) wtot[wave] = incl;
    __syncthreads();
    unsigned base = 0, total = 0;
#pragma unroll
    for (int w = 0; w < 8; ++w) { const unsigned t = wtot[w]; if (w < wave) base += t; total += t; }
    const unsigned excl = base + incl - pk;
    const unsigned tot_gt = total & 0xffffu, need_eq = (unsigned)CAP - tot_gt;
    unsigned g_before = excl & 0xffffu, e_before = excl >> 16;
#pragma unroll
    for (int j = 0; j < 8; ++j) {
        const bool gt = v[j] > Tv, eq = v[j] == Tv;
        const bool sel = gt || (eq && e_before < need_eq);
        const unsigned slotc = g_before + (e_before < need_eq ? e_before : need_eq);
        const int tok = b * S_ + tid * 8 + j;
        if (sel) gidx[e * ME + b * CAP + (int)slotc] = tok;
        inv[tok * 16 + e] = sel ? (int)(b * CAP + slotc) : -1;
        g_before += gt ? 1u : 0u; e_before += eq ? 1u : 0u;
    }
    __syncthreads();
}
__device__ __forceinline__ void phase5(Frame& F, const Params& P) {
    if (blockIdx.x < 64) topk_item(F, (int)blockIdx.x >> 4, (int)blockIdx.x & 15);
    LAS float* scr = (LAS float*)(F.lds + RING_OFF + 1024 + F.wave * 16384);
    const int gw = F.vcu * NWAVES + F.wave, NGW = F.G * NWAVES;
    const int wv = (int)blockIdx.x * NWAVES + F.wave, wv2 = ((int)blockIdx.x - 64) * NWAVES + F.wave;
    for (int k = 0; k < 13; ++k) {
        int it;
        if (k < 10) it = k * 2048 + wv; else { if (blockIdx.x < 64) break; it = 20480 + (k - 10) * 1536 + wv2; if (it >= 3 * 16 * 512) break; }
        const int mat = it >> 9, r = it & 511, which = mat >> 4, e = mat & 15;
        const float* W = (which == 0 ? P.w_eg : which == 1 ? P.w_eu : P.w_ed) + (size_t)e * D_ * FF;
        bf16* WT = (bf16*)(F.ws + (which == 0 ? WS_WEG : which == 1 ? WS_WEU : WS_WED)) + (size_t)e * D_ * FF;
        p0_matrix(F, W, 1024, 1024, WT, scr, r);
    }
}
struct ExpertOrder1 {
    const char* XN; const char* WG; const char* WU; const int* gidx; int G, c;
    __device__ bool next(int i, pg8::Unit& u) const {
        const int L = i * G + c; if (L >= 1024) return false;
        const int e = L >> 6, r = L & 63; u.e = e; u.pm = r & 7; u.pn = r >> 3; u.pad = 0;
        u.a = XN; u.gi = gidx + e * ME + u.pm * 256;
        const size_t bo = ((size_t)e * FF + (size_t)u.pn * 128) * D_ * 2; u.b0 = WG + bo; u.b1 = WU + bo; return true;
    }
};
struct EpiSwiglu {
    static constexpr bool PERM = true;
    bf16* HID;
    __device__ __forceinline__ void operator()(const f32x4 (&acc)[2][2][4][2], const pg8::Unit& u, int wr, int wc, int fr, int fq) const {
        const int row0 = u.e * ME + u.pm * 256 + wr * 64 + fr, col0 = u.pn * 128 + wc * 32 + 8 * fq;
#pragma unroll
        for (int ai = 0; ai < 2; ++ai)
#pragma unroll
            for (int m = 0; m < 4; ++m) { const f32x4 g0 = acc[ai][0][m][0], g1 = acc[ai][0][m][1];
                const f32x4 v0 = g0 * sig4(g0) * acc[ai][1][m][0], v1 = g1 * sig4(g1) * acc[ai][1][m][1];
                u32x4 w; w.x = pg8::cvt_pk_bf16(v0[0], v0[1]); w.y = pg8::cvt_pk_bf16(v0[2], v0[3]); w.z = pg8::cvt_pk_bf16(v1[0], v1[1]); w.w = pg8::cvt_pk_bf16(v1[2], v1[3]);
                *(u32x4*)(HID + (size_t)(row0 + ai * 128 + m * 16) * FF + col0) = w; }
    }
};
__device__ __forceinline__ void phase6(Frame& F, const Params& P) {
    ExpertOrder1 S{F.ws + WS_XN, F.ws + WS_WEG, F.ws + WS_WEU, (const int*)(F.ws + WS_GIDX), F.G, F.vcu};
    EpiSwiglu E{(bf16*)(F.ws + WS_HID)};
    pg8::gemm_phase<EpiSwiglu, ExpertOrder1, true, true>(F.lds + RING_OFF, D_, S, E);
}
struct ExpertOrder2 {
    const char* HID; const char* WD; int G, c;
    __device__ bool next(int i, pg8::Unit& u) const {
        const int L = i * G + c; if (L >= 512) return false;
        const int e = L >> 5, r = L & 31; u.e = e; u.pm = r & 7; u.pn = r >> 3; u.pad = 0; u.gi = nullptr;
        u.a = HID + ((size_t)e * ME + (size_t)u.pm * 256) * FF * 2;
        u.b0 = WD + ((size_t)e * D_ + (size_t)u.pn * 256) * FF * 2; u.b1 = u.b0 + (size_t)128 * FF * 2; return true;
    }
};
struct EpiRowScale {
    static constexpr bool PERM = true;
    const float* aff; const int* gidx; bf16* Y;
    __device__ __forceinline__ void operator()(const f32x4 (&acc)[2][2][4][2], const pg8::Unit& u, int wr, int wc, int fr, int fq) const {
        const int row0 = u.e * ME + u.pm * 256 + wr * 64 + fr, col0 = u.pn * 256 + wc * 32 + 8 * fq;
#pragma unroll
        for (int ai = 0; ai < 2; ++ai)
#pragma unroll
            for (int m = 0; m < 4; ++m) { const int r = row0 + ai * 128 + m * 16; const float a = aff[gidx[r] * NE + u.e];
#pragma unroll
                for (int bj = 0; bj < 2; ++bj) { const f32x4 v0 = acc[ai][bj][m][0] * a, v1 = acc[ai][bj][m][1] * a;
                    u32x4 w; w.x = pg8::cvt_pk_bf16(v0[0], v0[1]); w.y = pg8::cvt_pk_bf16(v0[2], v0[3]); w.z = pg8::cvt_pk_bf16(v1[0], v1[1]); w.w = pg8::cvt_pk_bf16(v1[2], v1[3]);
                    *(u32x4*)(Y + (size_t)r * D_ + col0 + bj * 128) = w; } }
    }
};
__device__ __forceinline__ void phase7(Frame& F, const Params& P) {
    ExpertOrder2 S{F.ws + WS_HID, F.ws + WS_WED, F.G, F.vcu};
    EpiRowScale E{(const float*)(F.ws + WS_AFF), (const int*)(F.ws + WS_GIDX), (bf16*)P.out};
    pg8::gemm_phase<EpiRowScale, ExpertOrder2, false, true>(F.lds + RING_OFF, FF, S, E);
}
constexpr size_t WS_PB = WS_GGLA;
__device__ __forceinline__ void phase8(Frame& F, const Params& P) {
    float* H = (float*)(F.ws + WS_H); const bf16* Y = (const bf16*)P.out; const int* inv = (const int*)(F.ws + WS_INV); bf16* XN3 = (bf16*)(F.ws + WS_XN3); bf16* PB = (bf16*)(F.ws + WS_PB);
    const int gw0 = F.vcu * NWAVES + F.wave, NGW = F.G * NWAVES, lane = F.lane;
    for (int row = gw0; row < T_; row += NGW) {
        f32x4* xr = (f32x4*)(H + (long)row * D_) + lane;
        f32x4 v[4];
#pragma unroll
        for (int j = 0; j < 4; ++j) v[j] = xr[64 * j];
        const int myinv = lane < 16 ? inv[row * 16 + lane] : -1;
        for (int e = 0; e < 16; ++e) { const int sl = __shfl(myinv, e); if (sl >= 0) { const bf16* yp = Y + ((long)e * ME + sl) * D_;
#pragma unroll
                for (int j = 0; j < 4; ++j) v[j] += ldbf4(yp + 4 * (lane + 64 * j)); } }
        float s = 0.f;
#pragma unroll
        for (int j = 0; j < 4; ++j) { xr[64 * j] = v[j]; s += v[j].x * v[j].x + v[j].y * v[j].y + v[j].z * v[j].z + v[j].w * v[j].w; }
        const float r = 1.0f / sqrtf(wave_sum(s) * (1.0f / D_) + EPS);
#pragma unroll
        for (int j = 0; j < 4; ++j) stbf4(XN3 + (long)row * D_ + 4 * (lane + 64 * j), v[j] * r * ((const f32x4*)P.norm_ple)[lane + 64 * j]);
        stbf4(PB + (long)row * PLE + 4 * lane, *((const f32x4*)(P.p + (long)row * PLE) + lane));
    }
}
struct EpiStoreBf16 {
    static constexpr bool PERM = true;
    bf16* C;
    __device__ __forceinline__ void operator()(const f32x4 (&acc)[2][2][4][2], const pg8::Unit& u, int wr, int wc, int fr, int fq) const {
        const int row0 = u.pm * 256 + wr * 64 + fr, col0 = u.pn * 256 + wc * 32 + 8 * fq;
#pragma unroll
        for (int ai = 0; ai < 2; ++ai)
#pragma unroll
            for (int m = 0; m < 4; ++m) { const size_t ro = (size_t)(row0 + ai * 128 + m * 16) * D_ + col0;
#pragma unroll
                for (int bj = 0; bj < 2; ++bj) { const f32x4 v0 = acc[ai][bj][m][0], v1 = acc[ai][bj][m][1];
                    u32x4 w; w.x = pg8::cvt_pk_bf16(v0[0], v0[1]); w.y = pg8::cvt_pk_bf16(v0[2], v0[3]); w.z = pg8::cvt_pk_bf16(v1[0], v1[1]); w.w = pg8::cvt_pk_bf16(v1[2], v1[3]);
                    *(u32x4*)(C + ro + bj * 128) = w; } }
    }
};
struct EpiPle {
    static constexpr bool PERM = false;
    const bf16* Pt; float* H;
    __device__ __forceinline__ void operator()(const f32x4 (&acc)[2][2][4][2], const pg8::Unit& u, int wr, int wc, int fr, int fq) const {
        const int row0 = u.pm * 256 + wr * 64 + fr, col0 = u.pn * 256 + wc * 32 + 4 * fq;
#pragma unroll
        for (int ai = 0; ai < 2; ++ai)
#pragma unroll
            for (int m = 0; m < 4; ++m) { const size_t ro = (size_t)(row0 + ai * 128 + m * 16) * D_ + col0;
#pragma unroll
                for (int bj = 0; bj < 2; ++bj)
#pragma unroll
                    for (int n = 0; n < 2; ++n) { const size_t o = ro + bj * 128 + n * 16; *(f32x4*)(H + o) = *(const f32x4*)(H + o) + sig4(acc[ai][bj][m][n]) * ldbf4(Pt + o); } }
    }
};
__device__ __forceinline__ void phase9a(Frame& F, const Params& P) {
    pg8::DenseOrder S; S.init(F.ws + WS_PB, F.ws + WS_WPLE, T_, D_, PLE, F.G, (int)blockIdx.x);
    EpiStoreBf16 E{(bf16*)(F.ws + WS_PLET)};
    pg8::gemm_phase<EpiStoreBf16, pg8::DenseOrder, false, false>(F.lds + RING_OFF, PLE, S, E);
}
__device__ __forceinline__ void phase9b(Frame& F, const Params& P) {
    pg8::DenseOrder S; S.init(F.ws + WS_XN3, F.ws + WS_WPG, T_, D_, D_, F.G, (int)blockIdx.x);
    EpiPle E{(const bf16*)(F.ws + WS_PLET), (float*)(F.ws + WS_H)};
    pg8::gemm_phase<EpiPle, pg8::DenseOrder, false, false>(F.lds + RING_OFF, D_, S, E);
}
__device__ __forceinline__ void phase10(Frame& F, const Params& P) {
    const float* H = (const float*)(F.ws + WS_H);
    const int gw0 = F.vcu * NWAVES + F.wave, NGW = F.G * NWAVES, lane = F.lane;
    for (int row = gw0; row < T_; row += NGW) {
        const f32x4* xr = (const f32x4*)(H + (long)row * D_) + lane;
        f32x4 v[4]; float s = 0.f;
#pragma unroll
        for (int j = 0; j < 4; ++j) { v[j] = xr[64 * j]; s += v[j].x * v[j].x + v[j].y * v[j].y + v[j].z * v[j].z + v[j].w * v[j].w; }
        const float r = 1.0f / sqrtf(wave_sum(s) * (1.0f / D_) + EPS);
#pragma unroll
        for (int j = 0; j < 4; ++j) *((f32x4*)(P.out + (long)row * D_) + lane + 64 * j) = v[j] * r * ((const f32x4*)P.norm_final)[lane + 64 * j];
    }
}

}
namespace mk {
typedef float f32x16 __attribute__((ext_vector_type(16)));
typedef short s16x8 __attribute__((ext_vector_type(8)));
typedef short s16x4 __attribute__((ext_vector_type(4)));
__device__ __forceinline__ int crow(int r, int hi) { return (r & 3) + 8 * (r >> 2) + 4 * hi; }
__device__ __forceinline__ s16x4 tr16(LAS const void* p) { return __builtin_bit_cast(s16x4, __builtin_amdgcn_ds_read_tr16_b64_v4i16((LAS s16x4*)p)); }
__device__ __forceinline__ s16x8 cat8(s16x4 lo, s16x4 hi) { const u32x2 a = __builtin_bit_cast(u32x2, lo), b = __builtin_bit_cast(u32x2, hi); return __builtin_bit_cast(s16x8, (u32x4){a.x, a.y, b.x, b.y}); }
__device__ __forceinline__ unsigned cvtpk(float lo, float hi) { f32x2 v = {lo, hi}; typedef __bf16 bf2 __attribute__((ext_vector_type(2))); bf2 b = __builtin_convertvector(v, bf2); return __builtin_bit_cast(unsigned, b); }

constexpr int ATT_K = 0, ATT_V = 49152;

__device__ __forceinline__ void attn_unit(Frame& F, const Params& P, int b, int kvh, int nb) {
    const bf16* QKV = (const bf16*)(F.ws + WS_QKV); bf16* ATT = (bf16*)(F.ws + WS_ATT);
    LAS unsigned char* lds = F.lds + RING_OFF;
    const int tid = F.tid, lane = F.lane, wave = F.wave;
#pragma unroll
    for (int i = 0; i < 6; ++i) {
        const int idx = tid + NT * i, row = idx >> 3, ch = idx & 7;
        const int pos = (nb - 1) * 128 + row;
        u32x4 kv = (u32x4){0u, 0u, 0u, 0u}, vv = (u32x4){0u, 0u, 0u, 0u};
        if (pos >= 0 && pos < S_) { const bf16* src = QKV + (size_t)(b * S_ + pos) * 768 + 512 + kvh * 64 + ch * 8; kv = *(const u32x4*)src; vv = *(const u32x4*)(src + 128); }
        *(LAS u32x4*)(lds + ATT_K + row * 128 + ((ch ^ (row & 7)) * 16)) = kv;
        *(LAS u32x4*)(lds + ATT_V + row * 128 + ch * 16) = vv;
    }
    __syncthreads();
    const int g = wave >> 1, qh = wave & 1, hq = kvh * 4 + g;
    const int ql = lane & 31, hi = lane >> 5;
    const float sink2 = P.sink[hq] * LOG2E;
    const bool edge = (nb == 0) || (nb == S_ / 128 - 1);
    for (int sb = 0; sb < 2; ++sb) {
        const int q0 = qh * 64 + sb * 32;
        const size_t tok = (size_t)b * S_ + nb * 128 + q0 + ql;
        s16x8 qr[4];
#pragma unroll
        for (int d0 = 0; d0 < 4; ++d0) qr[d0] = *(const s16x8*)(QKV + tok * 768 + hq * 64 + d0 * 16 + hi * 8);
        float m = sink2, l = 0.f;
        f32x16 o0 = {}, o1 = {};
        for (int kt = 0; kt < 9; ++kt) {
            const int kr0 = q0 + 32 * kt;
            f32x16 p = {};
            { const int krow = kr0 + ql; LAS const unsigned char* kb = lds + ATT_K + krow * 128; const int sw = krow & 7;
#pragma unroll
                for (int d0 = 0; d0 < 4; ++d0) { const s16x8 kf = *(LAS const s16x8*)(kb + (((2 * d0 + hi) ^ sw) * 16)); p = __builtin_amdgcn_mfma_f32_32x32x16_bf16(kf, qr[d0], p, 0, 0, 0); } }
            if (kt == 0 || kt == 8 || edge) {
#pragma unroll
                for (int r = 0; r < 16; ++r) { const int krow = kr0 + crow(r, hi); const int rel = krow - (q0 + ql); const int pos = (nb - 1) * 128 + krow;
                    if (rel < 0 || rel > 256 || pos < 0 || pos >= S_) p[r] = -INFINITY; }
            }
            float tm = p[0];
#pragma unroll
            for (int r = 1; r < 16; ++r) tm = fmaxf(tm, p[r]);
            tm = fmaxf(tm, __shfl_xor(tm, 32));
            const float mn = fmaxf(m, tm), alpha = exp2f(m - mn);
            float ps = 0.f;
#pragma unroll
            for (int r = 0; r < 16; ++r) { p[r] = exp2f(p[r] - mn); ps += p[r]; }
            l = l * alpha + ps; m = mn;
#pragma unroll
            for (int r = 0; r < 16; ++r) { o0[r] *= alpha; o1[r] *= alpha; }
            LAS const unsigned char* vb = lds + ATT_V + (kr0 + 4 * hi + ((lane & 15) >> 2)) * 128 + (16 * ((lane >> 4) & 1) + 4 * (lane & 3)) * 2;
#pragma unroll
            for (int s = 0; s < 2; ++s) {
                u32x4 pw; pw.x = cvtpk(p[8 * s + 0], p[8 * s + 1]); pw.y = cvtpk(p[8 * s + 2], p[8 * s + 3]); pw.z = cvtpk(p[8 * s + 4], p[8 * s + 5]); pw.w = cvtpk(p[8 * s + 6], p[8 * s + 7]);
                const s16x8 pf = __builtin_bit_cast(s16x8, pw);
#pragma unroll
                for (int dd = 0; dd < 2; ++dd) {
                    const s16x4 lo = tr16(vb + (16 * s) * 128 + dd * 64), hi4 = tr16(vb + (16 * s + 8) * 128 + dd * 64);
                    const s16x8 vf = cat8(lo, hi4);
                    if (dd == 0) o0 = __builtin_amdgcn_mfma_f32_32x32x16_bf16(vf, pf, o0, 0, 0, 0); else o1 = __builtin_amdgcn_mfma_f32_32x32x16_bf16(vf, pf, o1, 0, 0, 0);
                }
            }
        }
        l += __shfl_xor(l, 32);
        l += exp2f(sink2 - m);
        const float rl = 1.0f / l;
        bf16* op = ATT + tok * 512 + hq * 64;
#pragma unroll
        for (int dd = 0; dd < 2; ++dd)
#pragma unroll
            for (int rg = 0; rg < 4; ++rg) { const f32x16& o = dd ? o1 : o0; const int d = 32 * dd + 8 * rg + 4 * hi;
                *(u32x2*)(op + d) = (u32x2){cvtpk(o[4 * rg + 0] * rl, o[4 * rg + 1] * rl), cvtpk(o[4 * rg + 2] * rl, o[4 * rg + 3] * rl)}; }
    }
    __syncthreads();
}
__device__ __forceinline__ void phase2_attn(Frame& F, const Params& P, int first, int nwg) {
    for (int L = (int)blockIdx.x - first; L < 256; L += nwg) { if (L < 0) break; attn_unit(F, P, L >> 6, (L >> 5) & 1, L & 31); }
}
}
namespace mk {
constexpr int GL_QT = 0, GL_QS = 272;
constexpr int GL_KT = 17408;
constexpr int GL_KE = 34816, GL_KES = 320;
constexpr int GL_VV = 55296, GL_VS = 576;
constexpr int GL_AT = 92160, GL_AS = 144;
constexpr int GL_ZZ = 101376;
constexpr int GL_SEG = 105472;
constexpr int GL_DEC = 109568;
constexpr int GL_UP = 110080;
constexpr int GL_OB = 0, GL_OS = 528;
constexpr int GL_END = 118272;
constexpr int GLA_NSEG = 8, GLA_SEGC = 8;
constexpr int GLA_STATE_FLOATS = 128 * 256;

struct GlaPre { u32x4 v[4]; f32x4 z; unsigned q[8], k[8]; };

template <bool FULL>
__device__ __forceinline__ void gla_load(GlaPre& R, const bf16* GQK, const bf16* GV, const float* Z, int b, int h, int dir, int c, int tid) {
    const int d2 = tid & 63, ls = tid >> 6;
    { const int l = tid >> 3; if (tid < 256) { const int l4 = tid >> 2, r4 = tid & 3; const int il = 64 * c + l4, t = dir ? (S_ - 1 - il) : il;
            R.z = *(const f32x4*)(Z + (size_t)(b * S_ + t) * 32 + dir * 16 + 4 * r4); } (void)l; }
#pragma unroll
    for (int i = 0; i < 4; ++i) { const int idx = tid + NT * i, l = idx >> 5, ch = idx & 31; const int il = 64 * c + l, t = dir ? (S_ - 1 - il) : il;
        R.v[i] = *(const u32x4*)(GV + (size_t)(b * S_ + t) * 1024 + h * 256 + ch * 8); }
}
template <bool FULL>
__device__ __forceinline__ void gla_load_qk(GlaPre& R, const bf16* GQK, int b, int h, int dir, int c, int tid) {
    const int d2 = tid & 63, ls = tid >> 6;
#pragma unroll
    for (int li = 0; li < 8; ++li) { const int il = 64 * c + 8 * ls + li, t = dir ? (S_ - 1 - il) : il; const bf16* row = GQK + (size_t)(b * S_ + t) * 1024 + h * 128 + 2 * d2;
        R.k[li] = *(const unsigned*)(row + 512); if (FULL) R.q[li] = *(const unsigned*)row; }
}

template <bool FULL>
__device__ __forceinline__ void gla_run(Frame& F, const Params& P, int b, int h, int dir, int c0, int nc, f32x16 (&S)[4], float& gacc0, float& gacc1) {
    const bf16* GQK = (const bf16*)(F.ws + WS_GQK); const bf16* GV = (const bf16*)(F.ws + WS_GV); const float* Z = (const float*)(F.ws + WS_Z);
    bf16* OUT = (bf16*)(F.ws + (dir ? WS_OB : WS_OF));
    const float* up = dir ? P.up_b : P.up_f; const float* bias = dir ? P.bias_b : P.bias_f;
    LAS unsigned char* lds = F.lds + RING_OFF;
    const int tid = F.tid, lane = F.lane, w = F.wave, lr = lane & 31, hi = lane >> 5;
    const int d2 = tid & 63, ls = tid >> 6, d0 = 2 * d2;
#pragma unroll
    for (int i = 0; i < 4; ++i) { const int idx = tid + NT * i; ((LAS float*)(lds + GL_UP))[idx] = up[(idx >> 7) * 512 + h * 128 + (idx & 127)]; }
    const f32x2 bias2 = *(const f32x2*)(bias + h * 128 + d0);
    const int trq = (lane & 15) >> 2, trp = lane & 3, trg = (lane >> 4) & 1;
    GlaPre R;
    gla_load<FULL>(R, GQK, GV, Z, b, h, dir, c0, tid);
    for (int ci = 0; ci < nc; ++ci) {
        const int c = c0 + ci;
        gla_load_qk<FULL>(R, GQK, b, h, dir, c, tid);
        if (tid < 256) *(LAS f32x4*)(lds + GL_ZZ + (tid >> 2) * 64 + (tid & 3) * 16) = R.z;
#pragma unroll
        for (int i = 0; i < 4; ++i) { const int idx = tid + NT * i, l = idx >> 5, ch = idx & 31; *(LAS u32x4*)(lds + GL_VV + l * GL_VS + ch * 16) = R.v[i]; }
        if (FULL && ci > 0) {
#pragma unroll
            for (int i = 0; i < 4; ++i) { const int idx = tid + NT * i, l = idx >> 5, ch = idx & 31; const int il = 64 * (c - 1) + l, t = dir ? (S_ - 1 - il) : il;
                *(u32x4*)(OUT + (size_t)(b * S_ + t) * 1024 + h * 256 + ch * 8) = *(LAS const u32x4*)(lds + GL_OB + l * GL_OS + ch * 16); }
        }
        __syncthreads();
        float bl0[8], bl1[8];
        { float run0 = 0.f, run1 = 0.f;
            float up0[16], up1[16];
#pragma unroll
            for (int r = 0; r < 16; ++r) { const f32x2 u2 = *(LAS const f32x2*)(lds + GL_UP + (r * 128 + d0) * 4); up0[r] = u2.x; up1[r] = u2.y; }
#pragma unroll
            for (int li = 0; li < 8; ++li) { const LAS f32x4* zr = (const LAS f32x4*)(lds + GL_ZZ + (8 * ls + li) * 64);
                float x0 = bias2.x, x1 = bias2.y;
#pragma unroll
                for (int q = 0; q < 4; ++q) { const f32x4 zz = zr[q];
                    x0 += zz.x * up0[4 * q] + zz.y * up0[4 * q + 1] + zz.z * up0[4 * q + 2] + zz.w * up0[4 * q + 3];
                    x1 += zz.x * up1[4 * q] + zz.y * up1[4 * q + 1] + zz.z * up1[4 * q + 2] + zz.w * up1[4 * q + 3]; }
                const float l0 = (fminf(x0, 0.f) * LOG2E - __builtin_amdgcn_logf(1.0f + __builtin_amdgcn_exp2f(-fabsf(x0) * LOG2E))) * (1.0f / 16.0f);
                const float l1 = (fminf(x1, 0.f) * LOG2E - __builtin_amdgcn_logf(1.0f + __builtin_amdgcn_exp2f(-fabsf(x1) * LOG2E))) * (1.0f / 16.0f);
                run0 += l0; run1 += l1; bl0[li] = run0; bl1[li] = run1; } }
        *(LAS f32x2*)(lds + GL_SEG + (ls * 128 + d0) * 4) = (f32x2){bl0[7], bl1[7]};
        __syncthreads();
        float off0 = 0.f, off1 = 0.f, g0 = 0.f, g1 = 0.f;
#pragma unroll
        for (int q = 0; q < 8; ++q) { const f32x2 sg = *(LAS const f32x2*)(lds + GL_SEG + (q * 128 + d0) * 4); g0 += sg.x; g1 += sg.y; if (q < ls) { off0 += sg.x; off1 += sg.y; } }
        gacc0 += g0; gacc1 += g1;
        if (ls == 0) *(LAS f32x2*)(lds + GL_DEC + d0 * 4) = (f32x2){__builtin_amdgcn_exp2f(g0), __builtin_amdgcn_exp2f(g1)};
#pragma unroll
        for (int li = 0; li < 8; ++li) { const int l = 8 * ls + li; const float b0 = off0 + bl0[li], b1 = off1 + bl1[li];
            const float k0 = bf2f(R.k[li] & 0xffffu), k1 = bf2f(R.k[li] >> 16);
            *(LAS unsigned*)(lds + GL_KE + l * GL_KES + d0 * 2) = cvtpk(k0 * __builtin_amdgcn_exp2f(g0 - b0), k1 * __builtin_amdgcn_exp2f(g1 - b1));
            if (FULL) { const float q0 = bf2f(R.q[li] & 0xffffu), q1 = bf2f(R.q[li] >> 16);
                *(LAS unsigned*)(lds + GL_QT + l * GL_QS + d0 * 2) = cvtpk(q0 * __builtin_amdgcn_exp2f(b0), q1 * __builtin_amdgcn_exp2f(b1));
                *(LAS unsigned*)(lds + GL_KT + l * GL_QS + d0 * 2) = cvtpk(k0 * __builtin_amdgcn_exp2f(-b0), k1 * __builtin_amdgcn_exp2f(-b1)); }
            if (li & 1) __builtin_amdgcn_sched_barrier(0); }
        if (ci + 1 < nc) gla_load<FULL>(R, GQK, GV, Z, b, h, dir, c + 1, tid);
        __syncthreads();
        s16x8 vf[4];
        { LAS const unsigned char* vb = lds + GL_VV + (8 * hi + trq) * GL_VS + (32 * w + 16 * trg + 4 * trp) * 2;
#pragma unroll
            for (int s = 0; s < 4; ++s) { const s16x4 lo = tr16(vb + (16 * s) * GL_VS), hh = tr16(vb + (16 * s + 4) * GL_VS);
                vf[s] = cat8(lo, hh); } }
        f32x16 O0 = {}, O1 = {};
        if (FULL) {
            if (w < 3) {
                const int li_ = (w + 1) >> 1, mi = w >> 1;
                f32x16 a = {};
#pragma unroll
                for (int s = 0; s < 8; ++s) { const s16x8 kf = *(LAS const s16x8*)(lds + GL_KT + (32 * mi + lr) * GL_QS + (16 * s + 8 * hi) * 2);
                    const s16x8 qf = *(LAS const s16x8*)(lds + GL_QT + (32 * li_ + lr) * GL_QS + (16 * s + 8 * hi) * 2);
                    a = __builtin_amdgcn_mfma_f32_32x32x16_bf16(kf, qf, a, 0, 0, 0); }
                const int l = 32 * li_ + lr;
#pragma unroll
                for (int rg = 0; rg < 4; ++rg) { const int m0 = 32 * mi + 8 * rg + 4 * hi; float v4[4];
#pragma unroll
                    for (int j = 0; j < 4; ++j) { const int m = m0 + j; const bool keep = dir ? (m < l) : (m <= l); v4[j] = keep ? a[4 * rg + j] : 0.f; }
                    *(LAS u32x2*)(lds + GL_AT + l * GL_AS + m0 * 2) = (u32x2){cvtpk(v4[0], v4[1]), cvtpk(v4[2], v4[3])}; }
            }
#pragma unroll
            for (int k = 0; k < 4; ++k)
#pragma unroll
                for (int s2 = 0; s2 < 2; ++s2) { u32x4 pw; pw.x = cvtpk(S[k][8 * s2 + 0], S[k][8 * s2 + 1]); pw.y = cvtpk(S[k][8 * s2 + 2], S[k][8 * s2 + 3]); pw.z = cvtpk(S[k][8 * s2 + 4], S[k][8 * s2 + 5]); pw.w = cvtpk(S[k][8 * s2 + 6], S[k][8 * s2 + 7]);
                    const s16x8 sp = __builtin_bit_cast(s16x8, pw); const int dc = 32 * k + 16 * s2 + 4 * hi;
                    LAS const unsigned char* qrow = lds + GL_QT + lr * GL_QS + dc * 2;
                    { const s16x4 a0 = *(LAS const s16x4*)(qrow), a1 = *(LAS const s16x4*)(qrow + 16);
                      O0 = __builtin_amdgcn_mfma_f32_32x32x16_bf16(cat8(a0, a1), sp, O0, 0, 0, 0); }
                    { const s16x4 a0 = *(LAS const s16x4*)(qrow + 32 * GL_QS), a1 = *(LAS const s16x4*)(qrow + 32 * GL_QS + 16);
                      O1 = __builtin_amdgcn_mfma_f32_32x32x16_bf16(cat8(a0, a1), sp, O1, 0, 0, 0); }
                    if (s2 == 1) __builtin_amdgcn_sched_barrier(0); }
        }
#pragma unroll
        for (int k = 0; k < 4; ++k) {
#pragma unroll
            for (int rg = 0; rg < 4; ++rg) { const f32x4 dc = *(LAS const f32x4*)(lds + GL_DEC + (32 * k + 8 * rg + 4 * hi) * 4);
                S[k][4 * rg + 0] *= dc.x; S[k][4 * rg + 1] *= dc.y; S[k][4 * rg + 2] *= dc.z; S[k][4 * rg + 3] *= dc.w; }
            LAS const unsigned char* kb = lds + GL_KE + (8 * hi + trq) * GL_KES + (32 * k + 16 * trg + 4 * trp) * 2;
#pragma unroll
            for (int s = 0; s < 4; ++s) { const s16x4 lo = tr16(kb + (16 * s) * GL_KES), hh = tr16(kb + (16 * s + 4) * GL_KES);
                const s16x8 kf = cat8(lo, hh);
                S[k] = __builtin_amdgcn_mfma_f32_32x32x16_bf16(kf, vf[s], S[k], 0, 0, 0); }
            __builtin_amdgcn_sched_barrier(0);
        }
        if (FULL) {
            __syncthreads();
#pragma unroll
            for (int lb = 0; lb < 2; ++lb) {
                LAS const unsigned char* arow = lds + GL_AT + (32 * lb + lr) * GL_AS;
#pragma unroll
                for (int s = 0; s < 4; ++s) { if (lb == 0 && s >= 2) continue;
                    const s16x8 af = *(LAS const s16x8*)(arow + (16 * s + 8 * hi) * 2);
                    if (lb == 0) O0 = __builtin_amdgcn_mfma_f32_32x32x16_bf16(af, vf[s], O0, 0, 0, 0); else O1 = __builtin_amdgcn_mfma_f32_32x32x16_bf16(af, vf[s], O1, 0, 0, 0); }
            }
#pragma unroll
            for (int r = 0; r < 16; ++r) { const int l0 = crow(r, hi);
                *(LAS bf16*)(lds + GL_OB + l0 * GL_OS + (32 * w + lr) * 2) = (bf16)(cvtpk(O0[r], 0.f) & 0xffffu);
                *(LAS bf16*)(lds + GL_OB + (32 + l0) * GL_OS + (32 * w + lr) * 2) = (bf16)(cvtpk(O1[r], 0.f) & 0xffffu); }
        }
        __syncthreads();
    }
    if (FULL) {
        const int c = c0 + nc - 1;
#pragma unroll
        for (int i = 0; i < 4; ++i) { const int idx = tid + NT * i, l = idx >> 5, ch = idx & 31; const int il = 64 * c + l, t = dir ? (S_ - 1 - il) : il;
            *(u32x4*)(OUT + (size_t)(b * S_ + t) * 1024 + h * 256 + ch * 8) = *(LAS const u32x4*)(lds + GL_OB + l * GL_OS + ch * 16); }
        __syncthreads();
    }
}
__device__ __forceinline__ float* gla_SL(const Params& P, int u) { return P.out + (size_t)u * GLA_STATE_FLOATS; }
__device__ __forceinline__ float* gla_G(const Params& P, int u) { return P.out + (size_t)256 * GLA_STATE_FLOATS + (size_t)u * 128; }

__device__ __forceinline__ void gla_passA(Frame& F, const Params& P, int u) {
    const int seq = u >> 3, seg = u & 7;
    f32x16 S[4];
#pragma unroll
    for (int k = 0; k < 4; ++k) S[k] = (f32x16){};
    float ga0 = 0.f, ga1 = 0.f;
    gla_run<false>(F, P, seq >> 3, (seq >> 1) & 3, seq & 1, seg * GLA_SEGC, GLA_SEGC, S, ga0, ga1);
    float* SL = gla_SL(P, u);
#pragma unroll
    for (int k = 0; k < 4; ++k)
#pragma unroll
        for (int r = 0; r < 16; ++r) SL[((F.wave * 4 + k) * 16 + r) * 64 + F.lane] = S[k][r];
    if ((F.tid >> 6) == 0) *(f32x2*)(gla_G(P, u) + 2 * (F.tid & 63)) = (f32x2){ga0, ga1};
}
__device__ __forceinline__ void gla_passB(Frame& F, const Params& P, int u) {
    const int seq = u >> 3, seg = u & 7;
    LAS unsigned char* lds = F.lds + RING_OFF;
    const int hi = F.lane >> 5;
    f32x16 S[4];
#pragma unroll
    for (int k = 0; k < 4; ++k) S[k] = (f32x16){};
    for (int i = 0; i < seg; ++i) {
        const int ui = seq * 8 + i;
        if (F.tid < 128) ((LAS float*)(lds + GL_DEC))[F.tid] = __builtin_amdgcn_exp2f(gla_G(P, ui)[F.tid]);
        const float* SL = gla_SL(P, ui);
        f32x16 Lv[4];
#pragma unroll
        for (int k = 0; k < 4; ++k)
#pragma unroll
            for (int r = 0; r < 16; ++r) Lv[k][r] = SL[((F.wave * 4 + k) * 16 + r) * 64 + F.lane];
        __syncthreads();
#pragma unroll
        for (int k = 0; k < 4; ++k)
#pragma unroll
            for (int rg = 0; rg < 4; ++rg) { const f32x4 dc = *(LAS const f32x4*)(lds + GL_DEC + (32 * k + 8 * rg + 4 * hi) * 4);
                S[k][4 * rg + 0] = S[k][4 * rg + 0] * dc.x + Lv[k][4 * rg + 0]; S[k][4 * rg + 1] = S[k][4 * rg + 1] * dc.y + Lv[k][4 * rg + 1];
                S[k][4 * rg + 2] = S[k][4 * rg + 2] * dc.z + Lv[k][4 * rg + 2]; S[k][4 * rg + 3] = S[k][4 * rg + 3] * dc.w + Lv[k][4 * rg + 3]; }
        __syncthreads();
    }
    float ga0 = 0.f, ga1 = 0.f;
    gla_run<true>(F, P, seq >> 3, (seq >> 1) & 3, seq & 1, seg * GLA_SEGC, GLA_SEGC, S, ga0, ga1);
}
}
namespace mk {
constexpr int CW_BAR = 4096;
__global__ void __launch_bounds__(NT, 2) mega_fwd(Params Pin) {
    extern __shared__ __attribute__((aligned(16))) unsigned char lds[];
    typedef const Params __attribute__((address_space(4))) * kparams_t;
    kparams_t Pk = (kparams_t)__builtin_amdgcn_kernarg_segment_ptr();
#define PH(body) do { const Params& P = Pin; body; } while (0)
    Frame F; F.lds = (LAS unsigned char*)lds; F.ws = Pin.ws;
    F.tid = threadIdx.x; F.lane = F.tid & 63; F.wave = __builtin_amdgcn_readfirstlane(F.tid >> 6);
    F.G = gridDim.x; { const int bx = blockIdx.x; F.vcu = (F.G % 8 == 0) ? (bx % 8) * (F.G / 8) + bx / 8 : bx; }
    volatile LAS unsigned* MISC = (volatile LAS unsigned*)(F.lds + MISC_OFF);
    for (int u = F.tid; u < (LDS_BYTES - LDSCTL_OFF) / 4; u += NT) ((LAS unsigned*)(F.lds + LDSCTL_OFF))[u] = 0u;
    __syncthreads();
    XcdBarrier bar = xcd_barrier_post((unsigned*)(Pin.ws + WS_CTL) + CW_BAR, MISC + 8);
#define GRID_BAR() do { xcd_barrier(bar); asm volatile("" : "+v"(F.tid), "+v"(F.lane)); } while (0)
    PH(phase0(F, P));                 GRID_BAR();
    PH(phase1(F, P));                 GRID_BAR();
    PH({ const int u = (int)blockIdx.x; const int seg = u & 7;
      if (seg < 7) { gla_passA(F, P, u); if (seg < 6) { const int L = 64 + seg * 32 + (u >> 3); attn_unit(F, P, L >> 6, (L >> 5) & 1, L & 31); } }
      else { for (int L = u >> 3; L < 64; L += 32) attn_unit(F, P, L >> 6, (L >> 5) & 1, L & 31); } });
    GRID_BAR();
    PH({ const int u = (int)blockIdx.x; const int seg = u & 7;
      (void)seg; gla_passB(F, P, u); });
    GRID_BAR();
    PH(phase3_pre(F, P)); PH(phase3a(F, P)); GRID_BAR();
    PH(phase3b(F, P));                GRID_BAR();
    PH(phase4a(F, P));                GRID_BAR();
    PH(phase4b(F, P));                GRID_BAR();
    PH(phase5(F, P));                 GRID_BAR();
    PH(phase6(F, P));                 GRID_BAR();
    PH(phase7(F, P));                GRID_BAR();
    PH(phase8(F, P));                 GRID_BAR();
    PH(phase9a(F, P)); PH(phase9b(F, P)); GRID_BAR();
    PH(phase10(F, P));
#undef GRID_BAR
#undef PH
}
}
extern "C" void kernel_launch(void* const* d_in, const int* in_sizes, int n_in, void* d_out, int out_size, void* d_ws, size_t ws_size, hipStream_t stream) {
    static int ready = 0;
    if (!ready) {
        if (n_in != 23 || ws_size < WS_END) { fprintf(stderr, "kernel_launch: unexpected inputs (n_in %d, ws %zu < %zu)\n", n_in, ws_size, (size_t)WS_END); ready = -1; return; }
        if (hipFuncSetAttribute((const void*)mk::mega_fwd, hipFuncAttributeMaxDynamicSharedMemorySize, mk::LDS_BYTES) != hipSuccess) { fprintf(stderr, "kernel_launch: hipFuncSetAttribute failed\n"); ready = -1; return; }
        ready = 1;
    }
    if (ready < 0) return;
    Params P{};
    P.x = (const float*)d_in[0]; P.p = (const float*)d_in[1]; P.pos = (const int*)d_in[2]; P.norm_mix = (const float*)d_in[3]; P.w_in = (const float*)d_in[4];
    P.up_f = (const float*)d_in[5]; P.bias_f = (const float*)d_in[6]; P.up_b = (const float*)d_in[7]; P.bias_b = (const float*)d_in[8]; P.sink = (const float*)d_in[9];
    P.gla_norm = (const float*)d_in[10]; P.w_ba = (const float*)d_in[11]; P.w_bg = (const float*)d_in[12]; P.w_out = (const float*)d_in[13]; P.norm_ffn = (const float*)d_in[14];
    P.w_router = (const float*)d_in[15]; P.w_eg = (const float*)d_in[16]; P.w_eu = (const float*)d_in[17]; P.w_ed = (const float*)d_in[18]; P.norm_ple = (const float*)d_in[19];
    P.w_pg = (const float*)d_in[20]; P.w_ple = (const float*)d_in[21]; P.norm_final = (const float*)d_in[22];
    P.out = (float*)d_out; P.ws = (char*)d_ws;
    (void)hipMemsetAsync((char*)d_ws + WS_CTL, 0, 1 * MiB, stream);
    hipLaunchKernelGGL(mk::mega_fwd, dim3(256), dim3(mk::NT), mk::LDS_BYTES, stream, P);
}
```
